# Optimizing an MI355X kernel written in HIP

```python
import jax, jax.numpy as jnp
from jax import lax
import numpy as np

D_MODEL = 4096
BATCH = 4
SEQ = 2048
DEPTH = 1

GRID_W = 64
CTX_LEN = 256
M_HEADS = 8
M_DQK = 256
M_DV = 512
M_CHUNK = 64
A_HEADS = 32
A_KV_HEADS = 8
A_HEAD_DIM = 128
WINDOW = 128
A_BLOCK = 128
ROPE_BASE = 10000.0
D_FF = 4 * D_MODEL
EPS = 1e-6

M_QK_W = M_HEADS * M_DQK
M_V_W = M_HEADS * M_DV
A_Q_W = A_HEADS * A_HEAD_DIM
A_KV_W = A_KV_HEADS * A_HEAD_DIM
SPLITS = (M_QK_W, M_QK_W, M_V_W, M_V_W, 4 * M_HEADS, A_Q_W, A_KV_W, A_KV_W, D_MODEL, D_MODEL)
PROJ_W = sum(SPLITS)

kernel_name = "hybrid_mlstm_swa_dit_block"


def rmsnorm(x, g):
    xf = x.astype(jnp.float32)
    y = xf * lax.rsqrt(jnp.mean(xf * xf, axis=-1, keepdims=True) + EPS)
    return (y * g.astype(jnp.float32)).astype(x.dtype)


def modulate(h, shift, scale):
    return h * (1.0 + scale) + shift


def split_cols(a):
    idx = [int(i) for i in np.cumsum(SPLITS)[:-1]]
    return jnp.split(a, idx, axis=-1)


def _rotate(x, ang):
    x1, x2 = jnp.split(x, 2, axis=-1)
    cos = jnp.cos(ang)[:, None, :].astype(x.dtype)
    sin = jnp.sin(ang)[:, None, :].astype(x.dtype)
    return jnp.concatenate([x1 * cos - x2 * sin, x1 * sin + x2 * cos], axis=-1)


def rope_2d(x, row, col):
    half = x.shape[-1] // 2
    nf = half // 2
    freqs = ROPE_BASE ** (-jnp.arange(nf, dtype=jnp.float32) / nf)
    ang_r = row.astype(jnp.float32)[:, None] * freqs
    ang_c = col.astype(jnp.float32)[:, None] * freqs
    return jnp.concatenate([_rotate(x[..., :half], ang_r), _rotate(x[..., half:], ang_c)], axis=-1)


def mlstm_scan(q, k, v, ig, lf, state):
    B, S, H, _ = q.shape
    nc = S // M_CHUNK
    L = M_CHUNK
    tril = jnp.tril(jnp.ones((L, L), dtype=bool))

    def chunks(a):
        return jnp.moveaxis(a.reshape((B, nc, L) + a.shape[2:]), 1, 0)

    def step(carry, xs):
        C, n, m = carry
        qc, kc, vc, igc, lfc = xs
        b = jnp.cumsum(lfc, axis=1)
        a = b + m[:, None, :]
        Dm = b[:, :, None, :] - b[:, None, :, :] + igc[:, None, :, :]
        Dm = jnp.where(tril[None, :, :, None], Dm, -jnp.inf)
        m_t = jnp.maximum(a, jnp.max(Dm, axis=2))
        s = jnp.einsum('bthd,bshd->btsh', qc, kc) * jnp.exp(Dm - m_t[:, :, None, :])
        inter = jnp.exp(a - m_t)
        num = inter[..., None] * jnp.einsum('bthd,bhvd->bthv', qc, C) + jnp.einsum('btsh,bshv->bthv', s, vc)
        den = inter * jnp.einsum('bthd,bhd->bth', qc, n) + jnp.sum(s, axis=2)
        h = num / jnp.maximum(jnp.abs(den), jnp.exp(-m_t))[..., None]
        bL = b[:, -1]
        w = bL[:, None, :] - b + igc
        m_new = jnp.maximum(bL + m, jnp.max(w, axis=1))
        decay = jnp.exp(bL + m - m_new)
        wexp = jnp.exp(w - m_new[:, None, :])
        C_new = decay[:, :, None, None] * C + jnp.einsum('bsh,bshv,bshd->bhvd', wexp, vc, kc)
        n_new = decay[:, :, None] * n + jnp.einsum('bsh,bshd->bhd', wexp, kc)
        return (C_new, n_new, m_new), h

    state, hs = lax.scan(step, state, (chunks(q), chunks(k), chunks(v), chunks(ig), chunks(lf)))
    h = jnp.moveaxis(hs, 0, 1).reshape(B, S, H, v.shape[-1])
    return h, state


def mlstm_bidir(qm, km, vm, gm, qmc, kmc, vmc, gmc, gate_b):
    f32 = jnp.float32
    B, S = qm.shape[:2]
    Cn = qmc.shape[1]

    def prep(q, k, v, g, n_tok):
        q = q.astype(f32).reshape(B, n_tok, M_HEADS, M_DQK) * (M_DQK ** -0.5)
        k = k.astype(f32).reshape(B, n_tok, M_HEADS, M_DQK)
        v = v.astype(f32).reshape(B, n_tok, M_HEADS, M_DV)
        g = g.astype(f32).reshape(B, n_tok, 4, M_HEADS) + gate_b.astype(f32)
        return q, k, v, g[:, :, 0], jax.nn.log_sigmoid(g[:, :, 1]), g[:, :, 2], jax.nn.log_sigmoid(g[:, :, 3])

    q, k, v, ig_f, lf_f, ig_b, lf_b = prep(qm, km, vm, gm, S)
    qc, kc, vc, igc_f, lfc_f, igc_b, lfc_b = prep(qmc, kmc, vmc, gmc, Cn)
    zero = (jnp.zeros((B, M_HEADS, M_DV, M_DQK), f32), jnp.zeros((B, M_HEADS, M_DQK), f32),
            jnp.zeros((B, M_HEADS), f32))
    rev = lambda a: jnp.flip(a, axis=1)
    hc_f, st_f = mlstm_scan(qc, kc, vc, igc_f, lfc_f, zero)
    h_f, _ = mlstm_scan(q, k, v, ig_f, lf_f, st_f)
    hc_b, st_b = mlstm_scan(rev(qc), rev(kc), rev(vc), rev(igc_b), rev(lfc_b), zero)
    h_b, _ = mlstm_scan(rev(q), rev(k), rev(v), rev(ig_b), rev(lf_b), st_b)
    return h_f + rev(h_b), hc_f + rev(hc_b)


def mlstm_readout(h, o, norm_g):
    B, N = h.shape[:2]
    h = h * lax.rsqrt(jnp.mean(h * h, axis=-1, keepdims=True) + EPS)
    h = h.reshape(B, N, M_V_W) * norm_g.astype(jnp.float32) * jax.nn.sigmoid(o.astype(jnp.float32))
    return h.astype(o.dtype)


def window_attention(q, k, v, kc, vc, sink):
    B, S, Hq, d = q.shape
    Hkv = k.shape[2]
    G = Hq // Hkv
    Cn = kc.shape[1]
    nb = S // A_BLOCK
    scale = d ** -0.5
    pad = ((0, 0), (A_BLOCK, A_BLOCK), (0, 0), (0, 0))
    kp = jnp.pad(k, pad)
    vp = jnp.pad(v, pad)
    qg = q.reshape(B, S, Hkv, G, d)
    sink_l = sink.astype(jnp.float32).reshape(Hkv, G)
    offs_q = jnp.arange(A_BLOCK)
    offs_k = jnp.arange(3 * A_BLOCK) - A_BLOCK

    def block(n):
        start = n * A_BLOCK
        qb = lax.dynamic_slice_in_dim(qg, start, A_BLOCK, axis=1)
        kb = lax.dynamic_slice_in_dim(kp, start, 3 * A_BLOCK, axis=1)
        vb = lax.dynamic_slice_in_dim(vp, start, 3 * A_BLOCK, axis=1)
        qpos = start + offs_q
        kpos = start + offs_k
        valid = (jnp.abs(qpos[:, None] - kpos[None, :]) <= WINDOW) & (kpos >= 0)[None, :] & (kpos < S)[None, :]
        s_w = jnp.einsum('bqhgd,bkhd->bhgqk', qb, kb).astype(jnp.float32) * scale
        s_w = jnp.where(valid, s_w, -jnp.inf)
        s_c = jnp.einsum('bqhgd,bchd->bhgqc', qb, kc).astype(jnp.float32) * scale
        s_s = jnp.broadcast_to(sink_l[None, :, :, None, None], (B, Hkv, G, A_BLOCK, 1))
        p = jax.nn.softmax(jnp.concatenate([s_w, s_c, s_s], axis=-1), axis=-1)
        pw = p[..., :3 * A_BLOCK].astype(v.dtype)
        pc = p[..., 3 * A_BLOCK:3 * A_BLOCK + Cn].astype(v.dtype)
        o = jnp.einsum('bhgqk,bkhd->bqhgd', pw, vb) + jnp.einsum('bhgqc,bchd->bqhgd', pc, vc)
        return o.reshape(B, A_BLOCK, Hq * d)

    out = lax.map(block, jnp.arange(nb))
    return jnp.moveaxis(out, 0, 1).reshape(B, S, Hq * d)


def context_attention(qc, kc, vc, sink):
    B, Cn, Hq, d = qc.shape
    Hkv = kc.shape[2]
    G = Hq // Hkv
    qg = qc.reshape(B, Cn, Hkv, G, d)
    s = jnp.einsum('bqhgd,bkhd->bhgqk', qg, kc).astype(jnp.float32) * (d ** -0.5)
    s_s = jnp.broadcast_to(sink.astype(jnp.float32).reshape(Hkv, G)[None, :, :, None, None], (B, Hkv, G, Cn, 1))
    p = jax.nn.softmax(jnp.concatenate([s, s_s], axis=-1), axis=-1)[..., :Cn]
    o = jnp.einsum('bhgqk,bkhd->bqhgd', p.astype(vc.dtype), vc)
    return o.reshape(B, Cn, Hq * d)


def token_mixers(u, uc, row, col, w_in, m_gate_b, m_norm_g, sink, w_out_m, w_out_a, w_o, ctx_out):
    B, S, _ = u.shape
    Cn = uc.shape[1]
    qm, km, vm, om, gm, qa, ka, va, bg_m, bg_a = split_cols(u @ w_in)
    qmc, kmc, vmc, omc, gmc, qac, kac, vac, bgc_m, bgc_a = split_cols(uc @ w_in)
    hm, hm_c = mlstm_bidir(qm, km, vm, gm, qmc, kmc, vmc, gmc, m_gate_b)
    y_m = mlstm_readout(hm, om, m_norm_g) @ w_out_m
    q = rope_2d(qa.reshape(B, S, A_HEADS, A_HEAD_DIM), row, col)
    k = rope_2d(ka.reshape(B, S, A_KV_HEADS, A_HEAD_DIM), row, col)
    v = va.reshape(B, S, A_KV_HEADS, A_HEAD_DIM)
    kc = kac.reshape(B, Cn, A_KV_HEADS, A_HEAD_DIM)
    vc = vac.reshape(B, Cn, A_KV_HEADS, A_HEAD_DIM)
    y_a = window_attention(q, k, v, kc, vc, sink) @ w_out_a
    mix = (jax.nn.sigmoid(bg_m) * y_m + jax.nn.sigmoid(bg_a) * y_a) @ w_o
    mix_c = None
    if ctx_out:
        y_m_c = mlstm_readout(hm_c, omc, m_norm_g) @ w_out_m
        y_a_c = context_attention(qac.reshape(B, Cn, A_HEADS, A_HEAD_DIM), kc, vc, sink) @ w_out_a
        mix_c = (jax.nn.sigmoid(bgc_m) * y_m_c + jax.nn.sigmoid(bgc_a) * y_a_c) @ w_o
    return mix, mix_c


def sq_relu_mlp(u, w1, w2):
    return jnp.square(jax.nn.relu(u @ w1)) @ w2


def setup_inputs(seed: int = 0) -> dict:
    key = jax.random.key(seed)
    ks = jax.random.split(key, 16)
    D = D_MODEL

    def nrm(k, shape, scale):
        return jax.random.normal(k, shape, jnp.float32) * scale

    gate_base = jnp.array([0.0, 3.0, 0.0, 3.0], jnp.float32)[None, :, None]
    return {
        "x": nrm(ks[0], (BATCH, SEQ, D), 1.0),
        "c": nrm(ks[1], (BATCH, D), 1.0),
        "ctx": nrm(ks[2], (BATCH, CTX_LEN, D), 1.0),
        "c_ctx": nrm(ks[3], (D,), 1.0),
        "w_mod": nrm(ks[4], (DEPTH, D, 6 * D), 0.5 * D ** -0.5),
        "b_mod": nrm(ks[5], (DEPTH, 6 * D), 0.02),
        "norm_g": 1.0 + nrm(ks[6], (DEPTH, 4, D), 0.02),
        "w_in": nrm(ks[7], (DEPTH, D, PROJ_W), D ** -0.5),
        "m_gate_b": gate_base + nrm(ks[8], (DEPTH, 4, M_HEADS), 0.1),
        "m_norm_g": 1.0 + nrm(ks[9], (DEPTH, M_V_W), 0.02),
        "attn_sink": nrm(ks[10], (DEPTH, A_HEADS), 0.5),
        "w_out_m": nrm(ks[11], (DEPTH, M_V_W, D), M_V_W ** -0.5),
        "w_out_a": nrm(ks[12], (DEPTH, A_Q_W, D), A_Q_W ** -0.5),
        "w_o": nrm(ks[13], (DEPTH, D, D), D ** -0.5),
        "w_ff1": nrm(ks[14], (DEPTH, D, D_FF), D ** -0.5),
        "w_ff2": nrm(ks[15], (DEPTH, D_FF, D), D_FF ** -0.5),
    }


def reference(x, c, ctx, c_ctx, w_mod, b_mod, norm_g, w_in, m_gate_b, m_norm_g, attn_sink,
              w_out_m, w_out_a, w_o, w_ff1, w_ff2):
    B, S, _ = x.shape
    ROWS = S // GRID_W
    row, col = jnp.meshgrid(jnp.arange(ROWS), jnp.arange(GRID_W), indexing='ij')
    row = row.reshape(-1)
    col = col.reshape(-1)
    sc = jax.nn.silu(c)
    scc = jax.nn.silu(c_ctx)
    h, hc = x, ctx
    for l in range(DEPTH):
        ctx_out = l < DEPTH - 1
        mod = (sc @ w_mod[l] + b_mod[l])[:, None, :]
        mod_c = scc @ w_mod[l] + b_mod[l]
        sh1, s1, g1, sh2, s2, g2 = jnp.split(mod, 6, axis=-1)
        csh1, cs1, cg1, csh2, cs2, cg2 = jnp.split(mod_c, 6, axis=-1)
        u = modulate(rmsnorm(h, norm_g[l, 0]), sh1, s1)
        uc = modulate(rmsnorm(hc, norm_g[l, 0]), csh1, cs1)
        mix, mix_c = token_mixers(u, uc, row, col, w_in[l], m_gate_b[l], m_norm_g[l], attn_sink[l],
                                  w_out_m[l], w_out_a[l], w_o[l], ctx_out)
        h = h + g1 * rmsnorm(mix, norm_g[l, 1])
        u2 = modulate(rmsnorm(h, norm_g[l, 2]), sh2, s2)
        h = h + g2 * rmsnorm(sq_relu_mlp(u2, w_ff1[l], w_ff2[l]), norm_g[l, 3])
        if ctx_out:
            hc = hc + cg1 * rmsnorm(mix_c, norm_g[l, 1])
            uc2 = modulate(rmsnorm(hc, norm_g[l, 2]), csh2, cs2)
            hc = hc + cg2 * rmsnorm(sq_relu_mlp(uc2, w_ff1[l], w_ff2[l]), norm_g[l, 3])
    return h
```

```cpp
#define MK_N_LAUNCHES 12
#include <hip/hip_runtime.h>
#include <cstdio>
#include <cstdint>
namespace pg8 {
#define PG8_LAS __attribute__((address_space(3)))
typedef unsigned short bf16_t;
typedef short bf16x8 __attribute__((ext_vector_type(8)));
typedef float f32x4 __attribute__((ext_vector_type(4)));
typedef unsigned u32x4 __attribute__((ext_vector_type(4)));
constexpr int BM = 256, BK = 64, HALF = 128, HTB = HALF * BK * 2  , STAGE_BYTES = 8 * HTB, NXCD = 8, WGM = 8;

__host__ __device__ __forceinline__ int lds_byte(int r, int c) { const int st = (r >> 4) * 2 + (c >> 5), rr = r & 15, cc = c & 31, ob = rr * 64 + cc * 2; return st * 1024 + (ob ^ (((ob >> 9) & 1) << 5)); }
__host__ __device__ __forceinline__ void stage_rc(int b, int& R, int& C) { const int st = b / 1024, sb = b % 1024, swz = sb ^ (((sb >> 9) & 1) << 5); R = (st >> 1) * 16 + swz / 64; C = (st & 1) * 32 + (swz % 64) / 2; }
__host__ __device__ __forceinline__ int perm32(int rho) { const int n = rho >> 4, i = rho & 15; return 8 * (i >> 2) + 4 * n + (i & 3); }

struct Unit { int pm, pn; };
struct Gemm { const bf16_t* A; const bf16_t* Bt; int M, N, K; };

struct StaticOrder {
    int nM, nN, nwg, G, c;
    __host__ __device__ void init(int M, int N, int G_, int c_) { nM = M / BM; nN = N / BM; nwg = nM * nN; G = G_; c = c_; }
    __host__ __device__ bool next(int i, Unit& u) const {
        const long L = (long)i * G + c; if (L >= nwg) return false;
        int wgid = (int)L; { const int q = nwg / NXCD, r = nwg % NXCD, xcd = wgid % NXCD, off = wgid / NXCD; wgid = (xcd < r ? xcd * (q + 1) : r * (q + 1) + (xcd - r) * q) + off; }
        const int nig = WGM * nN, gid = wgid / nig, fm = gid * WGM, gsz = (nM - fm) < WGM ? (nM - fm) : WGM;
        u.pm = fm + ((wgid % nig) % gsz); u.pn = (wgid % nig) / gsz; return true;
    }
    __device__ __forceinline__ void a_ready(const Unit&) const {}
    __device__ __forceinline__ void done(const Unit&) const {}
};

__device__ __forceinline__ unsigned cvt_pk_bf16(float lo, float hi) { unsigned r; asm volatile("v_cvt_pk_bf16_f32 %0, %1, %2" : "=v"(r) : "v"(lo), "v"(hi)); return r; }
typedef float f32x2 __attribute__((ext_vector_type(2)));

__device__ __forceinline__ float bf_lo(unsigned w) { return __builtin_bit_cast(float, w << 16); }
__device__ __forceinline__ float bf_hi(unsigned w) { return __builtin_bit_cast(float, w & 0xffff0000u); }
__device__ __forceinline__ float sigmoidf_(float x) { return 1.0f / (1.0f + __expf(-x)); }
template <class F> struct Epi8 {
    static constexpr bool PERM = true, AFTER_DRAIN = false;
    F f;
    __device__ __forceinline__ void operator()(const f32x4 (&acc)[2][2][4][2], const Unit& u, int wr, int wc, int fr, int fq) const {
        const int row0 = u.pm * BM + wr * 64 + fr, col0 = u.pn * BM + wc * 32 + 8 * fq;
#pragma unroll
        for (int ai = 0; ai < 2; ++ai)
#pragma unroll
            for (int m = 0; m < 4; ++m) { const int row = row0 + ai * HALF + m * 16;
#pragma unroll
                for (int bj = 0; bj < 2; ++bj) f(row, col0 + bj * HALF, acc[ai][bj][m][0], acc[ai][bj][m][1], u.pn); }
    }
};
__device__ __forceinline__ u32x4 pack8(const f32x4& v0, const f32x4& v1) { u32x4 w; w.x = cvt_pk_bf16(v0[0], v0[1]); w.y = cvt_pk_bf16(v0[2], v0[3]); w.z = cvt_pk_bf16(v1[0], v1[1]); w.w = cvt_pk_bf16(v1[2], v1[3]); return w; }
struct FProj { bf16_t* P; float* G; int ldp; int gate_pn;
    __device__ __forceinline__ void operator()(int row, int col, const f32x4& v0, const f32x4& v1, int pn) const {
        if (pn == gate_pn) { const int cl = col - gate_pn * BM; if (cl < 32) { *(f32x4*)(G + (size_t)row * 32 + cl) = v0; *(f32x4*)(G + (size_t)row * 32 + cl + 4) = v1; } }
        else *(u32x4*)(P + (size_t)row * ldp + col) = pack8(v0, v1);
    } };
struct FGateM { const bf16_t* Pg; int ldp; float* T; int ldt;
    __device__ __forceinline__ void operator()(int row, int col, const f32x4& v0, const f32x4& v1, int) const {
        const u32x4 g = *(const u32x4*)(Pg + (size_t)row * ldp + col);
        f32x4 a, b; a[0] = sigmoidf_(bf_lo(g.x)) * v0[0]; a[1] = sigmoidf_(bf_hi(g.x)) * v0[1]; a[2] = sigmoidf_(bf_lo(g.y)) * v0[2]; a[3] = sigmoidf_(bf_hi(g.y)) * v0[3];
        b[0] = sigmoidf_(bf_lo(g.z)) * v1[0]; b[1] = sigmoidf_(bf_hi(g.z)) * v1[1]; b[2] = sigmoidf_(bf_lo(g.w)) * v1[2]; b[3] = sigmoidf_(bf_hi(g.w)) * v1[3];
        *(f32x4*)(T + (size_t)row * ldt + col) = a; *(f32x4*)(T + (size_t)row * ldt + col + 4) = b;
    } };
struct FGateA { const bf16_t* Pg; int ldp; const float* T; bf16_t* Y; int ldt;
    __device__ __forceinline__ void operator()(int row, int col, const f32x4& v0, const f32x4& v1, int) const {
        const u32x4 g = *(const u32x4*)(Pg + (size_t)row * ldp + col);
        f32x4 a = *(const f32x4*)(T + (size_t)row * ldt + col), b = *(const f32x4*)(T + (size_t)row * ldt + col + 4);
        a[0] += sigmoidf_(bf_lo(g.x)) * v0[0]; a[1] += sigmoidf_(bf_hi(g.x)) * v0[1]; a[2] += sigmoidf_(bf_lo(g.y)) * v0[2]; a[3] += sigmoidf_(bf_hi(g.y)) * v0[3];
        b[0] += sigmoidf_(bf_lo(g.z)) * v1[0]; b[1] += sigmoidf_(bf_hi(g.z)) * v1[1]; b[2] += sigmoidf_(bf_lo(g.w)) * v1[2]; b[3] += sigmoidf_(bf_hi(g.w)) * v1[3];
        *(u32x4*)(Y + (size_t)row * ldt + col) = pack8(a, b);
    } };
struct FF32 { float* C; int ldc;
    __device__ __forceinline__ void operator()(int row, int col, const f32x4& v0, const f32x4& v1, int) const { *(f32x4*)(C + (size_t)row * ldc + col) = v0; *(f32x4*)(C + (size_t)row * ldc + col + 4) = v1; } };
struct FRelu2 { bf16_t* O; int ldc;
    __device__ __forceinline__ void operator()(int row, int col, const f32x4& v0, const f32x4& v1, int) const {
        f32x4 a, b;
#pragma unroll
        for (int j = 0; j < 4; ++j) { const float x = fmaxf(v0[j], 0.f), y = fmaxf(v1[j], 0.f); a[j] = x * x; b[j] = y * y; }
        *(u32x4*)(O + (size_t)row * ldc + col) = pack8(a, b);
    } };

template <class Epi, class Sched, bool ALIGN_EPI = false, bool SP2 = false>
__device__ __forceinline__ void gemm_phase(PG8_LAS unsigned char* lds, const Gemm g, const Sched& S, const Epi& E) {
    const int tid = threadIdx.x, wid = __builtin_amdgcn_readfirstlane(tid >> 6), lane = tid & 63, wr = wid >> 2, wc = wid & 3, fr = lane & 15, fq = lane >> 4;
    const int K = g.K, nt = K / BK;
    unsigned voffA[2], voffB[2];
#pragma unroll
    for (int i = 0; i < 2; ++i) { int R, C; stage_rc(tid * 16 + i * 8192, R, C); const int Rb = Epi::PERM ? ((R & ~31) + perm32(R & 31)) : R;
        voffA[i] = (unsigned)(R * K + C) * 2u; voffB[i] = (unsigned)(Rb * K + C) * 2u; }
    const size_t kstep = (size_t)(BK * 2);
    const size_t hstep = (size_t)HALF * K * 2;
    const size_t tstep = 2 * hstep;
    const unsigned ldsw = (unsigned)wid * 1024u;
    const int aoff = lds_byte(wr * 64 + fr, fq * 8), boff = lds_byte(wc * 32 + fr, fq * 8);
#define PG8_SA(b, h) (((b) * 2 + (h)) * HTB)
#define PG8_SB(b, h) ((4 + (b) * 2 + (h)) * HTB)
#define PG8_STAGE(bufoff, gbase, voff) do { _Pragma("unroll") for (int _i = 0; _i < 2; ++_i) \
        __builtin_amdgcn_global_load_lds((const unsigned*)((const char*)(gbase) + (voff)[_i]), (PG8_LAS unsigned*)(lds + (bufoff) + ldsw + _i * 8192), 16, 0, 0); } while (0)
#define PG8_LDA(dst, b, h) do { _Pragma("unroll") for (int m = 0; m < 4; ++m) _Pragma("unroll") for (int k = 0; k < 2; ++k) dst[m][k] = *(const PG8_LAS bf16x8*)(lds + PG8_SA(b, h) + aoff + m * 2048 + k * 1024); } while (0)
#define PG8_LDB(dst, b, h) do { _Pragma("unroll") for (int n = 0; n < 2; ++n) _Pragma("unroll") for (int k = 0; k < 2; ++k) dst[n][k] = *(const PG8_LAS bf16x8*)(lds + PG8_SB(b, h) + boff + n * 2048 + k * 1024); } while (0)
#define PG8_MMA(ai, bj, At, Bt) do { __builtin_amdgcn_s_setprio(1); _Pragma("unroll") for (int m = 0; m < 4; ++m) _Pragma("unroll") for (int n = 0; n < 2; ++n) _Pragma("unroll") for (int k = 0; k < 2; ++k) \
        acc[ai][bj][m][n] = __builtin_amdgcn_mfma_f32_16x16x32_bf16(Bt[n][k], At[m][k], acc[ai][bj][m][n], 0, 0, 0); __builtin_amdgcn_s_setprio(0); } while (0)
#define PG8_WAIT_V(n) asm volatile("s_waitcnt vmcnt(" #n ")" ::: "memory")
#define PG8_WAIT_L(n) asm volatile("s_waitcnt lgkmcnt(" #n ")" ::: "memory")
#define PG8_BAR __builtin_amdgcn_s_barrier()
#define PG8_SCHED __builtin_amdgcn_sched_barrier(0)
    Unit cur, nxt; int ui = 0;
    if (!S.next(0, cur)) return;
    f32x4 acc[2][2][4][2];
#pragma unroll
    for (int a = 0; a < 2; ++a)
#pragma unroll
        for (int b = 0; b < 2; ++b)
#pragma unroll
            for (int m = 0; m < 4; ++m)
#pragma unroll
                for (int n = 0; n < 2; ++n) acc[a][b][m][n] = (f32x4){0.f, 0.f, 0.f, 0.f};
    bf16x8 At[4][2], B0[2][2], B1[2][2];
    const char* cA = (const char*)g.A + (size_t)cur.pm * tstep; const char* cB = (const char*)g.Bt + (size_t)cur.pn * tstep;
    S.a_ready(cur);
    if constexpr (SP2) {
        PG8_STAGE(PG8_SB(0, 0), cB, voffB); PG8_STAGE(PG8_SB(0, 1), cB + hstep, voffB); PG8_STAGE(PG8_SA(0, 0), cA, voffA); PG8_STAGE(PG8_SA(0, 1), cA + hstep, voffA);
        if (wr == 1) PG8_BAR;
        PG8_WAIT_V(2); PG8_BAR;
        PG8_STAGE(PG8_SB(1, 0), cB + kstep, voffB); PG8_STAGE(PG8_SA(1, 0), cA + kstep, voffA); PG8_STAGE(PG8_SB(1, 1), cB + hstep + kstep, voffB);
        PG8_WAIT_V(6); PG8_BAR;
    } else {
        PG8_STAGE(PG8_SB(0, 0), cB, voffB); PG8_STAGE(PG8_SA(0, 0), cA, voffA); PG8_STAGE(PG8_SB(0, 1), cB + hstep, voffB); PG8_STAGE(PG8_SA(0, 1), cA + hstep, voffA);
        if (wr == 1) PG8_BAR;
        PG8_WAIT_V(4); PG8_BAR;
        PG8_STAGE(PG8_SB(1, 0), cB + kstep, voffB); PG8_STAGE(PG8_SA(1, 0), cA + kstep, voffA); PG8_STAGE(PG8_SB(1, 1), cB + hstep + kstep, voffB);
        PG8_WAIT_V(6); PG8_BAR;
    }
    for (;;) {
        const bool has_next = S.next(ui + 1, nxt);
        const char* nA = has_next ? (const char*)g.A + (size_t)nxt.pm * tstep : cA; const char* nB = has_next ? (const char*)g.Bt + (size_t)nxt.pn * tstep : cB;
        for (int t = 0; t < nt; t += 2) {
            const bool last = (t == nt - 2);
            const char* a1 = cA + (size_t)(t + 1) * kstep;
            const char* a2 = last ? nA : cA + (size_t)(t + 2) * kstep; const char* b2 = last ? nB : cB + (size_t)(t + 2) * kstep;
            const char* a3 = a2 + kstep; const char* b3 = b2 + kstep;
            if (last && has_next) S.a_ready(nxt);
            if constexpr (SP2) {
            PG8_LDB(B0, 0, 0); PG8_LDB(B1, 0, 1); PG8_SCHED; PG8_LDA(At, 0, 0); PG8_STAGE(PG8_SA(1, 1), a1 + hstep, voffA);
            PG8_WAIT_V(8); PG8_WAIT_L(0); PG8_BAR; PG8_MMA(0, 0, At, B0); PG8_MMA(0, 1, At, B1); PG8_BAR; PG8_SCHED;
            PG8_LDA(At, 0, 1); PG8_STAGE(PG8_SB(0, 0), b2, voffB); PG8_STAGE(PG8_SB(0, 1), b2 + hstep, voffB); PG8_STAGE(PG8_SA(0, 0), a2, voffA);
            PG8_WAIT_V(8); PG8_WAIT_L(0); PG8_BAR; PG8_MMA(1, 0, At, B0); PG8_MMA(1, 1, At, B1); PG8_BAR; PG8_SCHED;
            PG8_LDB(B0, 1, 0); PG8_LDB(B1, 1, 1); PG8_SCHED; PG8_LDA(At, 1, 0); PG8_STAGE(PG8_SA(0, 1), a2 + hstep, voffA);
            PG8_WAIT_V(8); PG8_WAIT_L(0); PG8_BAR; PG8_MMA(0, 0, At, B0); PG8_MMA(0, 1, At, B1); PG8_BAR; PG8_SCHED;
            PG8_LDA(At, 1, 1); PG8_STAGE(PG8_SB(1, 0), b3, voffB); PG8_STAGE(PG8_SB(1, 1), b3 + hstep, voffB); PG8_STAGE(PG8_SA(1, 0), a3, voffA);
            PG8_WAIT_V(8); PG8_WAIT_L(0); PG8_BAR; PG8_MMA(1, 0, At, B0); PG8_MMA(1, 1, At, B1); PG8_BAR; PG8_SCHED;
            } else {
            PG8_LDB(B0, 0, 0); PG8_SCHED; PG8_LDA(At, 0, 0); PG8_STAGE(PG8_SA(1, 1), a1 + hstep, voffA);
            PG8_WAIT_L(8); PG8_BAR; PG8_WAIT_L(0); PG8_MMA(0, 0, At, B0); PG8_BAR; PG8_SCHED;
            PG8_LDB(B1, 0, 1); PG8_STAGE(PG8_SB(0, 0), b2, voffB);
            PG8_BAR; PG8_WAIT_L(0); PG8_MMA(0, 1, At, B1); PG8_BAR;
            PG8_LDA(At, 0, 1); PG8_STAGE(PG8_SA(0, 0), a2, voffA);
            PG8_BAR; PG8_WAIT_L(0); PG8_MMA(1, 0, At, B0); PG8_BAR; PG8_SCHED;
            PG8_STAGE(PG8_SB(0, 1), b2 + hstep, voffB);
            PG8_WAIT_V(6); PG8_BAR; PG8_MMA(1, 1, At, B1); PG8_BAR;
            PG8_LDB(B0, 1, 0); PG8_SCHED; PG8_LDA(At, 1, 0); PG8_STAGE(PG8_SA(0, 1), a2 + hstep, voffA);
            PG8_WAIT_L(8); PG8_BAR; PG8_WAIT_L(0); PG8_MMA(0, 0, At, B0); PG8_BAR; PG8_SCHED;
            PG8_LDB(B1, 1, 1); PG8_STAGE(PG8_SB(1, 0), b3, voffB);
            PG8_BAR; PG8_WAIT_L(0); PG8_MMA(0, 1, At, B1); PG8_BAR;
            PG8_LDA(At, 1, 1); PG8_STAGE(PG8_SA(1, 0), a3, voffA);
            PG8_BAR; PG8_WAIT_L(0); PG8_MMA(1, 0, At, B0); PG8_BAR; PG8_SCHED;
            PG8_STAGE(PG8_SB(1, 1), b3 + hstep, voffB);
            PG8_WAIT_V(6); PG8_BAR; PG8_MMA(1, 1, At, B1); PG8_BAR;
            }
        }
        if constexpr (ALIGN_EPI) { if (wr == 0) PG8_BAR; }
        if constexpr (!Epi::AFTER_DRAIN) { E(acc, cur, wr, wc, fr, fq); S.done(cur); }
        if (!has_next) break;
#pragma unroll
        for (int a = 0; a < 2; ++a)
#pragma unroll
            for (int b = 0; b < 2; ++b)
#pragma unroll
                for (int m = 0; m < 4; ++m)
#pragma unroll
                    for (int n = 0; n < 2; ++n) acc[a][b][m][n] = (f32x4){0.f, 0.f, 0.f, 0.f};
        cur = nxt; cA = nA; cB = nB; ++ui;
        if constexpr (ALIGN_EPI) { if (wr == 1) PG8_BAR; }
    }
    PG8_WAIT_V(0);
    if constexpr (!ALIGN_EPI) { if (wr == 0) PG8_BAR; }
    PG8_BAR;
    if constexpr (Epi::AFTER_DRAIN) { E.fused(acc, cur, wr, wc, fr, fq, lds, wid, lane); S.done(cur); }
#undef PG8_SA
#undef PG8_SB
#undef PG8_STAGE
#undef PG8_LDA
#undef PG8_LDB
#undef PG8_MMA
#undef PG8_WAIT_V
#undef PG8_WAIT_L
#undef PG8_BAR
#undef PG8_SCHED
}
}

constexpr int NWAVES = 8;
#ifndef MK_N_LAUNCHES
#define MK_N_LAUNCHES 1
#endif
constexpr int N_PHASES = 12;
constexpr int N_LAUNCHES = MK_N_LAUNCHES;
static_assert(N_LAUNCHES == 1 || N_LAUNCHES == N_PHASES, "MK_N_LAUNCHES is 1 or N_PHASES");

constexpr int DM = 4096, NB = 4, SEQ = 2048, CTXL = 256, ML = NB * SEQ, MC = NB * CTXL, MT = ML + MC;
constexpr int DFF = 16384, NMOD = 6 * DM;
constexpr int NPW = 26656, NP = 26880;
constexpr int OFF_QM = 0, OFF_KM = 2048, OFF_VM = 4096, OFF_OM = 8192, OFF_QA = 12288, OFF_KA = 16384, OFF_VA = 17408, OFF_BGM = 18432, OFF_BGA = 22528, OFF_GM = 26624;
constexpr int MH = 8, DQK = 256, DV = 512, AH = 32, AKV = 8, AD = 128, WIN = 128;
constexpr float EPS = 1e-6f;

constexpr size_t MiB = 1u << 20;
constexpr size_t WS_CTL = 0, CTL_ZERO_BYTES = 1 * MiB;
constexpr size_t WS_MOD = 1 * MiB;
constexpr size_t WS_WIN = 2 * MiB, WS_WOM = 212 * MiB, WS_WOA = 244 * MiB, WS_WO = 276 * MiB, WS_WF1 = 308 * MiB, WS_WF2 = 436 * MiB;
constexpr size_t WS_U = 564 * MiB;
constexpr size_t WS_P = 636 * MiB;
constexpr size_t WS_G = 1109 * MiB;
constexpr size_t WS_HM = 1111 * MiB, WS_AT = 1175 * MiB;
constexpr size_t WS_MIX = 1239 * MiB, WS_H1 = 1367 * MiB, WS_HB = 1495 * MiB, WS_END = 1623 * MiB;
constexpr size_t WS_HF = 2 * MiB, WS_T = 2 * MiB, WS_U2 = 130 * MiB;
constexpr size_t WS_YG = WS_U, WS_HDN = WS_P, WS_F = WS_MIX;
static_assert(WS_WIN + (size_t)NP * DM * 2 <= WS_WOM && WS_P + (size_t)MT * NP * 2 <= WS_G && WS_G + (size_t)MT * 32 * 4 <= WS_HM && WS_U + (size_t)MT * DM * 2 <= WS_P, "ws map");
static_assert(WS_U2 + (size_t)ML * DM * 2 <= WS_WOM && WS_HDN + (size_t)ML * DFF * 2 <= WS_G, "ws map overlays");
constexpr int CW_BAR = 4096;

constexpr int RING_OFF = 0, RING_BYTES = 131072;
constexpr int LDSCTL_OFF = RING_BYTES, MISC_OFF = LDSCTL_OFF + 320;
constexpr int LDS_BYTES = 147456;
static_assert(MISC_OFF + 128 <= LDS_BYTES, "LDS map");
#define GAS __attribute__((address_space(1)))
#define LAS __attribute__((address_space(3)))
typedef unsigned short bf16;
typedef unsigned v4u __attribute__((ext_vector_type(4)));
typedef float f32x4 __attribute__((ext_vector_type(4)));
typedef short bf16x8 __attribute__((ext_vector_type(8)));
typedef GAS unsigned gu32;
typedef GAS unsigned long long gu64;
#define RLX_AGENT __ATOMIC_RELAXED, __HIP_MEMORY_SCOPE_AGENT
#define LDS_WAIT() asm volatile("s_waitcnt lgkmcnt(0)" ::: "memory")
#define VM_WAIT() asm volatile("s_waitcnt vmcnt(0)" ::: "memory")
__device__ __forceinline__ unsigned long long rt() { return __builtin_amdgcn_s_memrealtime(); }
__device__ __forceinline__ unsigned f2bf(float f) { unsigned u = __builtin_bit_cast(unsigned, f); return (u + 0x7fffu + ((u >> 16) & 1u)) >> 16; }
__device__ __forceinline__ unsigned pk2(float lo, float hi) { return f2bf(lo) | (f2bf(hi) << 16); }

#define XB_TMO      128
#define XB_XCNT(j)  (256  + 64 * (j))
#define XB_XSUB(j)  (1280 + 64 * (j))
#define XB_XGEN(j)  (2304 + 64 * (j))
#define XB_TOP      3328
#define XB_TOPGEN   3392
#define XCD_BAR_WORDS 3456
#define XB_SPIN_CAP (1u << 18)

__device__ __forceinline__ unsigned xb_ld(unsigned* p)              { return __hip_atomic_load(p, __ATOMIC_RELAXED, __HIP_MEMORY_SCOPE_AGENT); }
__device__ __forceinline__ unsigned xb_add(unsigned* p, unsigned v) { return __hip_atomic_fetch_add(p, v, __ATOMIC_RELAXED, __HIP_MEMORY_SCOPE_AGENT); }
__device__ __forceinline__ unsigned xb_xcc_id() { return (unsigned)__builtin_amdgcn_s_getreg((3 << 11) | 20) & 0xFu; }
#define XB_SPIN(cond, bar) do { unsigned _sp = 0; while (cond) { __builtin_amdgcn_s_sleep(1); \
    if ((++_sp & 255u) == 0u) { if (xb_ld(&(bar)[XB_TMO])) break; if (_sp > XB_SPIN_CAP) { atomicAdd(&(bar)[XB_TMO], 1u); break; } } } } while (0)

struct XcdBarrier {
    unsigned* bar; unsigned x;
    volatile LAS unsigned* st;
};

__device__ __forceinline__ XcdBarrier xcd_barrier_post(unsigned* bar, volatile LAS unsigned* st) {
    XcdBarrier b; b.bar = bar; b.x = xb_xcc_id(); b.st = st;
    if (threadIdx.x == 0) (void)xb_add(&bar[XB_XCNT(b.x)], 1u);
    return b;
}
__device__ __forceinline__ void xcd_barrier_complete(unsigned* bar, unsigned x, unsigned& nloc, unsigned& nx) {
    const unsigned G = gridDim.x * gridDim.y * gridDim.z;
    unsigned sum, cnt, mine, sp = 0u;
    for (;;) {
        sum = 0u; cnt = 0u; mine = 0u;
#pragma unroll
        for (unsigned j = 0; j < 16; ++j) { const unsigned c = xb_ld(&bar[XB_XCNT(j)]); sum += c; cnt += (c > 0u) ? 1u : 0u; mine = (j == x) ? c : mine; }
        if (sum == G) break;
        __builtin_amdgcn_s_sleep(1);
        if ((++sp & 255u) == 0u) { if (xb_ld(&bar[XB_TMO])) break; if (sp > XB_SPIN_CAP) { atomicAdd(&bar[XB_TMO], 1u); break; } }
    }
    nloc = mine > 0u ? mine : 1u; nx = cnt > 0u ? cnt : 1u;
}

__device__ __forceinline__ void xcd_barrier(const XcdBarrier& b) {
    asm volatile("s_waitcnt vmcnt(0)" ::: "memory");
    __syncthreads();
    if (threadIdx.x == 0) {
        unsigned* bar = b.bar;
        __builtin_amdgcn_s_waitcnt(0);
        unsigned nloc = b.st[0], nx = b.st[1];
        if (nloc == 0u) { xcd_barrier_complete(bar, b.x, nloc, nx); b.st[0] = nloc; b.st[1] = nx; }
        const unsigned old = xb_add(&bar[XB_XSUB(b.x)], 1u);
        const unsigned gen = old / nloc;
        if (old + 1u == (gen + 1u) * nloc) {
            __builtin_amdgcn_fence(__ATOMIC_RELEASE, "agent");
            asm volatile("s_waitcnt vmcnt(0)" ::: "memory");
            const unsigned og = xb_add(&bar[XB_TOP], 1u);
            const unsigned tg = og / nx;
            if (og + 1u == (tg + 1u) * nx) xb_add(&bar[XB_TOPGEN], 1u);
            else XB_SPIN(xb_ld(&bar[XB_TOPGEN]) == tg, bar);
            __builtin_amdgcn_fence(__ATOMIC_ACQUIRE, "agent");
            xb_add(&bar[XB_XGEN(b.x)], 1u);
            asm volatile("s_waitcnt vmcnt(0)" ::: "memory");
        } else {
            XB_SPIN(xb_ld(&bar[XB_XGEN(b.x)]) == gen, bar);
            __builtin_amdgcn_fence(__ATOMIC_ACQUIRE, "agent");
            asm volatile("s_waitcnt vmcnt(0)" ::: "memory");
        }
    }
    __syncthreads();
}

__device__ __forceinline__ float wave_sum(float v) {
#pragma unroll
    for (int o = 1; o < 64; o <<= 1) v += __shfl_xor(v, o);
    return v;
}
__device__ __forceinline__ float wave_max(float v) {
#pragma unroll
    for (int o = 1; o < 64; o <<= 1) v = fmaxf(v, __shfl_xor(v, o));
    return v;
}
__device__ __forceinline__ float bf2f(bf16 b) { return __builtin_bit_cast(float, (unsigned)b << 16); }
__device__ __forceinline__ float bflo(unsigned w) { return __builtin_bit_cast(float, w << 16); }
__device__ __forceinline__ float bfhi(unsigned w) { return __builtin_bit_cast(float, w & 0xffff0000u); }
__device__ __forceinline__ float sigm(float x) { return 1.0f / (1.0f + expf(-x)); }
__device__ __forceinline__ float logsig(float x) { return x < 0.f ? x - log1pf(expf(x)) : -log1pf(expf(-x)); }

struct Args { const float* in[16]; float* out; unsigned char* ws; int ph_lo, ph_hi; };

__device__ __forceinline__ int win_map(int n0) { return n0 < 12288 ? n0 : (n0 < 12320 ? OFF_GM + (n0 - 12288) : n0 - 32); }

__device__ __forceinline__ void p0_transpose_item(const float* W, int K, int N, bf16* WT, bool remap, LAS float* scr, int item, int lane) {
    const int nblk = N / 32, kb = item / nblk, nb = item % nblk, k0 = 64 * kb, n0 = 32 * nb;
    const int d0 = remap ? win_map(n0) : n0;
#pragma unroll 8
    for (int i = 0; i < 32; ++i) { const int kk = 2 * i + (lane >> 5); scr[kk * 33 + (lane & 31)] = W[(size_t)(k0 + kk) * N + n0 + (lane & 31)]; }
    LDS_WAIT(); asm volatile("" ::: "memory");
    const int c = lane & 7;
#pragma unroll
    for (int j = 0; j < 4; ++j) { const int n = (lane >> 3) + 8 * j; const LAS float* s = scr + (8 * c) * 33 + n;
        v4u o; o.x = pk2(s[0 * 33], s[1 * 33]); o.y = pk2(s[2 * 33], s[3 * 33]); o.z = pk2(s[4 * 33], s[5 * 33]); o.w = pk2(s[6 * 33], s[7 * 33]);
        *(GAS v4u*)(WT + (size_t)(d0 + n) * K + k0 + 8 * c) = o; }
    LDS_WAIT(); asm volatile("" ::: "memory");
}

__device__ __forceinline__ void p0_prologue(const Args& A, LAS unsigned char* lds, int tid, int lane, int wave, int G) {
    unsigned char* ws = A.ws;
    LAS float* scr = (LAS float*)(lds + wave * 16384);
    const int gw = blockIdx.x * NWAVES + wave, NGW = G * NWAVES;
    constexpr int I_IN = (DM / 64) * (NPW / 32), I_SQ = (DM / 64) * (DM / 32), I_F1 = (DM / 64) * (DFF / 32), I_F2 = (DFF / 64) * (DM / 32);
    constexpr int NITEMS = I_IN + 3 * I_SQ + I_F1 + I_F2;
    for (int it = gw; it < NITEMS; it += NGW) {
        int r = it;
        if (r < I_IN) { p0_transpose_item(A.in[7], DM, NPW, (bf16*)(ws + WS_WIN), true, scr, r, lane); continue; } r -= I_IN;
        if (r < I_SQ) { p0_transpose_item(A.in[11], DM, DM, (bf16*)(ws + WS_WOM), false, scr, r, lane); continue; } r -= I_SQ;
        if (r < I_SQ) { p0_transpose_item(A.in[12], DM, DM, (bf16*)(ws + WS_WOA), false, scr, r, lane); continue; } r -= I_SQ;
        if (r < I_SQ) { p0_transpose_item(A.in[13], DM, DM, (bf16*)(ws + WS_WO), false, scr, r, lane); continue; } r -= I_SQ;
        if (r < I_F1) { p0_transpose_item(A.in[14], DM, DFF, (bf16*)(ws + WS_WF1), false, scr, r, lane); continue; } r -= I_F1;
        p0_transpose_item(A.in[15], DFF, DM, (bf16*)(ws + WS_WF2), false, scr, r, lane);
    }
    __syncthreads();
    LAS float* sc = (LAS float*)lds;
    LAS float* red = sc + 5 * DM;
    const float* cvec = A.in[1]; const float* cctx = A.in[3]; const float* wmod = A.in[4]; const float* bmod = A.in[5];
    float* MOD = (float*)(ws + WS_MOD);
    for (int e = tid; e < 5 * DM; e += NWAVES * 64) { const int r = e >> 12, k = e & (DM - 1); const float cv = r < 4 ? cvec[r * DM + k] : cctx[k]; sc[e] = cv / (1.0f + expf(-cv)); }
    __syncthreads();
    for (int cg = blockIdx.x; cg < NMOD / 96; cg += G) {
        const int kg = tid >> 5, cl = tid & 31;
        float a0[5], a1[5], a2[5];
#pragma unroll
        for (int r = 0; r < 5; ++r) { a0[r] = 0.f; a1[r] = 0.f; a2[r] = 0.f; }
#pragma unroll 4
        for (int k = kg; k < DM; k += 16) {
            const float* wr = wmod + (size_t)k * NMOD + cg * 96 + cl;
            const float w0 = wr[0], w1 = wr[32], w2 = wr[64];
#pragma unroll
            for (int r = 0; r < 5; ++r) { const float s = sc[r * DM + k]; a0[r] += s * w0; a1[r] += s * w1; a2[r] += s * w2; }
        }
#pragma unroll
        for (int r = 0; r < 5; ++r) { red[((kg * 3 + 0) * 5 + r) * 32 + cl] = a0[r]; red[((kg * 3 + 1) * 5 + r) * 32 + cl] = a1[r]; red[((kg * 3 + 2) * 5 + r) * 32 + cl] = a2[r]; }
        __syncthreads();
        if (tid < 480) { const int cc = tid / 160, r = (tid / 32) % 5, c2 = tid & 31; float s = 0.f;
#pragma unroll
            for (int g = 0; g < 16; ++g) s += red[((g * 3 + cc) * 5 + r) * 32 + c2];
            const int col = cg * 96 + cc * 32 + c2; MOD[r * NMOD + col] = s + bmod[col]; }
        __syncthreads();
    }
}

__device__ __forceinline__ void p1_rows(const Args& A, int lane, int wave, int G) {
    const int gw = blockIdx.x * NWAVES + wave, NGW = G * NWAVES;
    const float* MOD = (const float*)(A.ws + WS_MOD); const float* ng = A.in[6];
    bf16* U = (bf16*)(A.ws + WS_U);
    for (int m = gw; m < MT; m += NGW) {
        const float* xr = m < ML ? A.in[0] + (size_t)m * DM : A.in[2] + (size_t)(m - ML) * DM;
        const int r = m < ML ? m / SEQ : 4;
        const f32x4* x4 = (const f32x4*)xr + lane;
        f32x4 v[16]; float ss = 0.f;
#pragma unroll
        for (int j = 0; j < 16; ++j) { v[j] = x4[64 * j]; ss += (v[j].x * v[j].x + v[j].y * v[j].y) + (v[j].z * v[j].z + v[j].w * v[j].w); }
        const float rstd = 1.0f / sqrtf(wave_sum(ss) * (1.0f / DM) + EPS);
        const f32x4* g4 = (const f32x4*)ng + lane; const f32x4* sh4 = (const f32x4*)(MOD + r * NMOD) + lane; const f32x4* s4 = (const f32x4*)(MOD + r * NMOD + DM) + lane;
        unsigned long long* o8 = (unsigned long long*)(U + (size_t)m * DM) + lane;
#pragma unroll
        for (int j = 0; j < 16; ++j) { const f32x4 g = g4[64 * j], sh = sh4[64 * j], s = s4[64 * j]; const f32x4 y = v[j] * rstd * g; const f32x4 u = y * (1.0f + s) + sh;
            o8[64 * j] = (unsigned long long)pk2(u.x, u.y) | ((unsigned long long)pk2(u.z, u.w) << 32); }
    }
}

__device__ __forceinline__ void p3_rope(const Args& A, int tid, int G) {
    bf16* P = (bf16*)(A.ws + WS_P);
    const size_t total = (size_t)ML * 40 * 64, stride = (size_t)G * NWAVES * 64;
    for (size_t idx = (size_t)blockIdx.x * NWAVES * 64 + tid; idx < total; idx += stride) {
        const int pi = (int)(idx & 63), hd = (int)((idx >> 6) % 40), row = (int)(idx / (64 * 40));
        const int half = pi >> 5, i = pi & 31, t = row % SEQ, pos = half ? (t & 63) : (t >> 6);
        const float freq = expf(-(float)i * (1.0f / 32.0f) * 9.210340371976184f);
        const float ang = (float)pos * freq, cs = cosf(ang), sn = sinf(ang);
        const int colbase = (hd < 32 ? OFF_QA + hd * 128 : OFF_KA + (hd - 32) * 128) + half * 64 + i;
        bf16* p = P + (size_t)row * NP + colbase;
        const float x1 = bf2f(p[0]), x2 = bf2f(p[32]);
        p[0] = (bf16)f2bf(x1 * cs - x2 * sn); p[32] = (bf16)f2bf(x1 * sn + x2 * cs);
    }
}

__device__ __forceinline__ void mlstm_naive_item(const Args& A, LAS unsigned char* lds, int tid, int item) {
    const int vs = item & 3, dir = (item >> 2) & 1, h = (item >> 3) & 7, b = item >> 6;
    const int vl = tid >> 2, jg = tid & 3;
    const bf16* P = (const bf16*)(A.ws + WS_P); const float* Gt = (const float*)(A.ws + WS_G);
    float* Hb = (float*)(A.ws + (dir ? WS_HB : WS_HF));
    LAS float* Qs = (LAS float*)lds; LAS float* Ks = Qs + 16 * 256; LAS float* Vs = Ks + 16 * 256; LAS float* Gs = Vs + 16 * 128;
    const float bi = A.in[8][(2 * dir) * 8 + h], bfg = A.in[8][(2 * dir + 1) * 8 + h];
    float C[64], n[64];
#pragma unroll
    for (int j = 0; j < 64; ++j) { C[j] = 0.f; n[j] = 0.f; }
    float m = 0.f;
#pragma unroll 1
    for (int s0 = 0; s0 < CTXL + SEQ; s0 += 16) {
        __syncthreads();
        for (int e = tid; e < 16 * 256; e += NWAVES * 64) { const int s = e >> 8, j = e & 255, st = s0 + s;
            const int row = st < CTXL ? ML + b * CTXL + (dir ? CTXL - 1 - st : st) : b * SEQ + (dir ? SEQ - 1 - (st - CTXL) : st - CTXL);
            Qs[e] = bf2f(P[(size_t)row * NP + OFF_QM + h * DQK + j]) * 0.0625f; Ks[e] = bf2f(P[(size_t)row * NP + OFF_KM + h * DQK + j]); }
        for (int e = tid; e < 16 * 128; e += NWAVES * 64) { const int s = e >> 7, j = e & 127, st = s0 + s;
            const int row = st < CTXL ? ML + b * CTXL + (dir ? CTXL - 1 - st : st) : b * SEQ + (dir ? SEQ - 1 - (st - CTXL) : st - CTXL);
            Vs[e] = bf2f(P[(size_t)row * NP + OFF_VM + h * DV + vs * 128 + j]); }
        if (tid < 32) { const int s = tid >> 1, wh = tid & 1, st = s0 + s;
            const int row = st < CTXL ? ML + b * CTXL + (dir ? CTXL - 1 - st : st) : b * SEQ + (dir ? SEQ - 1 - (st - CTXL) : st - CTXL);
            Gs[tid] = Gt[(size_t)row * 32 + (2 * dir + wh) * 8 + h] + (wh ? bfg : bi); }
        __syncthreads();
#pragma unroll 1
        for (int s = 0; s < 16; ++s) {
            const float ig = Gs[2 * s], lf = logsig(Gs[2 * s + 1]);
            const float mn = fmaxf(lf + m, ig), fd = expf(lf + m - mn), iw = expf(ig - mn);
            m = mn;
            const float iv = iw * Vs[s * 128 + vl];
            float num = 0.f, den = 0.f;
#pragma unroll
            for (int jj = 0; jj < 64; jj += 4) {
                const f32x4 k4 = *(const LAS f32x4*)(Ks + s * 256 + jg * 64 + jj), q4 = *(const LAS f32x4*)(Qs + s * 256 + jg * 64 + jj);
#pragma unroll
                for (int e = 0; e < 4; ++e) { C[jj + e] = fd * C[jj + e] + iv * k4[e]; n[jj + e] = fd * n[jj + e] + iw * k4[e]; num += C[jj + e] * q4[e]; den += n[jj + e] * q4[e]; }
            }
            num += __shfl_xor(num, 1); num += __shfl_xor(num, 2); den += __shfl_xor(den, 1); den += __shfl_xor(den, 2);
            const int st = s0 + s;
            if (st >= CTXL && jg == 0) { const int row = b * SEQ + (dir ? SEQ - 1 - (st - CTXL) : st - CTXL);
                Hb[(size_t)row * DM + h * DV + vs * 128 + vl] = num / fmaxf(fabsf(den), expf(-mn)); }
        }
    }
    __syncthreads();
}

__device__ __forceinline__ void attn_naive_item(const Args& A, LAS float* wl, int lane, int item) {
    const int t = item & (SEQ - 1), hq = (item >> 11) & 31, b = item >> 16, hkv = hq >> 2;
    const bf16* P = (const bf16*)(A.ws + WS_P); bf16* AT = (bf16*)(A.ws + WS_AT);
    const int row = b * SEQ + t;
    { const unsigned qq = *(const unsigned*)(P + (size_t)row * NP + OFF_QA + hq * AD + 2 * lane); wl[2 * lane] = bflo(qq); wl[2 * lane + 1] = bfhi(qq); }
    LDS_WAIT(); asm volatile("" ::: "memory");
    const int lo = t - WIN < 0 ? 0 : t - WIN, hi = t + WIN > SEQ - 1 ? SEQ - 1 : t + WIN, nW = hi - lo + 1, nK = nW + CTXL;
    const float sink = A.in[10][hq], scale = 0.08838834764831845f;
    float sc[9]; float mx = sink;
#pragma unroll
    for (int bt = 0; bt < 9; ++bt) {
        const int j = bt * 64 + lane; const bool valid = j < nK; const int jc = valid ? j : 0;
        const int krow = jc < nW ? b * SEQ + lo + jc : ML + b * CTXL + (jc - nW);
        const bf16* kp = P + (size_t)krow * NP + OFF_KA + hkv * AD; float d = 0.f;
#pragma unroll 4
        for (int c = 0; c < 16; ++c) { const v4u kk = *(const v4u*)(kp + 8 * c); const f32x4 q0 = *(const LAS f32x4*)(wl + 8 * c), q1 = *(const LAS f32x4*)(wl + 8 * c + 4);
            d += bflo(kk.x) * q0[0] + bfhi(kk.x) * q0[1] + bflo(kk.y) * q0[2] + bfhi(kk.y) * q0[3] + bflo(kk.z) * q1[0] + bfhi(kk.z) * q1[1] + bflo(kk.w) * q1[2] + bfhi(kk.w) * q1[3]; }
        sc[bt] = valid ? d * scale : -INFINITY; mx = fmaxf(mx, sc[bt]);
    }
    mx = wave_max(mx);
    float sum = 0.f;
#pragma unroll
    for (int bt = 0; bt < 9; ++bt) { const float p = expf(sc[bt] - mx); sum += p; wl[128 + bt * 64 + lane] = p; }
    sum = wave_sum(sum) + expf(sink - mx);
    LDS_WAIT(); asm volatile("" ::: "memory");
    float o0 = 0.f, o1 = 0.f;
#pragma unroll 4
    for (int j = 0; j < nK; ++j) { const float p = wl[128 + j]; const int vrow = j < nW ? b * SEQ + lo + j : ML + b * CTXL + (j - nW);
        const unsigned vv = *(const unsigned*)(P + (size_t)vrow * NP + OFF_VA + hkv * AD + 2 * lane); o0 += p * bflo(vv); o1 += p * bfhi(vv); }
    const float inv = 1.0f / sum;
    *(unsigned*)(AT + (size_t)row * DM + hq * AD + 2 * lane) = pk2(o0 * inv, o1 * inv);
    LDS_WAIT(); asm volatile("" ::: "memory");
}

__device__ __forceinline__ void p5_readout(const Args& A, int lane, int wave, int G) {
    const int gw = blockIdx.x * NWAVES + wave, NGW = G * NWAVES;
    const float* HF = (const float*)(A.ws + WS_HF); const float* HB = (const float*)(A.ws + WS_HB);
    const bf16* P = (const bf16*)(A.ws + WS_P); bf16* HM = (bf16*)(A.ws + WS_HM); const float* mng = A.in[9];
    for (int it = gw; it < ML * MH; it += NGW) {
        const int row = it >> 3, h = it & 7; const size_t off = (size_t)row * DM + h * DV + 8 * lane;
        f32x4 a0 = *(const f32x4*)(HF + off), a1 = *(const f32x4*)(HF + off + 4); const f32x4 b0 = *(const f32x4*)(HB + off), b1 = *(const f32x4*)(HB + off + 4);
        a0 += b0; a1 += b1;
        const float ss = (a0.x * a0.x + a0.y * a0.y) + (a0.z * a0.z + a0.w * a0.w) + (a1.x * a1.x + a1.y * a1.y) + (a1.z * a1.z + a1.w * a1.w);
        const float rstd = 1.0f / sqrtf(wave_sum(ss) * (1.0f / DV) + EPS);
        const v4u om = *(const v4u*)(P + (size_t)row * NP + OFF_OM + h * DV + 8 * lane);
        const f32x4 g0 = *(const f32x4*)(mng + h * DV + 8 * lane), g1 = *(const f32x4*)(mng + h * DV + 8 * lane + 4);
        v4u o;
        o.x = pk2(a0.x * rstd * g0.x * sigm(bflo(om.x)), a0.y * rstd * g0.y * sigm(bfhi(om.x)));
        o.y = pk2(a0.z * rstd * g0.z * sigm(bflo(om.y)), a0.w * rstd * g0.w * sigm(bfhi(om.y)));
        o.z = pk2(a1.x * rstd * g1.x * sigm(bflo(om.z)), a1.y * rstd * g1.y * sigm(bfhi(om.z)));
        o.w = pk2(a1.z * rstd * g1.z * sigm(bflo(om.w)), a1.w * rstd * g1.w * sigm(bfhi(om.w)));
        *(v4u*)(HM + off) = o;
    }
}

__device__ __forceinline__ void p8_rows(const Args& A, int lane, int wave, int G) {
    const int gw = blockIdx.x * NWAVES + wave, NGW = G * NWAVES;
    const float* MOD = (const float*)(A.ws + WS_MOD); const float* ng = A.in[6];
    const float* MIX = (const float*)(A.ws + WS_MIX); float* H1 = (float*)(A.ws + WS_H1); bf16* U2 = (bf16*)(A.ws + WS_U2);
    for (int m = gw; m < ML; m += NGW) {
        const int r = m / SEQ;
        const f32x4* mx4 = (const f32x4*)(MIX + (size_t)m * DM) + lane; const f32x4* x4 = (const f32x4*)(A.in[0] + (size_t)m * DM) + lane;
        f32x4 v[16]; float ss = 0.f;
#pragma unroll
        for (int j = 0; j < 16; ++j) { v[j] = mx4[64 * j]; ss += (v[j].x * v[j].x + v[j].y * v[j].y) + (v[j].z * v[j].z + v[j].w * v[j].w); }
        const float rstd = 1.0f / sqrtf(wave_sum(ss) * (1.0f / DM) + EPS);
        const f32x4* n1 = (const f32x4*)(ng + DM) + lane; const f32x4* n2 = (const f32x4*)(ng + 2 * DM) + lane;
        const f32x4* g1 = (const f32x4*)(MOD + r * NMOD + 2 * DM) + lane; const f32x4* sh2 = (const f32x4*)(MOD + r * NMOD + 3 * DM) + lane; const f32x4* s2 = (const f32x4*)(MOD + r * NMOD + 4 * DM) + lane;
        f32x4* h4 = (f32x4*)(H1 + (size_t)m * DM) + lane; float ss2 = 0.f;
#pragma unroll
        for (int j = 0; j < 16; ++j) { const f32x4 hh = x4[64 * j] + g1[64 * j] * (v[j] * rstd * n1[64 * j]); v[j] = hh; h4[64 * j] = hh; ss2 += (hh.x * hh.x + hh.y * hh.y) + (hh.z * hh.z + hh.w * hh.w); }
        const float rstd2 = 1.0f / sqrtf(wave_sum(ss2) * (1.0f / DM) + EPS);
        unsigned long long* o8 = (unsigned long long*)(U2 + (size_t)m * DM) + lane;
#pragma unroll
        for (int j = 0; j < 16; ++j) { const f32x4 u = (v[j] * rstd2 * n2[64 * j]) * (1.0f + s2[64 * j]) + sh2[64 * j];
            o8[64 * j] = (unsigned long long)pk2(u.x, u.y) | ((unsigned long long)pk2(u.z, u.w) << 32); }
    }
}

__device__ __forceinline__ void p11_rows(const Args& A, int lane, int wave, int G, bool poison) {
    const int gw = blockIdx.x * NWAVES + wave, NGW = G * NWAVES;
    const float* MOD = (const float*)(A.ws + WS_MOD); const float* ng = A.in[6];
    const float* Fb = (const float*)(A.ws + WS_F); const float* H1 = (const float*)(A.ws + WS_H1);
    for (int m = gw; m < ML; m += NGW) {
        const int r = m / SEQ;
        const f32x4* f4 = (const f32x4*)(Fb + (size_t)m * DM) + lane; const f32x4* h4 = (const f32x4*)(H1 + (size_t)m * DM) + lane;
        f32x4 v[16]; float ss = 0.f;
#pragma unroll
        for (int j = 0; j < 16; ++j) { v[j] = f4[64 * j]; ss += (v[j].x * v[j].x + v[j].y * v[j].y) + (v[j].z * v[j].z + v[j].w * v[j].w); }
        const float rstd = 1.0f / sqrtf(wave_sum(ss) * (1.0f / DM) + EPS);
        const f32x4* n3 = (const f32x4*)(ng + 3 * DM) + lane; const f32x4* g2 = (const f32x4*)(MOD + r * NMOD + 5 * DM) + lane;
        f32x4* o4 = (f32x4*)(A.out + (size_t)m * DM) + lane; const float qn = __builtin_nanf("");
#pragma unroll
        for (int j = 0; j < 16; ++j) { f32x4 o = h4[64 * j] + g2[64 * j] * (v[j] * rstd * n3[64 * j]); if (poison) o = (f32x4){qn, qn, qn, qn}; o4[64 * j] = o; }
    }
}

__global__ void __launch_bounds__(NWAVES * 64, 2) fwd_kernel(Args args) {
    extern __shared__ __attribute__((aligned(16))) unsigned char lds_raw[];
    LAS unsigned char* lds = (LAS unsigned char*)lds_raw;
    volatile LAS unsigned* MISC = (volatile LAS unsigned*)(lds + MISC_OFF);
    const int tid = threadIdx.x, lane = tid & 63, wave = __builtin_amdgcn_readfirstlane(tid >> 6), G = gridDim.x;
    unsigned char* ws = args.ws;
    gu32* ctl = (gu32*)(ws + WS_CTL);
    for (int u = tid; u < (LDS_BYTES - LDSCTL_OFF) / 4; u += NWAVES * 64) ((LAS unsigned*)(lds + LDSCTL_OFF))[u] = 0u;
    __syncthreads();
    XcdBarrier bar; bar.bar = (unsigned*)(ctl + CW_BAR); bar.x = 0; bar.st = nullptr;
    if (N_LAUNCHES == 1) bar = xcd_barrier_post((unsigned*)(ctl + CW_BAR), MISC + 8);
    const int lo = args.ph_lo, hi = args.ph_hi;
#define IN(k) (lo <= (k) && (k) < hi)
#define SEAM(k) do { if (IN(k) && IN((k) + 1)) xcd_barrier(bar); } while (0)

    if (IN(0)) { p0_prologue(args, lds, tid, lane, wave, G); } SEAM(0);
    if (IN(1)) { p1_rows(args, lane, wave, G); } SEAM(1);
    if (IN(2)) {
        pg8::Gemm g{(const pg8::bf16_t*)(ws + WS_U), (const pg8::bf16_t*)(ws + WS_WIN), MT, NP, DM}; pg8::StaticOrder S; S.init(MT, NP, G, (int)blockIdx.x);
        pg8::Epi8<pg8::FProj> E{{(pg8::bf16_t*)(ws + WS_P), (float*)(ws + WS_G), NP, OFF_GM / 256}};
        pg8::gemm_phase<pg8::Epi8<pg8::FProj>, pg8::StaticOrder, true, true>(lds + RING_OFF, g, S, E);
    } SEAM(2);
    if (IN(3)) { p3_rope(args, tid, G); } SEAM(3);
    if (IN(4)) {
        for (int item = blockIdx.x; item < NB * MH * 2 * 4; item += G) mlstm_naive_item(args, lds, tid, item);
        __syncthreads();
        LAS float* wl = (LAS float*)(lds + wave * 4096);
        for (int it = blockIdx.x * NWAVES + wave; it < NB * AH * SEQ; it += G * NWAVES) attn_naive_item(args, wl, lane, it);
        __syncthreads();
    } SEAM(4);
    if (IN(5)) { p5_readout(args, lane, wave, G); } SEAM(5);
    if (IN(6)) {
        { pg8::Gemm g{(const pg8::bf16_t*)(ws + WS_HM), (const pg8::bf16_t*)(ws + WS_WOM), ML, DM, DM}; pg8::StaticOrder S; S.init(ML, DM, G, (int)blockIdx.x);
          pg8::Epi8<pg8::FGateM> E{{(const pg8::bf16_t*)(ws + WS_P) + OFF_BGM, NP, (float*)(ws + WS_T), DM}};
          pg8::gemm_phase<pg8::Epi8<pg8::FGateM>, pg8::StaticOrder, true, true>(lds + RING_OFF, g, S, E); }
        { pg8::Gemm g{(const pg8::bf16_t*)(ws + WS_AT), (const pg8::bf16_t*)(ws + WS_WOA), ML, DM, DM}; pg8::StaticOrder S; S.init(ML, DM, G, (int)blockIdx.x);
          pg8::Epi8<pg8::FGateA> E{{(const pg8::bf16_t*)(ws + WS_P) + OFF_BGA, NP, (const float*)(ws + WS_T), (pg8::bf16_t*)(ws + WS_YG), DM}};
          pg8::gemm_phase<pg8::Epi8<pg8::FGateA>, pg8::StaticOrder, true, true>(lds + RING_OFF, g, S, E); }
    } SEAM(6);
    if (IN(7)) {
        pg8::Gemm g{(const pg8::bf16_t*)(ws + WS_YG), (const pg8::bf16_t*)(ws + WS_WO), ML, DM, DM}; pg8::StaticOrder S; S.init(ML, DM, G, (int)blockIdx.x);
        pg8::Epi8<pg8::FF32> E{{(float*)(ws + WS_MIX), DM}};
        pg8::gemm_phase<pg8::Epi8<pg8::FF32>, pg8::StaticOrder, true, true>(lds + RING_OFF, g, S, E);
    } SEAM(7);
    if (IN(8)) { p8_rows(args, lane, wave, G); } SEAM(8);
    if (IN(9)) {
        pg8::Gemm g{(const pg8::bf16_t*)(ws + WS_U2), (const pg8::bf16_t*)(ws + WS_WF1), ML, DFF, DM}; pg8::StaticOrder S; S.init(ML, DFF, G, (int)blockIdx.x);
        pg8::Epi8<pg8::FRelu2> E{{(pg8::bf16_t*)(ws + WS_HDN), DFF}};
        pg8::gemm_phase<pg8::Epi8<pg8::FRelu2>, pg8::StaticOrder, true, true>(lds + RING_OFF, g, S, E);
    } SEAM(9);
    if (IN(10)) {
        pg8::Gemm g{(const pg8::bf16_t*)(ws + WS_HDN), (const pg8::bf16_t*)(ws + WS_WF2), ML, DM, DFF}; pg8::StaticOrder S; S.init(ML, DM, G, (int)blockIdx.x);
        pg8::Epi8<pg8::FF32> E{{(float*)(ws + WS_F), DM}};
        pg8::gemm_phase<pg8::Epi8<pg8::FF32>, pg8::StaticOrder, true, true>(lds + RING_OFF, g, S, E);
    } SEAM(10);
    if (IN(11)) {
        const bool poison = (N_LAUNCHES == 1) && (__hip_atomic_load(ctl + CW_BAR + XB_TMO, RLX_AGENT) != 0u);
        p11_rows(args, lane, wave, G, poison);
    }
#undef IN
#undef SEAM
}

extern "C" void kernel_launch(void* const* d_in, const int* in_sizes, int n_in, void* d_out, int out_size, void* d_ws, size_t ws_size, hipStream_t stream) {
    static int grid = 0;
    if (grid == 0) {
        if (n_in != 16 || out_size != ML * DM || ws_size < WS_END) { fprintf(stderr, "kernel_launch: unexpected shapes: n_in %d out %d ws %zu (need %zu); nothing launched\n", n_in, out_size, ws_size, (size_t)WS_END); grid = -1; return; }
        int dev = 0, cus = 0, per_cu = 0;
        if (hipGetDevice(&dev) != hipSuccess || hipDeviceGetAttribute(&cus, hipDeviceAttributeMultiprocessorCount, dev) != hipSuccess) { grid = -1; return; }
        if (hipFuncSetAttribute((const void*)fwd_kernel, hipFuncAttributeMaxDynamicSharedMemorySize, LDS_BYTES) != hipSuccess) { fprintf(stderr, "kernel_launch: hipFuncSetAttribute failed\n"); grid = -1; return; }
        if (hipOccupancyMaxActiveBlocksPerMultiprocessor(&per_cu, (const void*)fwd_kernel, NWAVES * 64, LDS_BYTES) != hipSuccess || per_cu < 1)
            fprintf(stderr, "kernel_launch: note: occupancy query reports %d workgroups per CU\n", per_cu);
        (void)hipGetLastError();
        grid = cus;
    }
    if (grid < 0) return;
    if (hipMemsetAsync((char*)d_ws + WS_CTL, 0, CTL_ZERO_BYTES, stream) != hipSuccess) { fprintf(stderr, "kernel_launch: memset failed\n"); return; }
    Args a{};
    for (int i = 0; i < 16; ++i) a.in[i] = (const float*)d_in[i];
    a.out = (float*)d_out; a.ws = (unsigned char*)d_ws;
    for (int li = 0; li < N_LAUNCHES; ++li) {
        a.ph_lo = (N_LAUNCHES == 1) ? 0 : li; a.ph_hi = (N_LAUNCHES == 1) ? N_PHASES : li + 1;
        hipLaunchKernelGGL(fwd_kernel, dim3(grid), dim3(NWAVES * 64), LDS_BYTES, stream, a);
        const hipError_t le = hipPeekAtLastError();
        if (le != hipSuccess) { fprintf(stderr, "kernel_launch: launch %d failed: %s\n", li, hipGetErrorName(le)); break; }
    }
}
```

```cpp
#define MK_N_LAUNCHES 1
#include <hip/hip_runtime.h>
#include <cstdio>
#include <cstdint>
namespace pg8 {
#define PG8_LAS __attribute__((address_space(3)))
typedef unsigned short bf16_t;
typedef short bf16x8 __attribute__((ext_vector_type(8)));
typedef float f32x4 __attribute__((ext_vector_type(4)));
typedef unsigned u32x4 __attribute__((ext_vector_type(4)));
constexpr int BM = 256, BK = 64, HALF = 128, HTB = HALF * BK * 2  , STAGE_BYTES = 8 * HTB, NXCD = 8, WGM = 8;

__host__ __device__ __forceinline__ int lds_byte(int r, int c) { const int st = (r >> 4) * 2 + (c >> 5), rr = r & 15, cc = c & 31, ob = rr * 64 + cc * 2; return st * 1024 + (ob ^ (((ob >> 9) & 1) << 5)); }
__host__ __device__ __forceinline__ void stage_rc(int b, int& R, int& C) { const int st = b / 1024, sb = b % 1024, swz = sb ^ (((sb >> 9) & 1) << 5); R = (st >> 1) * 16 + swz / 64; C = (st & 1) * 32 + (swz % 64) / 2; }
__host__ __device__ __forceinline__ int perm32(int rho) { const int n = rho >> 4, i = rho & 15; return 8 * (i >> 2) + 4 * n + (i & 3); }

struct Unit { int pm, pn; };
struct Gemm { const bf16_t* A; const bf16_t* Bt; int M, N, K, lda, ldb; };

struct StaticOrder {
    int nM, nN, nwg, G, c;
    __host__ __device__ void init(int M, int N, int G_, int c_) { nM = M / BM; nN = N / BM; nwg = nM * nN; G = G_; c = c_; }
    __host__ __device__ bool next(int i, Unit& u) const { return at((long)i * G + c, u); }
    __host__ __device__ bool at(const long L, Unit& u) const {
        if (L >= nwg) return false;
        int wgid = (int)L; { const int q = nwg / NXCD, r = nwg % NXCD, xcd = wgid % NXCD, off = wgid / NXCD; wgid = (xcd < r ? xcd * (q + 1) : r * (q + 1) + (xcd - r) * q) + off; }
        const int nig = WGM * nN, gid = wgid / nig, fm = gid * WGM, gsz = (nM - fm) < WGM ? (nM - fm) : WGM;
        u.pm = fm + ((wgid % nig) % gsz); u.pn = (wgid % nig) / gsz; return true;
    }
    __device__ __forceinline__ void a_ready(const Unit&) const {}
    __device__ __forceinline__ void done(const Unit&) const {}
};

__device__ __forceinline__ unsigned cvt_pk_bf16(float lo, float hi) { unsigned r; asm volatile("v_cvt_pk_bf16_f32 %0, %1, %2" : "=v"(r) : "v"(lo), "v"(hi)); return r; }
typedef float f32x2 __attribute__((ext_vector_type(2)));

__device__ __forceinline__ float bf_lo(unsigned w) { return __builtin_bit_cast(float, w << 16); }
__device__ __forceinline__ float bf_hi(unsigned w) { return __builtin_bit_cast(float, w & 0xffff0000u); }
__device__ __forceinline__ float sigmoidf_(float x) { return __builtin_amdgcn_rcpf(1.0f + __expf(-x)); }
template <class F> struct Epi8 {
    static constexpr bool PERM = true, AFTER_DRAIN = false;
    F f;
    __device__ __forceinline__ void operator()(const f32x4 (&acc)[2][2][4][2], const Unit& u, int wr, int wc, int fr, int fq) const {
        const int row0 = u.pm * BM + wr * 64 + fr, col0 = u.pn * BM + wc * 32 + 8 * fq;
#pragma unroll
        for (int ai = 0; ai < 2; ++ai)
#pragma unroll
            for (int m = 0; m < 4; ++m) { const int row = row0 + ai * HALF + m * 16;
#pragma unroll
                for (int bj = 0; bj < 2; ++bj) f(row, col0 + bj * HALF, acc[ai][bj][m][0], acc[ai][bj][m][1], u.pn); }
    }
};
struct EpiSt { u32x4* p; u32x4 v; };
template <class F> struct Epi8B {
    static constexpr bool PERM = true, AFTER_DRAIN = false;
    F f;
    __device__ __forceinline__ void operator()(const f32x4 (&acc)[2][2][4][2], const Unit& u, int wr, int wc, int fr, int fq) const {
        const int row0 = u.pm * BM + wr * 64 + fr, col0 = u.pn * BM + wc * 32 + 8 * fq;
#pragma unroll
        for (int ai = 0; ai < 2; ++ai) {
            decltype(f.calc(0, 0, acc[0][0][0][0], acc[0][0][0][1], 0)) st[4][2];
#pragma unroll
            for (int m = 0; m < 4; ++m)
#pragma unroll
                for (int bj = 0; bj < 2; ++bj) st[m][bj] = f.calc(row0 + ai * HALF + m * 16, col0 + bj * HALF, acc[ai][bj][m][0], acc[ai][bj][m][1], u.pn);
#pragma unroll
            for (int m = 0; m < 4; ++m)
#pragma unroll
                for (int bj = 0; bj < 2; ++bj) f.put(st[m][bj]);
        }
    }
};
__device__ __forceinline__ u32x4 pack8(const f32x4& v0, const f32x4& v1) { u32x4 w; w.x = cvt_pk_bf16(v0[0], v0[1]); w.y = cvt_pk_bf16(v0[2], v0[3]); w.z = cvt_pk_bf16(v1[0], v1[1]); w.w = cvt_pk_bf16(v1[2], v1[3]); return w; }
struct FProj { bf16_t* P; float* G; const float* ROT; int ldp; int gate_pn;
    __device__ __forceinline__ void operator()(int row, int col, const f32x4& v0, const f32x4& v1, int pn) const {
        if (pn == gate_pn) { const int cl = col - gate_pn * BM; if (cl < 32) { *(f32x4*)(G + (size_t)row * 32 + cl) = v0; *(f32x4*)(G + (size_t)row * 32 + cl + 4) = v1; } }
        else if (pn < 8) *(u32x4*)(P + (size_t)row * ldp + col) = pack8(v0 * 0.0625f, v1 * 0.0625f);
        else if (pn >= 48 && pn < 68 && row < 8192) { const int hp = col & 127, t = row & 2047, pos = (hp & 64) ? (t & 63) : (t >> 6), i0 = (hp & 63) >> 1;
            const f32x4 cs = *(const f32x4*)(ROT + pos * 32 + i0), sn = *(const f32x4*)(ROT + 2048 + pos * 32 + i0);
            *(u32x4*)(P + (size_t)row * ldp + col) = pack8(v0 * cs - v1 * sn, v0 * sn + v1 * cs); }
        else *(u32x4*)(P + (size_t)row * ldp + col) = pack8(v0, v1);
    } };
struct ProjOrder {
    StaticOrder base; int G, c;
    __host__ __device__ void init(int G_, int c_) { base.init(8192, 17 * 256, G_, c_); G = G_; c = c_; }
    __host__ __device__ bool next(int i, Unit& u) const { const long L = (long)i * G + c;
        if (L < base.nwg) { base.next(i, u); if (u.pn == 16) u.pn = 104; return true; }
        const int r = (int)(L - base.nwg); if (r >= 4 * 9) return false; u.pm = 32 + (r & 3); const int j = r >> 2; u.pn = j < 8 ? 8 + j : 104; return true; }
    __device__ __forceinline__ void a_ready(const Unit&) const {}
    __device__ __forceinline__ void done(const Unit&) const {}
};
struct ProjOrderI8 {
    StaticOrder base; int G, c, nheavy, qh;
    __host__ __device__ void init(int G_, int c_, int n_bf16_units) { base.init(8192, 88 * 256, G_, 0); G = G_; c = c_; nheavy = n_bf16_units % G_;
        const int ni = base.nwg + 4 * 24; int q = (ni - 2 * (G_ - nheavy) + G_ - 1) / G_; qh = q < 0 ? 0 : q; }
    __host__ __device__ bool next(int i, Unit& u) const {
        long L; if (i < qh) L = (long)i * G + c; else { if (c < nheavy) return false; L = (long)qh * G + (long)(i - qh) * (G - nheavy) + (c - nheavy); }
        if (L < base.nwg) { base.at(L, u); u.pn += 8; return true; }
        const int r = (int)(L - base.nwg); if (r >= 4 * 24) return false; u.pm = 32 + (r & 3); const int j = r >> 2; u.pn = j < 16 ? 8 + j : 40 + j; return true; }
    __device__ __forceinline__ void a_ready(const Unit&) const {}
    __device__ __forceinline__ void done(const Unit&) const {}
};
__device__ __forceinline__ float i2f(float bits) { return (float)__builtin_bit_cast(int, bits); }
__device__ __forceinline__ f32x4 i2f4(const f32x4& v) { return (f32x4){i2f(v[0]), i2f(v[1]), i2f(v[2]), i2f(v[3])}; }
struct FProjI8 { bf16_t* P; const float* rs; const float* cs; const float* ROT; int ldp; int off_a;
    __device__ __forceinline__ void put(const EpiSt& s_) const { *s_.p = s_.v; }
    __device__ __forceinline__ EpiSt calc(int row, int col, const f32x4& v0, const f32x4& v1, int pn) const {
        const float r = rs[row]; const f32x4 c0 = *(const f32x4*)(cs + col) * r, c1 = *(const f32x4*)(cs + col + 4) * r;
        f32x4 a = i2f4(v0) * c0, b = i2f4(v1) * c1;
        const int oc = off_a + col;
        if (pn >= 40 && pn < 60 && row < 8192) { const int hp = oc & 127, t = row & 2047, pos = (hp & 64) ? (t & 63) : (t >> 6), i0 = (hp & 63) >> 1;
            const f32x4 csn = *(const f32x4*)(ROT + pos * 32 + i0), sn = *(const f32x4*)(ROT + 2048 + pos * 32 + i0);
            const f32x4 ra = a * csn - b * sn, rb = a * sn + b * csn; a = ra; b = rb; }
        return EpiSt{(u32x4*)(P + (size_t)row * ldp + oc), pack8(a, b)};
    } };
struct FGateM { const bf16_t* Pg; int ldp; bf16_t* T; int ldt;
    __device__ __forceinline__ void operator()(int row, int col, const f32x4& v0, const f32x4& v1, int) const {
        const u32x4 g = *(const u32x4*)(Pg + (size_t)row * ldp + col);
        f32x4 a, b; a[0] = sigmoidf_(bf_lo(g.x)) * v0[0]; a[1] = sigmoidf_(bf_hi(g.x)) * v0[1]; a[2] = sigmoidf_(bf_lo(g.y)) * v0[2]; a[3] = sigmoidf_(bf_hi(g.y)) * v0[3];
        b[0] = sigmoidf_(bf_lo(g.z)) * v1[0]; b[1] = sigmoidf_(bf_hi(g.z)) * v1[1]; b[2] = sigmoidf_(bf_lo(g.w)) * v1[2]; b[3] = sigmoidf_(bf_hi(g.w)) * v1[3];
        *(u32x4*)(T + (size_t)row * ldt + col) = pack8(a, b);
    } };
struct FGateA { const bf16_t* Pg; int ldp; const bf16_t* T; bf16_t* Y; int ldt, ldy;
    __device__ __forceinline__ void operator()(int row, int col, const f32x4& v0, const f32x4& v1, int) const {
        const u32x4 g = *(const u32x4*)(Pg + (size_t)row * ldp + col), t = *(const u32x4*)(T + (size_t)row * ldt + col);
        f32x4 a, b;
        a[0] = bf_lo(t.x) + sigmoidf_(bf_lo(g.x)) * v0[0]; a[1] = bf_hi(t.x) + sigmoidf_(bf_hi(g.x)) * v0[1]; a[2] = bf_lo(t.y) + sigmoidf_(bf_lo(g.y)) * v0[2]; a[3] = bf_hi(t.y) + sigmoidf_(bf_hi(g.y)) * v0[3];
        b[0] = bf_lo(t.z) + sigmoidf_(bf_lo(g.z)) * v1[0]; b[1] = bf_hi(t.z) + sigmoidf_(bf_hi(g.z)) * v1[1]; b[2] = bf_lo(t.w) + sigmoidf_(bf_lo(g.w)) * v1[2]; b[3] = bf_hi(t.w) + sigmoidf_(bf_hi(g.w)) * v1[3];
        *(u32x4*)(Y + (size_t)row * ldy + col) = pack8(a, b);
    } };
struct FGateM8 { const bf16_t* Pg; int ldp; bf16_t* T; int ldt; const float* rs; const float* cs;
    __device__ __forceinline__ void put(const EpiSt& s_) const { *s_.p = s_.v; }
    __device__ __forceinline__ EpiSt calc(int row, int col, const f32x4& v0, const f32x4& v1, int) const {
        const float r = rs[row]; const f32x4 c0 = *(const f32x4*)(cs + col) * r, c1 = *(const f32x4*)(cs + col + 4) * r;
        const u32x4 g = *(const u32x4*)(Pg + (size_t)row * ldp + col);
        f32x4 a, b; a[0] = sigmoidf_(bf_lo(g.x)) * i2f(v0[0]) * c0[0]; a[1] = sigmoidf_(bf_hi(g.x)) * i2f(v0[1]) * c0[1]; a[2] = sigmoidf_(bf_lo(g.y)) * i2f(v0[2]) * c0[2]; a[3] = sigmoidf_(bf_hi(g.y)) * i2f(v0[3]) * c0[3];
        b[0] = sigmoidf_(bf_lo(g.z)) * i2f(v1[0]) * c1[0]; b[1] = sigmoidf_(bf_hi(g.z)) * i2f(v1[1]) * c1[1]; b[2] = sigmoidf_(bf_lo(g.w)) * i2f(v1[2]) * c1[2]; b[3] = sigmoidf_(bf_hi(g.w)) * i2f(v1[3]) * c1[3];
        return EpiSt{(u32x4*)(T + (size_t)row * ldt + col), pack8(a, b)};
    } };
struct FGateA8 { const bf16_t* Pg; int ldp; const bf16_t* T; bf16_t* Y; int ldt, ldy; const float* rs; const float* cs;
    __device__ __forceinline__ void put(const EpiSt& s_) const { *s_.p = s_.v; }
    __device__ __forceinline__ EpiSt calc(int row, int col, const f32x4& v0, const f32x4& v1, int) const {
        const float r = rs[row]; const f32x4 c0 = *(const f32x4*)(cs + col) * r, c1 = *(const f32x4*)(cs + col + 4) * r;
        const u32x4 g = *(const u32x4*)(Pg + (size_t)row * ldp + col), t = *(const u32x4*)(T + (size_t)row * ldt + col);
        f32x4 a, b;
        a[0] = bf_lo(t.x) + sigmoidf_(bf_lo(g.x)) * i2f(v0[0]) * c0[0]; a[1] = bf_hi(t.x) + sigmoidf_(bf_hi(g.x)) * i2f(v0[1]) * c0[1]; a[2] = bf_lo(t.y) + sigmoidf_(bf_lo(g.y)) * i2f(v0[2]) * c0[2]; a[3] = bf_hi(t.y) + sigmoidf_(bf_hi(g.y)) * i2f(v0[3]) * c0[3];
        b[0] = bf_lo(t.z) + sigmoidf_(bf_lo(g.z)) * i2f(v1[0]) * c1[0]; b[1] = bf_hi(t.z) + sigmoidf_(bf_hi(g.z)) * i2f(v1[1]) * c1[1]; b[2] = bf_lo(t.w) + sigmoidf_(bf_lo(g.w)) * i2f(v1[2]) * c1[2]; b[3] = bf_hi(t.w) + sigmoidf_(bf_hi(g.w)) * i2f(v1[3]) * c1[3];
        return EpiSt{(u32x4*)(Y + (size_t)row * ldy + col), pack8(a, b)};
    } };
struct FF32 { float* C; int ldc;
    __device__ __forceinline__ void operator()(int row, int col, const f32x4& v0, const f32x4& v1, int) const { *(f32x4*)(C + (size_t)row * ldc + col) = v0; *(f32x4*)(C + (size_t)row * ldc + col + 4) = v1; } };
struct FBf16 { bf16_t* O; int ldc;
    __device__ __forceinline__ void operator()(int row, int col, const f32x4& v0, const f32x4& v1, int) const { *(u32x4*)(O + (size_t)row * ldc + col) = pack8(v0, v1); } };
struct FRelu2I8 { bf16_t* O; const float* rs; const float* cs; int ldc;
    __device__ __forceinline__ void put(const EpiSt& s_) const { *s_.p = s_.v; }
    __device__ __forceinline__ EpiSt calc(int row, int col, const f32x4& v0, const f32x4& v1, int) const {
        const float r = rs[row]; const f32x4 c0 = *(const f32x4*)(cs + col) * r, c1 = *(const f32x4*)(cs + col + 4) * r;
        f32x4 a = i2f4(v0) * c0, b = i2f4(v1) * c1;
#pragma unroll
        for (int j = 0; j < 4; ++j) { a[j] = fmaxf(a[j], 0.f); b[j] = fmaxf(b[j], 0.f); }
        a = a * a; b = b * b;
        return EpiSt{(u32x4*)(O + (size_t)row * ldc + col), pack8(a, b)};
    } };
struct FRelu2 { bf16_t* O; int ldc;
    __device__ __forceinline__ void operator()(int row, int col, const f32x4& v0, const f32x4& v1, int) const {
        f32x4 a, b;
#pragma unroll
        for (int j = 0; j < 4; ++j) { const float x = fmaxf(v0[j], 0.f), y = fmaxf(v1[j], 0.f); a[j] = x * x; b[j] = y * y; }
        *(u32x4*)(O + (size_t)row * ldc + col) = pack8(a, b);
    } };

typedef int i32x4 __attribute__((ext_vector_type(4)));
template <bool I8> __device__ __forceinline__ f32x4 mma16(const bf16x8& b, const bf16x8& a, const f32x4& c) {
    if constexpr (I8) return __builtin_bit_cast(f32x4, __builtin_amdgcn_mfma_i32_16x16x64_i8(__builtin_bit_cast(i32x4, b), __builtin_bit_cast(i32x4, a), __builtin_bit_cast(i32x4, c), 0, 0, 0));
    else return __builtin_amdgcn_mfma_f32_16x16x32_bf16(b, a, c, 0, 0, 0);
}
template <class Epi, class Sched, bool ALIGN_EPI = false, bool SP2 = false, bool I8 = false>
__device__ __forceinline__ void gemm_phase(PG8_LAS unsigned char* lds, const Gemm g, const Sched& S, const Epi& E, const int wave_id) {
    const int lane = (int)__builtin_amdgcn_mbcnt_hi(~0u, __builtin_amdgcn_mbcnt_lo(~0u, 0u)), wid = wave_id, tid = wid * 64 + lane,
              wr = wid >> 2, wc = wid & 3, fr = lane & 15, fq = lane >> 4;
    const int K = g.K, nt = K / BK;
    unsigned voffA[2], voffB[2];
#pragma unroll
    for (int i = 0; i < 2; ++i) { int R, C; stage_rc(tid * 16 + i * 8192, R, C); const int Rb = Epi::PERM ? ((R & ~31) + perm32(R & 31)) : R;
        voffA[i] = (unsigned)(R * g.lda + C) * 2u; voffB[i] = (unsigned)(Rb * g.ldb + C) * 2u; }
    const size_t kstep = (size_t)(BK * 2);
    const size_t hstepA = (size_t)HALF * g.lda * 2, hstepB = (size_t)HALF * g.ldb * 2;
    const size_t tstepA = 2 * hstepA, tstepB = 2 * hstepB;
    const unsigned ldsw = (unsigned)wid * 1024u;
    const int aoff = lds_byte(wr * 64 + fr, fq * 8), boff = lds_byte(wc * 32 + fr, fq * 8);
#define PG8_SA(b, h) (((b) * 2 + (h)) * HTB)
#define PG8_SB(b, h) ((4 + (b) * 2 + (h)) * HTB)
#define PG8_STAGE(bufoff, gbase, voff) do { _Pragma("unroll") for (int _i = 0; _i < 2; ++_i) \
        __builtin_amdgcn_global_load_lds((const unsigned*)((const char*)(gbase) + (voff)[_i]), (PG8_LAS unsigned*)(lds + (bufoff) + ldsw + _i * 8192), 16, 0, 0); } while (0)
#define PG8_LDA(dst, b, h) do { _Pragma("unroll") for (int m = 0; m < 4; ++m) _Pragma("unroll") for (int k = 0; k < 2; ++k) dst[m][k] = *(const PG8_LAS bf16x8*)(lds + PG8_SA(b, h) + aoff + m * 2048 + k * 1024); } while (0)
#define PG8_LDB(dst, b, h) do { _Pragma("unroll") for (int n = 0; n < 2; ++n) _Pragma("unroll") for (int k = 0; k < 2; ++k) dst[n][k] = *(const PG8_LAS bf16x8*)(lds + PG8_SB(b, h) + boff + n * 2048 + k * 1024); } while (0)
#define PG8_MMA(ai, bj, At, Bt) do { __builtin_amdgcn_s_setprio(1); _Pragma("unroll") for (int m = 0; m < 4; ++m) _Pragma("unroll") for (int n = 0; n < 2; ++n) _Pragma("unroll") for (int k = 0; k < 2; ++k) \
        acc[ai][bj][m][n] = mma16<I8>(Bt[n][k], At[m][k], acc[ai][bj][m][n]); __builtin_amdgcn_s_setprio(0); } while (0)
#define PG8_WAIT_V(n) asm volatile("s_waitcnt vmcnt(" #n ")" ::: "memory")
#define PG8_WAIT_L(n) asm volatile("s_waitcnt lgkmcnt(" #n ")" ::: "memory")
#define PG8_BAR __builtin_amdgcn_s_barrier()
#define PG8_SCHED __builtin_amdgcn_sched_barrier(0)
    Unit cur, nxt; int ui = 0;
    if (!S.next(0, cur)) return;
    f32x4 acc[2][2][4][2];
#pragma unroll
    for (int a = 0; a < 2; ++a)
#pragma unroll
        for (int b = 0; b < 2; ++b)
#pragma unroll
            for (int m = 0; m < 4; ++m)
#pragma unroll
                for (int n = 0; n < 2; ++n) acc[a][b][m][n] = (f32x4){0.f, 0.f, 0.f, 0.f};
    bf16x8 At[4][2], B0[2][2], B1[2][2];
    const char* cA = (const char*)g.A + (size_t)cur.pm * tstepA; const char* cB = (const char*)g.Bt + (size_t)cur.pn * tstepB;
    S.a_ready(cur);
    if constexpr (SP2) {
        PG8_STAGE(PG8_SB(0, 0), cB, voffB); PG8_STAGE(PG8_SB(0, 1), cB + hstepB, voffB); PG8_STAGE(PG8_SA(0, 0), cA, voffA); PG8_STAGE(PG8_SA(0, 1), cA + hstepA, voffA);
        if (wr == 1) PG8_BAR;
        PG8_WAIT_V(2); PG8_BAR;
        PG8_STAGE(PG8_SB(1, 0), cB + kstep, voffB); PG8_STAGE(PG8_SA(1, 0), cA + kstep, voffA); PG8_STAGE(PG8_SB(1, 1), cB + hstepB + kstep, voffB);
        PG8_WAIT_V(6); PG8_BAR;
    } else {
        PG8_STAGE(PG8_SB(0, 0), cB, voffB); PG8_STAGE(PG8_SA(0, 0), cA, voffA); PG8_STAGE(PG8_SB(0, 1), cB + hstepB, voffB); PG8_STAGE(PG8_SA(0, 1), cA + hstepA, voffA);
        if (wr == 1) PG8_BAR;
        PG8_WAIT_V(4); PG8_BAR;
        PG8_STAGE(PG8_SB(1, 0), cB + kstep, voffB); PG8_STAGE(PG8_SA(1, 0), cA + kstep, voffA); PG8_STAGE(PG8_SB(1, 1), cB + hstepB + kstep, voffB);
        PG8_WAIT_V(6); PG8_BAR;
    }
    for (;;) {
        const bool has_next = S.next(ui + 1, nxt);
        const char* nA = has_next ? (const char*)g.A + (size_t)nxt.pm * tstepA : cA; const char* nB = has_next ? (const char*)g.Bt + (size_t)nxt.pn * tstepB : cB;
        for (int t = 0; t < nt; t += 2) {
            const bool last = (t == nt - 2);
            const char* a1 = cA + (size_t)(t + 1) * kstep;
            const char* a2 = last ? nA : cA + (size_t)(t + 2) * kstep; const char* b2 = last ? nB : cB + (size_t)(t + 2) * kstep;
            const char* a3 = a2 + kstep; const char* b3 = b2 + kstep;
            if (last && has_next) S.a_ready(nxt);
            if constexpr (SP2) {
            PG8_LDB(B0, 0, 0); PG8_LDB(B1, 0, 1); PG8_SCHED; PG8_LDA(At, 0, 0); PG8_STAGE(PG8_SA(1, 1), a1 + hstepA, voffA);
            PG8_WAIT_V(8); PG8_WAIT_L(0); PG8_BAR; PG8_MMA(0, 0, At, B0); PG8_MMA(0, 1, At, B1); PG8_BAR; PG8_SCHED;
            PG8_LDA(At, 0, 1); PG8_STAGE(PG8_SB(0, 0), b2, voffB); PG8_STAGE(PG8_SB(0, 1), b2 + hstepB, voffB); PG8_STAGE(PG8_SA(0, 0), a2, voffA);
            PG8_WAIT_V(8); PG8_WAIT_L(0); PG8_BAR; PG8_MMA(1, 0, At, B0); PG8_MMA(1, 1, At, B1); PG8_BAR; PG8_SCHED;
            PG8_LDB(B0, 1, 0); PG8_LDB(B1, 1, 1); PG8_SCHED; PG8_LDA(At, 1, 0); PG8_STAGE(PG8_SA(0, 1), a2 + hstepA, voffA);
            PG8_WAIT_V(8); PG8_WAIT_L(0); PG8_BAR; PG8_MMA(0, 0, At, B0); PG8_MMA(0, 1, At, B1); PG8_BAR; PG8_SCHED;
            PG8_LDA(At, 1, 1); PG8_STAGE(PG8_SB(1, 0), b3, voffB); PG8_STAGE(PG8_SB(1, 1), b3 + hstepB, voffB); PG8_STAGE(PG8_SA(1, 0), a3, voffA);
            PG8_WAIT_V(8); PG8_WAIT_L(0); PG8_BAR; PG8_MMA(1, 0, At, B0); PG8_MMA(1, 1, At, B1); PG8_BAR; PG8_SCHED;
            } else {
            PG8_LDB(B0, 0, 0); PG8_SCHED; PG8_LDA(At, 0, 0); PG8_STAGE(PG8_SA(1, 1), a1 + hstepA, voffA);
            PG8_WAIT_L(8); PG8_BAR; PG8_WAIT_L(0); PG8_MMA(0, 0, At, B0); PG8_BAR; PG8_SCHED;
            PG8_LDB(B1, 0, 1); PG8_STAGE(PG8_SB(0, 0), b2, voffB);
            PG8_BAR; PG8_WAIT_L(0); PG8_MMA(0, 1, At, B1); PG8_BAR;
            PG8_LDA(At, 0, 1); PG8_STAGE(PG8_SA(0, 0), a2, voffA);
            PG8_BAR; PG8_WAIT_L(0); PG8_MMA(1, 0, At, B0); PG8_BAR; PG8_SCHED;
            PG8_STAGE(PG8_SB(0, 1), b2 + hstepB, voffB);
            PG8_WAIT_V(6); PG8_BAR; PG8_MMA(1, 1, At, B1); PG8_BAR;
            PG8_LDB(B0, 1, 0); PG8_SCHED; PG8_LDA(At, 1, 0); PG8_STAGE(PG8_SA(0, 1), a2 + hstepA, voffA);
            PG8_WAIT_L(8); PG8_BAR; PG8_WAIT_L(0); PG8_MMA(0, 0, At, B0); PG8_BAR; PG8_SCHED;
            PG8_LDB(B1, 1, 1); PG8_STAGE(PG8_SB(1, 0), b3, voffB);
            PG8_BAR; PG8_WAIT_L(0); PG8_MMA(0, 1, At, B1); PG8_BAR;
            PG8_LDA(At, 1, 1); PG8_STAGE(PG8_SA(1, 0), a3, voffA);
            PG8_BAR; PG8_WAIT_L(0); PG8_MMA(1, 0, At, B0); PG8_BAR; PG8_SCHED;
            PG8_STAGE(PG8_SB(1, 1), b3 + hstepB, voffB);
            PG8_WAIT_V(6); PG8_BAR; PG8_MMA(1, 1, At, B1); PG8_BAR;
            }
        }
        if constexpr (ALIGN_EPI) { if (wr == 0) PG8_BAR; }
        if constexpr (!Epi::AFTER_DRAIN) { E(acc, cur, wr, wc, fr, fq); S.done(cur); }
        if (!has_next) break;
#pragma unroll
        for (int a = 0; a < 2; ++a)
#pragma unroll
            for (int b = 0; b < 2; ++b)
#pragma unroll
                for (int m = 0; m < 4; ++m)
#pragma unroll
                    for (int n = 0; n < 2; ++n) acc[a][b][m][n] = (f32x4){0.f, 0.f, 0.f, 0.f};
        cur = nxt; cA = nA; cB = nB; ++ui;
        if constexpr (ALIGN_EPI) { if (wr == 1) PG8_BAR; }
    }
    PG8_WAIT_V(0);
    if constexpr (!ALIGN_EPI) { if (wr == 0) PG8_BAR; }
    PG8_BAR;
    if constexpr (Epi::AFTER_DRAIN) { E.fused(acc, cur, wr, wc, fr, fq, lds, wid, lane); S.done(cur); }
#undef PG8_SA
#undef PG8_SB
#undef PG8_STAGE
#undef PG8_LDA
#undef PG8_LDB
#undef PG8_MMA
#undef PG8_WAIT_V
#undef PG8_WAIT_L
#undef PG8_BAR
#undef PG8_SCHED
}
}

constexpr int NWAVES = 8;
#ifndef MK_N_LAUNCHES
#define MK_N_LAUNCHES 1
#endif
constexpr int N_PHASES = 11;
constexpr int N_LAUNCHES = MK_N_LAUNCHES;
static_assert(N_LAUNCHES == 1 || N_LAUNCHES == N_PHASES, "MK_N_LAUNCHES is 1 or N_PHASES");

constexpr int DM = 4096, NB = 4, SEQ = 2048, CTXL = 256, ML = NB * SEQ, MC = NB * CTXL, MT = ML + MC;
constexpr int DFF = 16384, NMOD = 6 * DM;
constexpr int PK = DM + 64, PF = DFF + 64;
constexpr int NPW = 26656, NP = 26880;
constexpr int OFF_QM = 0, OFF_KM = 2048, OFF_VM = 4096, OFF_OM = 8192, OFF_QA = 12288, OFF_KA = 16384, OFF_VA = 17408, OFF_BGM = 18432, OFF_BGA = 22528, OFF_GM = 26624;
constexpr int MH = 8, DQK = 256, DV = 512, AH = 32, AKV = 8, AD = 128, WIN = 128;
constexpr float EPS = 1e-6f;

constexpr size_t MiB = 1u << 20;
constexpr size_t WS_CTL = 0, CTL_ZERO_BYTES = 1 * MiB;
constexpr size_t WS_MOD = 1 * MiB, WS_ROT = WS_MOD + 512 * 1024, WS_RS1 = WS_ROT + 64 * 1024;
constexpr size_t WS_WIN = 2 * MiB, WS_WOM = 216 * MiB, WS_WOA = 249 * MiB, WS_WO = 282 * MiB, WS_WF1 = 315 * MiB, WS_WF2 = 445 * MiB;
constexpr size_t WS_U = 574 * MiB;
constexpr size_t WS_P = 648 * MiB;
constexpr size_t WS_G = 1121 * MiB;
constexpr size_t WS_HM = 1123 * MiB, WS_AT = 1188 * MiB;
constexpr size_t WS_MIX = 1253 * MiB, WS_HB = 1381 * MiB;
constexpr int P8 = DM + 128;
constexpr int N8P = 24576;
constexpr size_t WS_U8 = 1445 * MiB, WS_W8G = 1483 * MiB, WS_W8F = 1582 * MiB, WS_U28 = WS_AT, WS_END = 1648 * MiB;
constexpr size_t WS_RSU = WS_ROT + 128 * 1024, WS_RS2 = WS_ROT + 192 * 1024, WS_CSG = WS_ROT + 224 * 1024, WS_CSF = WS_ROT + 320 * 1024;
constexpr size_t WS_HM8 = 130 * MiB, WS_AT8 = WS_U8;
constexpr size_t WS_W8OM = WS_HM, WS_W8OA = WS_HM + 17 * MiB, WS_END2 = WS_END;
constexpr size_t WS_RSHM = WS_ROT + 384 * 1024, WS_RSAT = WS_ROT + 416 * 1024, WS_CSOM = WS_ROT + 448 * 1024, WS_CSOA = WS_ROT + 464 * 1024, WS_CMAXO = 768 * 1024;
static_assert(WS_W8OM + (size_t)DM * P8 <= WS_W8OA && WS_W8OA + (size_t)DM * P8 <= WS_AT && WS_CSF + DFF * 4 <= WS_RSHM && WS_CSOA + DM * 4 <= WS_WIN && WS_CMAXO + 2 * DM * 4 <= CTL_ZERO_BYTES, "ws map int8 out");
constexpr size_t WS_CMAXG = 256 * 1024, WS_CMAXF = 512 * 1024;
static_assert(WS_U8 + (size_t)MT * P8 <= WS_W8G && WS_W8G + (size_t)N8P * P8 <= WS_W8F && WS_CSG + N8P * 4 <= WS_CSF && WS_RS2 + ML * 4 <= WS_CSG && WS_RSU + MT * 4 <= WS_RS2 && WS_W8F + (size_t)DFF * P8 <= WS_END && WS_U28 + (size_t)ML * P8 <= WS_MIX && WS_CSF + DFF * 4 <= WS_WIN, "ws map int8");
constexpr size_t WS_HF = 2 * MiB, WS_T = 2 * MiB, WS_U2 = 130 * MiB;
constexpr size_t WS_YG = WS_U, WS_HDN = WS_P, WS_F = WS_MIX + 64 * MiB;
static_assert(WS_WIN + (size_t)NP * PK * 2 <= WS_WOM && WS_WOM + (size_t)DM * PK * 2 <= WS_WOA && WS_WOA + (size_t)DM * PK * 2 <= WS_WO && WS_WO + (size_t)DM * PK * 2 <= WS_WF1 && WS_WF1 + (size_t)DFF * PK * 2 <= WS_WF2 && WS_WF2 + (size_t)DM * PF * 2 <= WS_U, "ws map: weights");
static_assert(WS_U + (size_t)MT * PK * 2 <= WS_P && WS_P + (size_t)MT * NP * 2 <= WS_G && WS_G + (size_t)MT * 32 * 4 <= WS_HM && WS_HM + (size_t)ML * PK * 2 <= WS_AT && WS_AT + (size_t)ML * PK * 2 <= WS_MIX && WS_F + (size_t)ML * DM * 2 <= WS_HB && WS_HB + (size_t)ML * DM * 2 <= WS_END, "ws map");
static_assert(WS_T + (size_t)ML * DM * 4 <= WS_U2 && WS_U2 + (size_t)ML * PK * 2 <= WS_WOM && WS_HDN + (size_t)ML * PF * 2 <= WS_G && WS_YG + (size_t)ML * PK * 2 <= WS_P, "ws map overlays");
constexpr int CW_BAR = 4096;

constexpr int RING_OFF = 0, RING_BYTES = 131072;
constexpr int LDSCTL_OFF = RING_BYTES, MISC_OFF = LDSCTL_OFF + 320;
constexpr int LDS_BYTES = 147456;
static_assert(MISC_OFF + 128 <= LDS_BYTES, "LDS map");
#define GAS __attribute__((address_space(1)))
#define LAS __attribute__((address_space(3)))
typedef unsigned short bf16;
typedef unsigned v4u __attribute__((ext_vector_type(4)));
typedef float f32x4 __attribute__((ext_vector_type(4)));
typedef short bf16x8 __attribute__((ext_vector_type(8)));
typedef GAS unsigned gu32;
typedef GAS unsigned long long gu64;
#define RLX_AGENT __ATOMIC_RELAXED, __HIP_MEMORY_SCOPE_AGENT
#define LDS_WAIT() asm volatile("s_waitcnt lgkmcnt(0)" ::: "memory")
#define VM_WAIT() asm volatile("s_waitcnt vmcnt(0)" ::: "memory")
__device__ __forceinline__ unsigned long long rt() { return __builtin_amdgcn_s_memrealtime(); }
__device__ __forceinline__ unsigned f2bf(float f) { unsigned u = __builtin_bit_cast(unsigned, f); return (u + 0x7fffu + ((u >> 16) & 1u)) >> 16; }
typedef __bf16 pk2_bf2 __attribute__((ext_vector_type(2)));
typedef float pk2_f2 __attribute__((ext_vector_type(2)));
__device__ __forceinline__ unsigned pk2(float lo, float hi) { pk2_f2 v = {lo, hi}; return __builtin_bit_cast(unsigned, __builtin_convertvector(v, pk2_bf2)); }

#define XB_TMO      128
#define XB_XCNT(j)  (256  + 64 * (j))
#define XB_XSUB(j)  (1280 + 64 * (j))
#define XB_XGEN(j)  (2304 + 64 * (j))
#define XB_TOP      3328
#define XB_TOPGEN   3392
#define XCD_BAR_WORDS 3456
#define XB_SPIN_CAP (1u << 18)

__device__ __forceinline__ unsigned xb_ld(unsigned* p)              { return __hip_atomic_load(p, __ATOMIC_RELAXED, __HIP_MEMORY_SCOPE_AGENT); }
__device__ __forceinline__ unsigned xb_add(unsigned* p, unsigned v) { return __hip_atomic_fetch_add(p, v, __ATOMIC_RELAXED, __HIP_MEMORY_SCOPE_AGENT); }
__device__ __forceinline__ unsigned xb_xcc_id() { return (unsigned)__builtin_amdgcn_s_getreg((3 << 11) | 20) & 0xFu; }
#define XB_SPIN(cond, bar) do { unsigned _sp = 0; while (cond) { __builtin_amdgcn_s_sleep(1); \
    if ((++_sp & 255u) == 0u) { if (xb_ld(&(bar)[XB_TMO])) break; if (_sp > XB_SPIN_CAP) { atomicAdd(&(bar)[XB_TMO], 1u); break; } } } } while (0)

struct XcdBarrier {
    int wave;
    unsigned* bar; unsigned x;
    volatile LAS unsigned* st;
};

__device__ __forceinline__ bool xb_leader(int wave) { return wave == 0 && __builtin_amdgcn_mbcnt_hi(~0u, __builtin_amdgcn_mbcnt_lo(~0u, 0u)) == 0u; }
__device__ __forceinline__ XcdBarrier xcd_barrier_post(unsigned* bar, volatile LAS unsigned* st, int wave) {
    XcdBarrier b; b.wave = wave; b.bar = bar; b.x = xb_xcc_id(); b.st = st;
    if (xb_leader(wave)) (void)xb_add(&bar[XB_XCNT(b.x)], 1u);
    return b;
}
__device__ __forceinline__ void xcd_barrier_complete(unsigned* bar, unsigned x, unsigned& nloc, unsigned& nx) {
    const unsigned G = gridDim.x * gridDim.y * gridDim.z;
    unsigned sum, cnt, mine, sp = 0u;
    for (;;) {
        sum = 0u; cnt = 0u; mine = 0u;
#pragma unroll
        for (unsigned j = 0; j < 16; ++j) { const unsigned c = xb_ld(&bar[XB_XCNT(j)]); sum += c; cnt += (c > 0u) ? 1u : 0u; mine = (j == x) ? c : mine; }
        if (sum == G) break;
        __builtin_amdgcn_s_sleep(1);
        if ((++sp & 255u) == 0u) { if (xb_ld(&bar[XB_TMO])) break; if (sp > XB_SPIN_CAP) { atomicAdd(&bar[XB_TMO], 1u); break; } }
    }
    nloc = mine > 0u ? mine : 1u; nx = cnt > 0u ? cnt : 1u;
}

__device__ __forceinline__ void xcd_barrier(const XcdBarrier& b) {
    asm volatile("s_waitcnt vmcnt(0)" ::: "memory");
    __syncthreads();
    if (xb_leader(b.wave)) {
        unsigned* bar = b.bar;
        __builtin_amdgcn_s_waitcnt(0);
        unsigned nloc = b.st[0], nx = b.st[1];
        if (nloc == 0u) { xcd_barrier_complete(bar, b.x, nloc, nx); b.st[0] = nloc; b.st[1] = nx; }
        const unsigned old = xb_add(&bar[XB_XSUB(b.x)], 1u);
        const unsigned gen = old / nloc;
        if (old + 1u == (gen + 1u) * nloc) {
            __builtin_amdgcn_fence(__ATOMIC_RELEASE, "agent");
            asm volatile("s_waitcnt vmcnt(0)" ::: "memory");
            const unsigned og = xb_add(&bar[XB_TOP], 1u);
            const unsigned tg = og / nx;
            if (og + 1u == (tg + 1u) * nx) xb_add(&bar[XB_TOPGEN], 1u);
            else XB_SPIN(xb_ld(&bar[XB_TOPGEN]) == tg, bar);
            __builtin_amdgcn_fence(__ATOMIC_ACQUIRE, "agent");
            xb_add(&bar[XB_XGEN(b.x)], 1u);
            asm volatile("s_waitcnt vmcnt(0)" ::: "memory");
        } else {
            XB_SPIN(xb_ld(&bar[XB_XGEN(b.x)]) == gen, bar);
            __builtin_amdgcn_fence(__ATOMIC_ACQUIRE, "agent");
            asm volatile("s_waitcnt vmcnt(0)" ::: "memory");
        }
    }
    __syncthreads();
}

template <int CTRL> __device__ __forceinline__ float dppx(float v) { return __builtin_bit_cast(float, __builtin_amdgcn_update_dpp(0, __builtin_bit_cast(int, v), CTRL, 0xf, 0xf, true)); }
#define XSWAP(name, insn, comb) __device__ __forceinline__ float name(float x) { float a = x, b = x; asm("s_nop 1\n\t" insn " %0, %1" : "+v"(a), "+v"(b)); return comb; }
XSWAP(xsum16, "v_permlane16_swap_b32", a + b)
XSWAP(xsum32, "v_permlane32_swap_b32", a + b)
XSWAP(xmax16, "v_permlane16_swap_b32", fmaxf(a, b))
XSWAP(xmax32, "v_permlane32_swap_b32", fmaxf(a, b))
#undef XSWAP
__device__ __forceinline__ void rowbcast4(float x, float (&r)[4]) {
    float a = x, b = x; asm("s_nop 1\n\tv_permlane16_swap_b32 %0, %1" : "+v"(a), "+v"(b));
    float a0 = a, a2 = a; asm("s_nop 1\n\tv_permlane32_swap_b32 %0, %1" : "+v"(a0), "+v"(a2));
    float b1 = b, b3 = b; asm("s_nop 1\n\tv_permlane32_swap_b32 %0, %1" : "+v"(b1), "+v"(b3));
    r[0] = a0; r[1] = b1; r[2] = a2; r[3] = b3;
}
__device__ __forceinline__ float wave_sum(float v) {
    v += dppx<0xB1>(v); v += dppx<0x4E>(v); v += dppx<0x141>(v); v += dppx<0x140>(v);
    return xsum32(xsum16(v));
}
__device__ __forceinline__ float wave_max(float v) {
    v = fmaxf(v, dppx<0xB1>(v)); v = fmaxf(v, dppx<0x4E>(v)); v = fmaxf(v, dppx<0x141>(v)); v = fmaxf(v, dppx<0x140>(v));
    return xmax32(xmax16(v));
}
__device__ __forceinline__ float bf2f(bf16 b) { return __builtin_bit_cast(float, (unsigned)b << 16); }
__device__ __forceinline__ float bflo(unsigned w) { return __builtin_bit_cast(float, w << 16); }
typedef __bf16 bf16x2_d __attribute__((ext_vector_type(2)));
__device__ __forceinline__ float dot2bf(unsigned a, unsigned b, float c) { return __builtin_amdgcn_fdot2_f32_bf16(__builtin_bit_cast(bf16x2_d, a), __builtin_bit_cast(bf16x2_d, b), c, false); }
__device__ __forceinline__ float bfhi(unsigned w) { return __builtin_bit_cast(float, w & 0xffff0000u); }
__device__ __forceinline__ float sigm(float x) { return __builtin_amdgcn_rcpf(1.0f + __expf(-x)); }
__device__ __forceinline__ float logsig(float x) { return x < 0.f ? x - log1pf(expf(x)) : -log1pf(expf(-x)); }
__device__ __forceinline__ float logsig_fast(float x) { const float e = __expf(-fabsf(x)); return fminf(x, 0.f) - __logf(1.0f + e); }

#define BAR_LDS() do { asm volatile("s_waitcnt lgkmcnt(0)" ::: "memory"); __builtin_amdgcn_s_barrier(); asm volatile("" ::: "memory"); } while (0)
struct Args { const float* in[16]; float* out; unsigned char* ws; int ph_lo, ph_hi; };

__device__ __forceinline__ int win_map(int n0) { return n0 < 12288 ? n0 : (n0 < 12320 ? OFF_GM + (n0 - 12288) : n0 - 32); }


namespace ml {
typedef short s16x4 __attribute__((ext_vector_type(4)));
typedef short v4i16_t __attribute__((ext_vector_type(4)));
typedef unsigned v2u __attribute__((ext_vector_type(2)));
constexpr int QS = 528, KS = 544, VS = 288, S_PITCH = 144;
constexpr int Q_OFF = 0, K_OFF = Q_OFF + 64 * QS, V_OFF = K_OFF + 64 * KS, S_OFF = V_OFF + 64 * VS, NB_OFF = S_OFF + 64 * S_PITCH, NQ_OFF = NB_OFF + 1024, RS_OFF = NQ_OFF + 2048, WE_OFF = RS_OFF + 512, GG_OFF = WE_OFF + 256, MV_OFF = GG_OFF + 256, FAB_OFF = MV_OFF + 256;
static_assert(FAB_OFF + 8 * 512 <= 131072, "mLSTM LDS map");
__device__ __forceinline__ unsigned off_b(unsigned row, unsigned ch) { return 256u * row + 16u * (ch ^ (((row & 3u) << 2) | ((row >> 2) & 3u))); }
__device__ __forceinline__ unsigned rr16(unsigned lane, unsigned rb, unsigned s) { return off_b((lane & 15u) + 16u * rb, 4u * s + (lane >> 4)); }
__device__ __forceinline__ unsigned tr16(unsigned lane, unsigned c, unsigned ks, unsigned t) { const unsigned g = lane >> 4, q = (lane & 15u) >> 2, p = lane & 3u; return off_b(32u * ks + 8u * g + 4u * t + q, 2u * c + (p >> 1)) + 8u * (p & 1u); }
__device__ __forceinline__ s16x4 trd(LAS unsigned char* p) { return __builtin_bit_cast(s16x4, __builtin_amdgcn_ds_read_tr16_b64_v4i16((LAS v4i16_t*)p)); }
__device__ __forceinline__ bf16x8 cat8(s16x4 lo, s16x4 hi) { return __builtin_shufflevector(lo, hi, 0, 1, 2, 3, 4, 5, 6, 7); }
__device__ __forceinline__ unsigned cvtpk(float lo, float hi) { unsigned r; asm volatile("v_cvt_pk_bf16_f32 %0, %1, %2" : "=v"(r) : "v"(lo), "v"(hi)); return r; }
template <int CTRL, int ROWMASK> __device__ __forceinline__ float dppf(float old, float src) { return __builtin_bit_cast(float, __builtin_amdgcn_update_dpp(__builtin_bit_cast(int, old), __builtin_bit_cast(int, src), CTRL, ROWMASK, 0xf, false)); }
__device__ __forceinline__ float scan_add(float v) { v += dppf<0x111, 0xf>(0.f, v); v += dppf<0x112, 0xf>(0.f, v); v += dppf<0x114, 0xf>(0.f, v); v += dppf<0x118, 0xf>(0.f, v); v += dppf<0x142, 0xa>(0.f, v); v += dppf<0x143, 0xc>(0.f, v); return v; }
__device__ __forceinline__ float scan_max(float v) { const float ni = -INFINITY; v = fmaxf(v, dppf<0x111, 0xf>(ni, v)); v = fmaxf(v, dppf<0x112, 0xf>(ni, v)); v = fmaxf(v, dppf<0x114, 0xf>(ni, v)); v = fmaxf(v, dppf<0x118, 0xf>(ni, v)); v = fmaxf(v, dppf<0x142, 0xa>(ni, v)); v = fmaxf(v, dppf<0x143, 0xc>(ni, v)); return v; }
__device__ __forceinline__ int scan_row(int b, int dir, int st) { return st < CTXL ? ML + b * CTXL + (dir ? CTXL - 1 - st : st) : b * SEQ + (dir ? SEQ - 1 - (st - CTXL) : st - CTXL); }

__device__ __forceinline__ void mlstm_item(const Args& A, LAS unsigned char* lds, int tid_in, int lane_in, int wave, int item) {
    int tid = tid_in, lane = lane_in;
    const int vs = item & 3, dir = (item >> 2) & 1, h = (item >> 3) & 7, b = item >> 6;
    const bf16* P = (const bf16*)(A.ws + WS_P); const float* Gt = (const float*)(A.ws + WS_G);
    bf16* Hb = (bf16*)(A.ws + (dir ? WS_HB : WS_HF));
    const float bi = A.in[8][(2 * dir) * 8 + h], bfg = A.in[8][(2 * dir + 1) * 8 + h];
    LAS float* NBUF = (LAS float*)(lds + NB_OFF); LAS float* NQ = (LAS float*)(lds + NQ_OFF); LAS float* RS = (LAS float*)(lds + RS_OFF); LAS float* WE = (LAS float*)(lds + WE_OFF); LAS float* GGT = (LAS float*)(lds + GG_OFF); LAS float* MVT = (LAS float*)(lds + MV_OFF); LAS float* FAB = (LAS float*)(lds + FAB_OFF + wave * 512);
    { int t0 = tid_in; asm volatile("" : "+v"(t0)); if (t0 < 256) NBUF[t0] = 0.f; }
    asm volatile("" ::: "memory");
    f32x4 X[16];
#pragma unroll
    for (int i = 0; i < 16; ++i) X[i] = (f32x4){0.f, 0.f, 0.f, 0.f};
    float m = 0.f;
    const f32x4 z4 = (f32x4){0.f, 0.f, 0.f, 0.f};
    v4u pq[4], pk[4], pv[2]; float pgi, pgf;
    const int sgn = dir ? -1 : 1;
    const int goff_qk = sgn * (tid_in >> 5) * NP + h * DQK + (tid_in & 31) * 8, goff_v = sgn * (tid_in >> 4) * NP + OFF_VM + h * DV + vs * 128 + (tid_in & 15) * 8, goff_g = sgn * lane_in * 32 + (2 * dir) * 8 + h;
    const unsigned lds_q = (unsigned)(QS * (tid_in >> 5) + 16 * (tid_in & 31)), lds_k = (unsigned)(KS * (tid_in >> 5) + 64 * ((tid_in & 31) >> 2) + 8 * (tid_in & 3)), lds_v = (unsigned)(VS * (tid_in >> 4) + 16 * (tid_in & 15));
    const int hoff = sgn * (lane_in & 15) * DM + h * DV + vs * 128 + 16 * wave + 4 * (lane_in >> 4);
#define ML_LOAD(cc) do { const int row0_ = scan_row(b, dir, 64 * (cc)); const bf16* pb_ = P + (size_t)row0_ * NP; \
        _Pragma("unroll") for (int i = 0; i < 4; ++i) { pq[i] = *(const v4u*)(pb_ + (goff_qk + OFF_QM + sgn * 16 * i * NP)); pk[i] = *(const v4u*)(pb_ + (goff_qk + OFF_KM + sgn * 16 * i * NP)); } \
        _Pragma("unroll") for (int i = 0; i < 2; ++i) pv[i] = *(const v4u*)(pb_ + (goff_v + sgn * 32 * i * NP)); \
        { const float* gb_ = Gt + (size_t)row0_ * 32; pgi = gb_[goff_g]; pgf = gb_[goff_g + 8]; } } while (0)
#define ML_STORE() do { _Pragma("unroll") for (int i = 0; i < 4; ++i) { *(LAS v4u*)(lds + Q_OFF + lds_q + 16 * QS * i) = pq[i]; { v2u k0_, k1_; k0_.x = pk[i].x; k0_.y = pk[i].y; k1_.x = pk[i].z; k1_.y = pk[i].w; *(LAS v2u*)(lds + K_OFF + lds_k + 16 * KS * i) = k0_; *(LAS v2u*)(lds + K_OFF + lds_k + 16 * KS * i + 32) = k1_; } } \
        _Pragma("unroll") for (int i = 0; i < 2; ++i) *(LAS v4u*)(lds + V_OFF + lds_v + 32 * VS * i) = pv[i]; } while (0)
    ML_LOAD(0); ML_STORE();
#pragma unroll 1
    for (int c = 0; c < (CTXL + SEQ) / 64; ++c) {
        const bool latent = c >= CTXL / 64;
        { int lo_ = lane_in, to_ = tid_in; asm volatile("" : "+v"(lo_), "+v"(to_)); lane = lo_; tid = to_; }
        const unsigned q4 = (unsigned)lane >> 4, l15 = (unsigned)lane & 15u;
        const unsigned sperm = 16u * (q4 >> 1) + 4u * (q4 & 1u) + (l15 >> 2);
        LAS unsigned char* qacc = lds + Q_OFF + QS * l15 + 16u * q4;
        LAS unsigned char* qrow = lds + Q_OFF + QS * l15 + 32u * (q4 & 1u) + 8u * (q4 >> 1);
        LAS unsigned char* krow = lds + K_OFF + KS * l15 + 16u * q4;
        LAS unsigned char* ktr = lds + K_OFF + KS * sperm + 8u * (lane & 3);
        LAS unsigned char* vtr = lds + V_OFF + VS * sperm + 8u * (lane & 3) + 32u * wave;
        LAS unsigned char* srd = lds + S_OFF + S_PITCH * l15 + 32u * (q4 >> 1) + 16u * (q4 & 1u);
        const int wperm = 16 * (int)(q4 >> 1) + 4 * (int)(q4 & 1u);
        float bcs, gg, Mv;
        { const float ig = pgi + bi, lf = logsig_fast(pgf + bfg);
          bcs = scan_add(lf); gg = ig - bcs; Mv = fmaxf(m, scan_max(gg)); }
        const float bL = __builtin_bit_cast(float, __builtin_amdgcn_readlane(__builtin_bit_cast(int, bcs), 63)), M63 = __builtin_bit_cast(float, __builtin_amdgcn_readlane(__builtin_bit_cast(int, Mv), 63));
        const float decay = __expf(m - M63);
        if (wave == 0) { WE[lane] = __expf(gg - M63); GGT[lane] = gg; MVT[lane] = Mv; }
        BAR_LDS();
        if (c + 1 < (CTXL + SEQ) / 64) ML_LOAD(c + 1);
        f32x4 accI[4];
        if (latent) {
            bf16x8 nfrag; f32x4 accN[4];
            { const f32x4 n0 = *(const LAS f32x4*)(NBUF + 32 * wave + 4 * (int)q4), n1 = *(const LAS f32x4*)(NBUF + 32 * wave + 16 + 4 * (int)q4);
              v4u nb; nb.x = cvtpk(n0[0], n0[1]); nb.y = cvtpk(n0[2], n0[3]); nb.z = cvtpk(n1[0], n1[1]); nb.w = cvtpk(n1[2], n1[3]);
              nfrag = __builtin_bit_cast(bf16x8, nb); }
            const int tb = wave >> 1, sb0 = 2 * (wave & 1);
            f32x4 st0, st1;
            const int tl = 16 * tb + (int)l15; const float Mt = MVT[tl];
            const f32x4 gs0 = *(const LAS f32x4*)(GGT + 16 * sb0 + 4 * (int)q4), gs1 = *(const LAS f32x4*)(GGT + 16 * sb0 + 16 + 4 * (int)q4);
            st0 = z4; st1 = z4;
            if (sb0 + 1 <= tb) {
#pragma unroll
                for (int ks = 0; ks < 8; ++ks) {
                    const bf16x8 qb = cat8(*(const LAS s16x4*)(qrow + 16 * QS * tb + 64 * ks), *(const LAS s16x4*)(qrow + 16 * QS * tb + 64 * ks + 16));
                    const bf16x8 k0 = *(const LAS bf16x8*)(krow + 16 * KS * sb0 + 64 * ks), k1 = *(const LAS bf16x8*)(krow + 16 * KS * (sb0 + 1) + 64 * ks);
                    st0 = __builtin_amdgcn_mfma_f32_16x16x32_bf16(k0, qb, st0, 0, 0, 0); st1 = __builtin_amdgcn_mfma_f32_16x16x32_bf16(k1, qb, st1, 0, 0, 0); }
            } else if (sb0 <= tb) {
#pragma unroll
                for (int ks = 0; ks < 8; ++ks) {
                    const bf16x8 qb = cat8(*(const LAS s16x4*)(qrow + 16 * QS * tb + 64 * ks), *(const LAS s16x4*)(qrow + 16 * QS * tb + 64 * ks + 16));
                    const bf16x8 k0 = *(const LAS bf16x8*)(krow + 16 * KS * sb0 + 64 * ks);
                    st0 = __builtin_amdgcn_mfma_f32_16x16x32_bf16(k0, qb, st0, 0, 0, 0); }
            }
            float rs = 0.f;
#pragma unroll
            for (int r = 0; r < 4; ++r) { const int s0 = 16 * sb0 + 4 * (int)q4 + r, s1 = s0 + 16;
                st0[r] = s0 <= tl ? st0[r] * __expf(gs0[r] - Mt) : 0.f; st1[r] = s1 <= tl ? st1[r] * __expf(gs1[r] - Mt) : 0.f; rs += st0[r] + st1[r]; }
            rs = xsum32(xsum16(rs));
            if (q4 == 0) RS[(wave & 1) * 64 + tl] = rs;
            { v2u w0, w1; w0.x = cvtpk(st0[0], st0[1]); w0.y = cvtpk(st0[2], st0[3]); w1.x = cvtpk(st1[0], st1[1]); w1.y = cvtpk(st1[2], st1[3]);
              const int pq_ = (int)(((q4 & 1u) << 1) | (q4 >> 1));
              *(LAS v2u*)(lds + S_OFF + tl * S_PITCH + 32 * sb0 + 8 * pq_) = w0; *(LAS v2u*)(lds + S_OFF + tl * S_PITCH + 32 * sb0 + 32 + 8 * pq_) = w1; }
            { const unsigned qb0 = (unsigned)(size_t)qacc, qb1 = qb0 + 16 * QS, qb2 = qb0 + 32 * QS, qb3 = qb0 + 48 * QS;
              bf16x8 fa0, fa1, fa2, fa3, fb0, fb1, fb2, fb3;
#define ML_RD4(f0, f1, f2, f3, kp) do { asm volatile("ds_read_b128 %0, %4 offset:%8\n\tds_read_b128 %1, %5 offset:%8\n\tds_read_b128 %2, %6 offset:%8\n\tds_read_b128 %3, %7 offset:%8" \
                  : "=&v"(f0), "=&v"(f1), "=&v"(f2), "=&v"(f3) : "v"(qb0), "v"(qb1), "v"(qb2), "v"(qb3), "n"(64 * (kp)) : "memory"); } while (0)
#define ML_WT4(f0, f1, f2, f3, n) asm volatile("s_waitcnt lgkmcnt(" #n ")" : "+v"(f0), "+v"(f1), "+v"(f2), "+v"(f3))
#define ML_MM4(f0, f1, f2, f3, kp) do { v4u xb; xb.x = cvtpk(X[2 * (kp)][0], X[2 * (kp)][1]); xb.y = cvtpk(X[2 * (kp)][2], X[2 * (kp)][3]); xb.z = cvtpk(X[2 * (kp) + 1][0], X[2 * (kp) + 1][1]); xb.w = cvtpk(X[2 * (kp) + 1][2], X[2 * (kp) + 1][3]); \
                  const bf16x8 xf = __builtin_bit_cast(bf16x8, xb); \
                  accI[0] = __builtin_amdgcn_mfma_f32_16x16x32_bf16(xf, f0, (kp) ? accI[0] : z4, 0, 0, 0); accI[1] = __builtin_amdgcn_mfma_f32_16x16x32_bf16(xf, f1, (kp) ? accI[1] : z4, 0, 0, 0); \
                  accI[2] = __builtin_amdgcn_mfma_f32_16x16x32_bf16(xf, f2, (kp) ? accI[2] : z4, 0, 0, 0); accI[3] = __builtin_amdgcn_mfma_f32_16x16x32_bf16(xf, f3, (kp) ? accI[3] : z4, 0, 0, 0); \
                  if (wave == (kp)) { accN[0] = __builtin_amdgcn_mfma_f32_16x16x32_bf16(nfrag, f0, z4, 0, 0, 0); accN[1] = __builtin_amdgcn_mfma_f32_16x16x32_bf16(nfrag, f1, z4, 0, 0, 0); \
                      accN[2] = __builtin_amdgcn_mfma_f32_16x16x32_bf16(nfrag, f2, z4, 0, 0, 0); accN[3] = __builtin_amdgcn_mfma_f32_16x16x32_bf16(nfrag, f3, z4, 0, 0, 0); } } while (0)
              asm volatile("s_waitcnt lgkmcnt(0)" ::: "memory");
              ML_RD4(fa0, fa1, fa2, fa3, 0);
              ML_RD4(fb0, fb1, fb2, fb3, 1); ML_WT4(fa0, fa1, fa2, fa3, 4); ML_MM4(fa0, fa1, fa2, fa3, 0);
              ML_RD4(fa0, fa1, fa2, fa3, 2); ML_WT4(fb0, fb1, fb2, fb3, 4); ML_MM4(fb0, fb1, fb2, fb3, 1);
              ML_RD4(fb0, fb1, fb2, fb3, 3); ML_WT4(fa0, fa1, fa2, fa3, 4); ML_MM4(fa0, fa1, fa2, fa3, 2);
              ML_RD4(fa0, fa1, fa2, fa3, 4); ML_WT4(fb0, fb1, fb2, fb3, 4); ML_MM4(fb0, fb1, fb2, fb3, 3);
              ML_RD4(fb0, fb1, fb2, fb3, 5); ML_WT4(fa0, fa1, fa2, fa3, 4); ML_MM4(fa0, fa1, fa2, fa3, 4);
              ML_RD4(fa0, fa1, fa2, fa3, 6); ML_WT4(fb0, fb1, fb2, fb3, 4); ML_MM4(fb0, fb1, fb2, fb3, 5);
              ML_RD4(fb0, fb1, fb2, fb3, 7); ML_WT4(fa0, fa1, fa2, fa3, 4); ML_MM4(fa0, fa1, fa2, fa3, 6);
              ML_WT4(fb0, fb1, fb2, fb3, 0); ML_MM4(fb0, fb1, fb2, fb3, 7);
#undef ML_RD4
#undef ML_WT4
#undef ML_MM4
            }
            if (q4 == 0) {
#pragma unroll
                for (int tt = 0; tt < 4; ++tt) NQ[wave * 64 + 16 * tt + (int)l15] = accN[tt][0]; }
        }
        bf16x8 vf[2], vw[2]; f32x4 wA[2], wB[2];
#pragma unroll
        for (int ks = 0; ks < 2; ++ks) { const s16x4 lo = trd(vtr + VS * (32 * ks)), hi = trd(vtr + VS * (32 * ks + 8)); vf[ks] = cat8(lo, hi);
            wA[ks] = *(const LAS f32x4*)(WE + 32 * ks + wperm); wB[ks] = *(const LAS f32x4*)(WE + 32 * ks + wperm + 8); const f32x4 w0 = wA[ks], w1 = wB[ks];
            const v4u vu = __builtin_bit_cast(v4u, vf[ks]); v4u o;
            o.x = cvtpk(bflo(vu.x) * w0[0], bfhi(vu.x) * w0[1]); o.y = cvtpk(bflo(vu.y) * w0[2], bfhi(vu.y) * w0[3]);
            o.z = cvtpk(bflo(vu.z) * w1[0], bfhi(vu.z) * w1[1]); o.w = cvtpk(bflo(vu.w) * w1[2], bfhi(vu.w) * w1[3]);
            vw[ks] = __builtin_bit_cast(bf16x8, o); }
        { float na[2]; v4u wq[2];
#pragma unroll
          for (int ks = 0; ks < 2; ++ks) { wq[ks].x = cvtpk(wA[ks][0], wA[ks][1]); wq[ks].y = cvtpk(wA[ks][2], wA[ks][3]); wq[ks].z = cvtpk(wB[ks][0], wB[ks][1]); wq[ks].w = cvtpk(wB[ks][2], wB[ks][3]); }
#pragma unroll
          for (int e = 0; e < 2; ++e) { LAS unsigned char* kp_ = ktr + 64u * wave + 32 * e; float a = 0.f;
#pragma unroll
              for (int ks = 0; ks < 2; ++ks) { const v4u ku = __builtin_bit_cast(v4u, cat8(trd(kp_ + KS * (32 * ks)), trd(kp_ + KS * (32 * ks + 8))));
                  a = dot2bf(ku.x, wq[ks].x, a); a = dot2bf(ku.y, wq[ks].y, a); a = dot2bf(ku.z, wq[ks].z, a); a = dot2bf(ku.w, wq[ks].w, a); }
              na[e] = xsum32(xsum16(a)); }
          if (q4 == 0) { const int d0 = 32 * wave + (int)l15; NBUF[d0] = decay * NBUF[d0] + na[0]; NBUF[d0 + 16] = decay * NBUF[d0 + 16] + na[1]; } }
        { s16x4 kA[4][2][2], kB[4][2][2];
#define ML_KRD(buf, ig) _Pragma("unroll") for (int i4 = 0; i4 < 4; ++i4) { _Pragma("unroll") for (int ks = 0; ks < 2; ++ks) { \
            buf[i4][ks][0] = trd(ktr + KS * (32 * ks) + 32 * (4 * (ig) + i4)); buf[i4][ks][1] = trd(ktr + KS * (32 * ks + 8) + 32 * (4 * (ig) + i4)); } }
#define ML_KMM(buf, ig) _Pragma("unroll") for (int i4 = 0; i4 < 4; ++i4) { const int i = 4 * (ig) + i4; X[i] *= decay; \
            _Pragma("unroll") for (int ks = 0; ks < 2; ++ks) X[i] = __builtin_amdgcn_mfma_f32_16x16x32_bf16(cat8(buf[i4][ks][0], buf[i4][ks][1]), vw[ks], X[i], 0, 0, 0); }
          ML_KRD(kA, 0) ML_KRD(kB, 1) ML_KMM(kA, 0) ML_KRD(kA, 2) ML_KMM(kB, 1) ML_KRD(kB, 3) ML_KMM(kA, 2) ML_KMM(kB, 3)
#undef ML_KRD
#undef ML_KMM
        }
        if (latent) {
            BAR_LDS();
            bf16x8 sa0[4], sa1[2]; float nqv[8];
#pragma unroll
            for (int tt = 0; tt < 4; ++tt) sa0[tt] = *(const LAS bf16x8*)(srd + 16 * S_PITCH * tt);
#pragma unroll
            for (int tt = 2; tt < 4; ++tt) sa1[tt - 2] = *(const LAS bf16x8*)(srd + 16 * S_PITCH * tt + 64);
#pragma unroll
            for (int w = 0; w < 8; ++w) nqv[w] = NQ[w * 64 + lane];
            const float rs0 = RS[lane], rs1 = RS[64 + lane];
            if (c + 1 < (CTXL + SEQ) / 64) ML_STORE();
            float FA, FB;
            { const float nq = ((nqv[0] + nqv[1]) + (nqv[2] + nqv[3])) + ((nqv[4] + nqv[5]) + (nqv[6] + nqv[7]));
              const float inter = __expf(m - Mv), den = inter * nq + rs0 + rs1;
              FB = __builtin_amdgcn_rcpf(fmaxf(fabsf(den), __expf(-(bcs + Mv)))); FA = inter * FB; }
            f32x4 accS[4];
#pragma unroll
            for (int tt = 0; tt < 4; ++tt) {
                accS[tt] = __builtin_amdgcn_mfma_f32_16x16x32_bf16(vf[0], sa0[tt], z4, 0, 0, 0);
                if (tt >= 2) accS[tt] = __builtin_amdgcn_mfma_f32_16x16x32_bf16(vf[1], sa1[tt - 2], accS[tt], 0, 0, 0); }
            bf16* hb_ = Hb + (size_t)scan_row(b, dir, 64 * c) * DM; float fav[4], fbv[4]; rowbcast4(FA, fav); rowbcast4(FB, fbv);
#pragma unroll
            for (int tt = 0; tt < 4; ++tt) { const float fa = fav[tt], fb = fbv[tt];
                v2u w; w.x = cvtpk(fa * accI[tt][0] + fb * accS[tt][0], fa * accI[tt][1] + fb * accS[tt][1]); w.y = cvtpk(fa * accI[tt][2] + fb * accS[tt][2], fa * accI[tt][3] + fb * accS[tt][3]);
                *(v2u*)(hb_ + (hoff + sgn * 16 * tt * DM)) = w; }
        } else {
            BAR_LDS();
            if (c + 1 < (CTXL + SEQ) / 64) ML_STORE();
        }
        m = bL + M63;
    }
#undef ML_LOAD
#undef ML_STORE
    BAR_LDS();
}
}


namespace at {
typedef float f32x16 __attribute__((ext_vector_type(16)));
typedef __bf16 bf16x2_t __attribute__((ext_vector_type(2)));
typedef float f32x2_t __attribute__((ext_vector_type(2)));
constexpr int KSTR = 272, VSTR = 320, VOFF = 64 * KSTR, BUFSZ = 64 * KSTR + 64 * VSTR;
__device__ __forceinline__ float max3f(float a, float b, float c) { float r; asm("v_max3_f32 %0, %1, %2, %3" : "=v"(r) : "v"(a), "v"(b), "v"(c)); return r; }
__device__ __forceinline__ unsigned cvt2(float lo, float hi) { f32x2_t v = {lo, hi}; bf16x2_t b = __builtin_convertvector(v, bf16x2_t); return __builtin_bit_cast(unsigned, b); }
__device__ __forceinline__ bf16x8 pack_step(const f32x16& x, int s) { v4u p; p.x = cvt2(x[8 * s], x[8 * s + 1]); p.y = cvt2(x[8 * s + 2], x[8 * s + 3]); p.z = cvt2(x[8 * s + 4], x[8 * s + 5]); p.w = cvt2(x[8 * s + 6], x[8 * s + 7]); return __builtin_bit_cast(bf16x8, p); }

struct TagT { static constexpr bool v = true; }; struct TagF { static constexpr bool v = false; };
__device__ __forceinline__ void attn_items(const Args& A, LAS unsigned char* lds, int tid_in, int lane_in, int wave, int G) {
    constexpr int NIT = NB * AKV * (SEQ / 64);
    int item = blockIdx.x;
    if (item >= NIT) return;
    constexpr bool late = false;
    const bf16* P = (const bf16*)(A.ws + WS_P); bf16* AT = (bf16*)(A.ws + WS_AT);
    int lane = lane_in, tid = tid_in;
    { asm volatile("" : "+v"(lane), "+v"(tid)); }
    const int l31 = lane & 31, hh = lane >> 5;
    const float cl2 = 0.08838834764831845f * 1.4426950408889634f;
    bf16x8 qf[8], qn[8]; v4u pk[2], pv[2];
#define AT_GEOM(it, b_, hkv_, hq_, q0_, qw_, ks_, nwt_) const int b_ = (it) >> 8, hkv_ = ((it) >> 5) & 7, hq_ = hkv_ * 4 + (wave & 3), q0_ = 64 * ((it) & 31), qw_ = q0_ + 32 * (wave >> 2), \
        ks_ = q0_ - WIN < 0 ? 0 : q0_ - WIN, nwt_ = ((q0_ + 64 + WIN > SEQ ? SEQ : q0_ + 64 + WIN) - ks_) >> 6
#define AT_QLOAD(qd, b_, qw_, hq_) do { const bf16* qp_ = P + (size_t)((b_) * SEQ + (qw_) + l31) * NP + OFF_QA + (hq_) * AD + 8 * hh; \
        _Pragma("unroll") for (int ks = 0; ks < 8; ++ks) qd[ks] = *(const bf16x8*)(qp_ + 16 * ks); } while (0)
#define AT_LOAD(b_, hkv_, ks_, nwt_, i) do { const int r0_ = (i) < (nwt_) ? (b_) * SEQ + (ks_) + 64 * (i) : ML + (b_) * CTXL + 64 * ((i) - (nwt_)); \
        _Pragma("unroll") for (int j = 0; j < 2; ++j) { const int idx = tidl + 512 * j; const bf16* gp = P + (size_t)(r0_ + (idx >> 4)) * NP + (hkv_) * AD + (idx & 15) * 8; \
            pk[j] = *(const v4u*)(gp + OFF_KA); pv[j] = *(const v4u*)(gp + OFF_VA); } } while (0)
#define AT_STORE(bufo) do { _Pragma("unroll") for (int j = 0; j < 2; ++j) { const int idx = tid + 512 * j; \
            *(LAS v4u*)(lds + (unsigned)(bufo) + KSTR * (idx >> 4) + 16 * (idx & 15)) = pk[j]; *(LAS v4u*)(lds + (unsigned)(bufo) + VOFF + VSTR * (idx >> 4) + 16 * (idx & 15)) = pv[j]; } } while (0)
#define AT_PV(Vb) do { LAS unsigned char* vp_ = (Vb) + vbase; _Pragma("unroll") for (int f = 0; f < 4; ++f) { _Pragma("unroll") for (int d = 0; d < 4; ++d) { \
            const ml::s16x4 lo = ml::trd(vp_ + VSTR * (16 * f) + 64 * d), hi = ml::trd(vp_ + VSTR * (16 * f + 8) + 64 * d);     \
            O[d] = __builtin_amdgcn_mfma_f32_32x32x16_bf16(ml::cat8(lo, hi), pb[f], O[d], 0, 0, 0); } } } while (0)
    const unsigned kbase = (unsigned)(KSTR * l31 + 16 * hh), vbase = (unsigned)(VSTR * (4 * hh + ((lane & 15) >> 2)) + 32 * ((lane >> 4) & 1) + 8 * (lane & 3));
    int cb, chkv, chq, cq0, cqw, cks, cnwt;
    { AT_GEOM(item, b0, hkv0, hq0, q00, qw0, ks0, nwt0); cb = b0; chkv = hkv0; chq = hq0; cq0 = q00; cqw = qw0; cks = ks0; cnwt = nwt0; }
    int tidl = tid;
    AT_LOAD(cb, chkv, cks, cnwt, 0); AT_QLOAD(qf, cb, cqw, chq);
    AT_STORE(0);
    asm volatile("" : "+v"(qf[0]), "+v"(qf[1]), "+v"(qf[2]), "+v"(qf[3]), "+v"(qf[4]), "+v"(qf[5]), "+v"(qf[6]), "+v"(qf[7]));
#pragma unroll
    for (int ks = 0; ks < 8; ++ks) qn[ks] = qf[ks];
#pragma unroll 1
    for (;;) {
        const int b = cb, hkv = chkv, hq = chq, q0 = cq0, qw = cqw, kstart = cks, nwt = cnwt, nt = nwt + CTXL / 64;
        const int nxt = item + G; const bool more = nxt < NIT;
        AT_GEOM(more ? nxt : item, nb, nhkv, nhq, nq0, nqw, nks, nnwt);
        asm volatile("" : "+v"(tidl));
        float m = A.in[10][hq] * 1.4426950408889634f, l = hh == 0 ? 1.0f : 0.0f;
        f32x16 O[4];
#pragma unroll
        for (int d = 0; d < 4; ++d)
#pragma unroll
            for (int r = 0; r < 16; ++r) O[d][r] = 0.f;
        bf16x8 pb[4];
        int bo = 0, bprev = 0;
        auto trip = [&](const int i, auto last) {
            const int bo1 = bo == 2 * BUFSZ ? 0 : bo + BUFSZ;
            BAR_LDS();
            if (!decltype(last)::v) AT_LOAD(b, hkv, kstart, nwt, i + 1); else if (more) { AT_LOAD(nb, nhkv, nks, nnwt, 0); AT_QLOAD(qn, nb, nqw, nhq); }
            if (late && i > 0) AT_PV(lds + bprev + VOFF);
            LAS unsigned char* Kb = lds + bo + kbase;
            f32x16 S0, S1;
            { const f32x16 z16 = {0.f, 0.f, 0.f, 0.f, 0.f, 0.f, 0.f, 0.f, 0.f, 0.f, 0.f, 0.f, 0.f, 0.f, 0.f, 0.f};
              S0 = __builtin_amdgcn_mfma_f32_32x32x16_bf16(*(const LAS bf16x8*)(Kb), qf[0], z16, 0, 0, 0); S1 = __builtin_amdgcn_mfma_f32_32x32x16_bf16(*(const LAS bf16x8*)(Kb + 32 * KSTR), qf[0], z16, 0, 0, 0); }
#pragma unroll
            for (int ks = 1; ks < 8; ++ks) { const bf16x8 k0 = *(const LAS bf16x8*)(Kb + 32 * ks), k1 = *(const LAS bf16x8*)(Kb + 32 * KSTR + 32 * ks);
                S0 = __builtin_amdgcn_mfma_f32_32x32x16_bf16(k0, qf[ks], S0, 0, 0, 0); S1 = __builtin_amdgcn_mfma_f32_32x32x16_bf16(k1, qf[ks], S1, 0, 0, 0); }
            float mx = -INFINITY;
            if (i < nwt && (kstart + 64 * i + WIN == q0 || kstart + 64 * i == q0 + WIN)) {
                const int dlt = kstart + 64 * i + 4 * hh - (qw + l31);
#pragma unroll
                for (int r = 0; r < 16; ++r) { const int d0 = dlt + (r & 3) + 8 * (r >> 2), d1 = d0 + 32;
                    S0[r] = (d0 >= -WIN && d0 <= WIN) ? S0[r] : -INFINITY; S1[r] = (d1 >= -WIN && d1 <= WIN) ? S1[r] : -INFINITY; } }
#pragma unroll
            for (int r = 0; r < 16; ++r) mx = max3f(mx, S0[r], S1[r]);
            mx = xmax32(mx);
            if (!__all(mx * cl2 - m <= 8.0f)) { const float mn = fmaxf(m, mx * cl2), alpha = __builtin_amdgcn_exp2f(m - mn); m = mn; l *= alpha;
#pragma unroll
                for (int d = 0; d < 4; ++d)
#pragma unroll
                    for (int r = 0; r < 16; ++r) O[d][r] *= alpha; }
            float ls = 0.f;
#pragma unroll
            for (int r = 0; r < 16; ++r) { S0[r] = __builtin_amdgcn_exp2f(S0[r] * cl2 - m); S1[r] = __builtin_amdgcn_exp2f(S1[r] * cl2 - m); ls += S0[r] + S1[r]; }
            l += ls;
            pb[0] = pack_step(S0, 0); pb[1] = pack_step(S0, 1); pb[2] = pack_step(S1, 0); pb[3] = pack_step(S1, 1);
            if (!late) AT_PV(lds + bo + VOFF);
            if (!decltype(last)::v) AT_STORE(bo1);
            bprev = bo; bo = bo1;
        };
#pragma unroll 1
        for (int i = 0; i + 1 < nt; ++i) trip(i, TagF{});
        trip(nt - 1, TagT{});
        if (late) AT_PV(lds + bprev + VOFF);
        BAR_LDS();
        if (more) AT_STORE(0);
        const float inv = __builtin_amdgcn_rcpf(xsum32(l));
        int l2 = lane; asm volatile("" : "+v"(l2));
        bf16* op = AT + (size_t)(b * SEQ + qw + (l2 & 31)) * PK + hq * AD + 4 * (l2 >> 5);
#pragma unroll
        for (int d = 0; d < 4; ++d)
#pragma unroll
            for (int g = 0; g < 4; ++g) { ml::v2u w; w.x = cvt2(O[d][4 * g] * inv, O[d][4 * g + 1] * inv); w.y = cvt2(O[d][4 * g + 2] * inv, O[d][4 * g + 3] * inv);
                *(ml::v2u*)(op + 32 * d + 8 * g) = w; }
        if (!more) break;
#pragma unroll
        for (int ks = 0; ks < 8; ++ks) qf[ks] = qn[ks];
        item = nxt; cb = nb; chkv = nhkv; chq = nhq; cq0 = nq0; cqw = nqw; cks = nks; cnwt = nnwt;
    }
#undef AT_GEOM
#undef AT_QLOAD
#undef AT_LOAD
#undef AT_STORE
#undef AT_PV
    BAR_LDS();
}
}

__device__ __forceinline__ unsigned q4(float a, float b, float c, float d) {
    const float M = 12582912.0f;
    const unsigned ua = __builtin_bit_cast(unsigned, a + M), ub = __builtin_bit_cast(unsigned, b + M), uc = __builtin_bit_cast(unsigned, c + M), ud = __builtin_bit_cast(unsigned, d + M);
    const unsigned lo = __builtin_amdgcn_perm(ub, ua, 0x0c0c0400u), hi = __builtin_amdgcn_perm(ud, uc, 0x0c0c0400u);
    return __builtin_amdgcn_perm(hi, lo, 0x05040100u); }
struct TItem { const float* src; bf16* dst; int N, K; };
constexpr int P0_NB_IN = 129, P0_I_IN = (DM / 64) * P0_NB_IN, P0_I_SQ = (DM / 64) * (DM / 32), P0_NSMALL = P0_I_IN + P0_I_SQ + (DFF / 64) * (DM / 32);
__device__ __forceinline__ TItem p0_item(const Args& A, int it, int lane) {
    unsigned char* ws = A.ws; const float* W; bf16* WT; int N, K, kb, nb; bool remap = false; int r = it;
    if (r < P0_I_IN) { W = A.in[7]; WT = (bf16*)(ws + WS_WIN); N = NPW; K = DM; remap = true; kb = r / P0_NB_IN; nb = r - kb * P0_NB_IN; if (nb == 128) nb = 12288 / 32; }
    else if ((r -= P0_I_IN) < P0_I_SQ) { W = A.in[13]; WT = (bf16*)(ws + WS_WO); N = DM; K = DM; kb = r >> 7; nb = r & 127; }
    else { r -= P0_I_SQ; W = A.in[15]; WT = (bf16*)(ws + WS_WF2); N = DM; K = DFF; kb = r >> 7; nb = r & 127; }
    const int k0 = 64 * kb, n0 = 32 * nb, d0 = remap ? win_map(n0) : n0;
    TItem t; t.src = W + (size_t)(k0 + (lane >> 5)) * N + n0 + (lane & 31); t.dst = WT + (size_t)d0 * (K + 64) + k0; t.N = N; t.K = K + 64; return t;
}
__device__ __forceinline__ void p0_load(const TItem& t, float (&wv)[32]) {
#pragma unroll
    for (int i = 0; i < 32; ++i) wv[i] = __builtin_nontemporal_load(t.src + (size_t)(2 * i) * t.N);
}
__device__ __forceinline__ void p0_emit(const TItem& t, const float (&wv)[32], LAS float* scr, int lane) {
#pragma unroll
    for (int i = 0; i < 32; ++i) scr[(2 * i + (lane >> 5)) * 33 + (lane & 31)] = wv[i];
    LDS_WAIT(); asm volatile("" ::: "memory");
    const int c = lane & 7;
#pragma unroll
    for (int j = 0; j < 4; ++j) { const int n = (lane >> 3) + 8 * j; const LAS float* s = scr + (8 * c) * 33 + n;
        v4u o; o.x = pk2(s[0 * 33], s[1 * 33]); o.y = pk2(s[2 * 33], s[3 * 33]); o.z = pk2(s[4 * 33], s[5 * 33]); o.w = pk2(s[6 * 33], s[7 * 33]);
        *(GAS v4u*)(t.dst + (size_t)n * t.K + 8 * c) = o; }
    LDS_WAIT(); asm volatile("" ::: "memory");
}
constexpr int P0_NBIG_IN = 704, P0_NBIG = P0_NBIG_IN + 2 * (DM / 32) + DFF / 32;
struct BigItem { const char* W; unsigned char* dst; float* cs; int N, n0, rbase; bool rot; };
__device__ __forceinline__ BigItem p0_big_item(const Args& A, int item) {
    unsigned char* ws = A.ws; BigItem t; t.rot = false;
    if (item < P0_NBIG_IN) { t.W = (const char*)A.in[7]; t.N = NPW; t.n0 = item < 256 ? OFF_VM + 32 * item : 12320 + 32 * (item - 256); const int d0 = win_map(t.n0); t.rot = d0 >= OFF_QA && d0 < OFF_VA;
        t.rbase = (t.rot ? (d0 & ~63) + ((d0 & 32) ? 4 : 0) : d0) - OFF_KM; t.dst = ws + WS_W8G; t.cs = (float*)(ws + WS_CSG); }
    else if (item < P0_NBIG_IN + 128) { t.W = (const char*)A.in[11]; t.N = DM; t.n0 = 32 * (item - P0_NBIG_IN); t.rbase = t.n0; t.dst = ws + WS_W8OM; t.cs = (float*)(ws + WS_CSOM); }
    else if (item < P0_NBIG_IN + 256) { t.W = (const char*)A.in[12]; t.N = DM; t.n0 = 32 * (item - P0_NBIG_IN - 128); t.rbase = t.n0; t.dst = ws + WS_W8OA; t.cs = (float*)(ws + WS_CSOA); }
    else { t.W = (const char*)A.in[14]; t.N = DFF; t.n0 = 32 * (item - P0_NBIG_IN - 256); t.rbase = t.n0; t.dst = ws + WS_W8F; t.cs = (float*)(ws + WS_CSF); }
    return t;
}
__device__ __forceinline__ unsigned p0_big_voff(const BigItem& t, int wave) {
    int t1; asm volatile("v_mbcnt_lo_u32_b32 %0, -1, 0\n\tv_mbcnt_hi_u32_b32 %0, -1, %0" : "=v"(t1)); t1 += wave * 64;
    return (unsigned)((64 * (t1 >> 3)) * t.N + t.n0 + 4 * (t1 & 7)) * 4u;
}
__device__ __forceinline__ void p0_bigs(const Args& A, LAS unsigned char* lds, int wave, int G) {
    int item = blockIdx.x;
    if (item >= P0_NBIG) return;
    BigItem cur = p0_big_item(A, item);
    unsigned voff = p0_big_voff(cur, wave);
    f32x4 ta[8], tb[8];
#define P0B_LD(t, b, it) _Pragma("unroll") for (int u = 0; u < 8; ++u) t[u] = __builtin_nontemporal_load((const f32x4*)((it).W + (size_t)(8 * (b) + u) * (size_t)(4 * (it).N) + voff));
#define P0B_CV(t, b) _Pragma("unroll") for (int u = 0; u < 8; ++u) { const int p = 8 * (b) + u; d[2 * p] = at::cvt2(t[u].x, t[u].y); d[2 * p + 1] = at::cvt2(t[u].z, t[u].w); \
        a0 = fmaxf(a0, fabsf(t[u].x)); a1 = fmaxf(a1, fabsf(t[u].y)); a2 = fmaxf(a2, fabsf(t[u].z)); a3 = fmaxf(a3, fabsf(t[u].w)); \
        asm volatile("" : "+v"(d[2 * p]), "+v"(d[2 * p + 1]), "+v"(a0), "+v"(a1), "+v"(a2), "+v"(a3)); }
    P0B_LD(ta, 0, cur) P0B_LD(tb, 1, cur)
    for (;;) {
        unsigned d[128]; float a0 = 0.f, a1 = 0.f, a2 = 0.f, a3 = 0.f;
        __builtin_amdgcn_sched_barrier(0);
#pragma unroll
        for (int b = 0; b < 8; b += 2) {
            P0B_CV(ta, b) __builtin_amdgcn_sched_barrier(0);
            if (b + 2 < 8) { P0B_LD(ta, b + 2, cur) } __builtin_amdgcn_sched_barrier(0);
            P0B_CV(tb, b + 1) __builtin_amdgcn_sched_barrier(0);
            if (b + 3 < 8) { P0B_LD(tb, b + 3, cur) } __builtin_amdgcn_sched_barrier(0);
        }
        const int nxt = item + G; const bool more = nxt < P0_NBIG;
        const BigItem nx = p0_big_item(A, more ? nxt : item);
        if (more) { voff = p0_big_voff(nx, wave); P0B_LD(ta, 0, nx) P0B_LD(tb, 1, nx) }
        __builtin_amdgcn_sched_barrier(0);
        int t2; asm volatile("v_mbcnt_lo_u32_b32 %0, -1, 0\n\tv_mbcnt_hi_u32_b32 %0, -1, %0" : "=v"(t2)); t2 += wave * 64;
        const int r8 = t2 >> 3, c4 = t2 & 7, ln = t2 & 63;
        a0 = xmax32(xmax16(fmaxf(a0, dppx<0x128>(a0)))); a1 = xmax32(xmax16(fmaxf(a1, dppx<0x128>(a1)))); a2 = xmax32(xmax16(fmaxf(a2, dppx<0x128>(a2)))); a3 = xmax32(xmax16(fmaxf(a3, dppx<0x128>(a3))));
        LAS float* red = (LAS float*)(lds + LDSCTL_OFF + 1024);
        if (ln < 8) { red[wave * 32 + 4 * ln] = a0; red[wave * 32 + 4 * ln + 1] = a1; red[wave * 32 + 4 * ln + 2] = a2; red[wave * 32 + 4 * ln + 3] = a3; }
        BAR_LDS();
#pragma unroll
        for (int w = 0; w < 8; ++w) { a0 = fmaxf(a0, red[w * 32 + 4 * c4]); a1 = fmaxf(a1, red[w * 32 + 4 * c4 + 1]); a2 = fmaxf(a2, red[w * 32 + 4 * c4 + 2]); a3 = fmaxf(a3, red[w * 32 + 4 * c4 + 3]); }
        const float i0 = a0 > 0.f ? 127.0f / a0 : 0.f, i1 = a1 > 0.f ? 127.0f / a1 : 0.f, i2 = a2 > 0.f ? 127.0f / a2 : 0.f, i3 = a3 > 0.f ? 127.0f / a3 : 0.f;
        const int rbase = cur.rbase; const bool rot = cur.rot;
        if (t2 < 8) { const int nb4 = 4 * c4; float* cs = cur.cs;
            cs[rbase + (rot ? 8 * ((nb4 + 0) >> 2) + ((nb4 + 0) & 3) : nb4 + 0)] = a0 * (1.0f / 127.0f); cs[rbase + (rot ? 8 * ((nb4 + 1) >> 2) + ((nb4 + 1) & 3) : nb4 + 1)] = a1 * (1.0f / 127.0f);
            cs[rbase + (rot ? 8 * ((nb4 + 2) >> 2) + ((nb4 + 2) & 3) : nb4 + 2)] = a2 * (1.0f / 127.0f); cs[rbase + (rot ? 8 * ((nb4 + 3) >> 2) + ((nb4 + 3) & 3) : nb4 + 3)] = a3 * (1.0f / 127.0f); }
        LAS unsigned char* img = lds + c4 * 4096;
#pragma unroll
        for (int j = 0; j < 4; ++j) { const int ch = ((4 * r8 + j) ^ c4) << 4; v4u o0, o1, o2, o3;
#pragma unroll
            for (int e = 0; e < 4; ++e) { const int p = 16 * j + 4 * e;
                o0[e] = q4(bflo(d[2 * p]) * i0, bflo(d[2 * p + 2]) * i0, bflo(d[2 * p + 4]) * i0, bflo(d[2 * p + 6]) * i0);
                o1[e] = q4(bfhi(d[2 * p]) * i1, bfhi(d[2 * p + 2]) * i1, bfhi(d[2 * p + 4]) * i1, bfhi(d[2 * p + 6]) * i1);
                o2[e] = q4(bflo(d[2 * p + 1]) * i2, bflo(d[2 * p + 3]) * i2, bflo(d[2 * p + 5]) * i2, bflo(d[2 * p + 7]) * i2);
                o3[e] = q4(bfhi(d[2 * p + 1]) * i3, bfhi(d[2 * p + 3]) * i3, bfhi(d[2 * p + 5]) * i3, bfhi(d[2 * p + 7]) * i3); }
            *(LAS v4u*)(img + 0 * 32768 + ch) = o0; *(LAS v4u*)(img + 1 * 32768 + ch) = o1; *(LAS v4u*)(img + 2 * 32768 + ch) = o2; *(LAS v4u*)(img + 3 * 32768 + ch) = o3; }
        BAR_LDS();
        int l3; asm volatile("v_mbcnt_lo_u32_b32 %0, -1, 0\n\tv_mbcnt_hi_u32_b32 %0, -1, %0" : "=v"(l3));
#pragma unroll
        for (int i = 0; i < 4; ++i) { const int rho = 4 * wave + i, n = 4 * (rho & 7) + (rho >> 3);
            unsigned char* drow = cur.dst + (size_t)(rbase + (rot ? 8 * (n >> 2) + (n & 3) : n)) * P8;
#pragma unroll
            for (int q = 0; q < 4; ++q) { const int ch = 64 * q + l3; *(GAS v4u*)(drow + 16 * ch) = *(const LAS v4u*)(lds + rho * 4096 + ((ch ^ (rho & 7)) << 4)); } }
        if (!more) break;
        item = nxt; cur = nx;
    }
#undef P0B_LD
#undef P0B_CV
}

__device__ __forceinline__ void p0_prologue(const Args& A, LAS unsigned char* lds, int tid, int lane, int wave, int G) {
    unsigned char* ws = A.ws;
    LAS float* scr = (LAS float*)(lds + wave * 16384);
    const int gw = blockIdx.x * NWAVES + wave, NGW = G * NWAVES;
    { const int maxbig = (P0_NBIG + G - 1) / G, ndefw = (G * maxbig - P0_NBIG) * NWAVES, nextra = 7 * ndefw <= P0_NSMALL ? 7 : 0;
      const int rb = (P0_NSMALL - nextra * ndefw) / NGW, t0 = rb * NGW, t1 = t0 + nextra * ndefw;
      const int wdef = gw - (NGW - ndefw);
      auto sidx = [&](int i) -> int {
          if (i < rb) return i * NGW + gw;
          int j = i - rb;
          if (wdef >= 0) { if (j < nextra) return t0 + j * ndefw + wdef; j -= nextra; }
          return (j == 0 && t1 + gw < P0_NSMALL) ? t1 + gw : -1; };
      float wa[32], wb[32]; int i = 0, ia = sidx(0);
      TItem ta = p0_item(A, ia >= 0 ? ia : 0, lane), tb = ta;
      if (ia >= 0) p0_load(ta, wa);
      while (ia >= 0) {
          const int ib = sidx(i + 1);
          if (ib >= 0) { tb = p0_item(A, ib, lane); p0_load(tb, wb); }
          p0_emit(ta, wa, scr, lane);
          if (ib < 0) break;
          ia = sidx(i + 2);
          if (ia >= 0) { ta = p0_item(A, ia, lane); p0_load(ta, wa); }
          p0_emit(tb, wb, scr, lane);
          i += 2;
      } }
    { float* ROT = (float*)(ws + WS_ROT); const int e = blockIdx.x * NWAVES * 64 + tid;
      if (e < 64 * 32) { const int pos = e >> 5, i = e & 31; const float freq = expf(-(float)i * (1.0f / 32.0f) * 9.210340371976184f), ang = (float)pos * freq; ROT[e] = cosf(ang); ROT[2048 + e] = sinf(ang); } }
    __syncthreads();
    LAS float* sc = (LAS float*)lds;
    LAS float* red = sc + 5 * DM;
    const float* cvec = A.in[1]; const float* cctx = A.in[3]; const float* wmod = A.in[4]; const float* bmod = A.in[5];
    float* MOD = (float*)(ws + WS_MOD);
    for (int e = tid; e < 5 * DM; e += NWAVES * 64) { const int r = e >> 12, k = e & (DM - 1); const float cv = r < 4 ? cvec[r * DM + k] : cctx[k]; sc[e] = cv / (1.0f + expf(-cv)); }
    __syncthreads();
    for (int cg = blockIdx.x; cg < NMOD / 96; cg += G) {
        const int kg = tid >> 5, cl = tid & 31;
        float a0[5], a1[5], a2[5];
#pragma unroll
        for (int r = 0; r < 5; ++r) { a0[r] = 0.f; a1[r] = 0.f; a2[r] = 0.f; }
#pragma unroll 8
        for (int k = kg; k < DM; k += 16) {
            const float* wr = wmod + (size_t)k * NMOD + cg * 96 + cl;
            const float w0 = __builtin_nontemporal_load(wr), w1 = __builtin_nontemporal_load(wr + 32), w2 = __builtin_nontemporal_load(wr + 64);
#pragma unroll
            for (int r = 0; r < 5; ++r) { const float s = sc[r * DM + k]; a0[r] += s * w0; a1[r] += s * w1; a2[r] += s * w2; }
        }
#pragma unroll
        for (int r = 0; r < 5; ++r) { red[((kg * 3 + 0) * 5 + r) * 32 + cl] = a0[r]; red[((kg * 3 + 1) * 5 + r) * 32 + cl] = a1[r]; red[((kg * 3 + 2) * 5 + r) * 32 + cl] = a2[r]; }
        __syncthreads();
        if (tid < 480) { const int cc = tid / 160, r = (tid / 32) % 5, c2 = tid & 31; float s = 0.f;
#pragma unroll
            for (int g = 0; g < 16; ++g) s += red[((g * 3 + cc) * 5 + r) * 32 + c2];
            const int col = cg * 96 + cc * 32 + c2; MOD[r * NMOD + col] = s + bmod[col]; }
        __syncthreads();
    }
}

__device__ __forceinline__ void p1_rows(const Args& A, int lane, int wave, int G) {
    const int gw = blockIdx.x * NWAVES + wave, NGW = G * NWAVES;
    const float* MOD = (const float*)(A.ws + WS_MOD); const float* ng = A.in[6];
    bf16* U = (bf16*)(A.ws + WS_U); unsigned char* U8 = A.ws + WS_U8; float* RSU = (float*)(A.ws + WS_RSU);
    for (int m = gw; m < MT; m += NGW) {
        const float* xr = m < ML ? A.in[0] + (size_t)m * DM : A.in[2] + (size_t)(m - ML) * DM;
        const int r = m < ML ? m / SEQ : 4;
        const f32x4* x4 = (const f32x4*)xr + lane;
        f32x4 v[16]; float ss = 0.f;
#pragma unroll
        for (int j = 0; j < 16; ++j) { v[j] = __builtin_nontemporal_load(x4 + 64 * j); ss += (v[j].x * v[j].x + v[j].y * v[j].y) + (v[j].z * v[j].z + v[j].w * v[j].w); }
        const float rstd = __builtin_amdgcn_rsqf(wave_sum(ss) * (1.0f / DM) + EPS);
        const f32x4* g4 = (const f32x4*)ng + lane; const f32x4* sh4 = (const f32x4*)(MOD + r * NMOD) + lane; const f32x4* s4 = (const f32x4*)(MOD + r * NMOD + DM) + lane;
        unsigned long long* o8 = (unsigned long long*)(U + (size_t)m * PK) + lane; float amax = 0.f;
#pragma unroll
        for (int j = 0; j < 16; ++j) { const f32x4 g = g4[64 * j], sh = sh4[64 * j], s = s4[64 * j]; const f32x4 y = v[j] * rstd * g; const f32x4 u = y * (1.0f + s) + sh; v[j] = u;
            amax = fmaxf(amax, fmaxf(fmaxf(fabsf(u.x), fabsf(u.y)), fmaxf(fabsf(u.z), fabsf(u.w))));
            o8[64 * j] = (unsigned long long)pk2(u.x, u.y) | ((unsigned long long)pk2(u.z, u.w) << 32); }
        { amax = wave_max(amax); const float inv = amax > 0.f ? 127.0f / amax : 0.f; if (lane == 0) RSU[m] = amax * (1.0f / 127.0f);
            unsigned* d8 = (unsigned*)(U8 + (size_t)m * P8) + lane;
#pragma unroll
            for (int j = 0; j < 16; ++j) d8[64 * j] = q4(v[j].x * inv, v[j].y * inv, v[j].z * inv, v[j].w * inv); }
    }
}

__device__ __forceinline__ void ld8f(const float* p, f32x4& a, f32x4& b) { a = *(const f32x4*)p; b = *(const f32x4*)(p + 4); }
__device__ __forceinline__ void ld8f_nt(const float* p, f32x4& a, f32x4& b) { a = __builtin_nontemporal_load((const f32x4*)p); b = __builtin_nontemporal_load((const f32x4*)(p + 4)); }
__device__ __forceinline__ void un8(const v4u w, f32x4& a, f32x4& b) { a = (f32x4){bflo(w.x), bfhi(w.x), bflo(w.y), bfhi(w.y)}; b = (f32x4){bflo(w.z), bfhi(w.z), bflo(w.w), bfhi(w.w)}; }
__device__ __forceinline__ float sq8(const f32x4& a, const f32x4& b) { return (a.x * a.x + a.y * a.y) + (a.z * a.z + a.w * a.w) + (b.x * b.x + b.y * b.y) + (b.z * b.z + b.w * b.w); }
__device__ __forceinline__ float amax8(const f32x4& a, const f32x4& b) { return fmaxf(fmaxf(fmaxf(fabsf(a.x), fabsf(a.y)), fmaxf(fabsf(a.z), fabsf(a.w))), fmaxf(fmaxf(fabsf(b.x), fabsf(b.y)), fmaxf(fabsf(b.z), fabsf(b.w)))); }
__device__ __forceinline__ void p5_readout(const Args& A, int lane, int wave, int G) {
    const int gw = blockIdx.x * NWAVES + wave, NGW = G * NWAVES;
    const bf16* HF = (const bf16*)(A.ws + WS_HF); const bf16* HB = (const bf16*)(A.ws + WS_HB); const bf16* AT = (const bf16*)(A.ws + WS_AT);
    const bf16* P = (const bf16*)(A.ws + WS_P); const float* mng = A.in[9];
    unsigned char* HM8 = A.ws + WS_HM8; unsigned char* AT8 = A.ws + WS_AT8; float* RSHM = (float*)(A.ws + WS_RSHM); float* RSAT = (float*)(A.ws + WS_RSAT);
    for (int row = gw; row < ML; row += NGW) {
        f32x4 va[8], vb[8]; float amax = 0.f;
#pragma unroll
        for (int h = 0; h < 8; ++h) { const size_t off = (size_t)row * DM + h * DV + 8 * lane;
            const v4u hf = *(const v4u*)(HF + off), hb = *(const v4u*)(HB + off); const v4u om = *(const v4u*)(P + (size_t)row * NP + OFF_OM + h * DV + 8 * lane);
            f32x4 a0 = (f32x4){bflo(hf.x) + bflo(hb.x), bfhi(hf.x) + bfhi(hb.x), bflo(hf.y) + bflo(hb.y), bfhi(hf.y) + bfhi(hb.y)}, a1 = (f32x4){bflo(hf.z) + bflo(hb.z), bfhi(hf.z) + bfhi(hb.z), bflo(hf.w) + bflo(hb.w), bfhi(hf.w) + bfhi(hb.w)};
            const float rstd = __builtin_amdgcn_rsqf(wave_sum(sq8(a0, a1)) * (1.0f / DV) + EPS);
            const f32x4 g0 = *(const f32x4*)(mng + h * DV + 8 * lane), g1 = *(const f32x4*)(mng + h * DV + 8 * lane + 4);
            a0 = a0 * rstd * g0 * (f32x4){sigm(bflo(om.x)), sigm(bfhi(om.x)), sigm(bflo(om.y)), sigm(bfhi(om.y))}; a1 = a1 * rstd * g1 * (f32x4){sigm(bflo(om.z)), sigm(bfhi(om.z)), sigm(bflo(om.w)), sigm(bfhi(om.w))};
            va[h] = a0; vb[h] = a1; amax = fmaxf(amax, amax8(a0, a1)); }
        amax = wave_max(amax); float inv = amax > 0.f ? 127.0f / amax : 0.f; if (lane == 0) RSHM[row] = amax * (1.0f / 127.0f);
#pragma unroll
        for (int h = 0; h < 8; ++h) { uint2 o; o.x = q4(va[h].x * inv, va[h].y * inv, va[h].z * inv, va[h].w * inv); o.y = q4(vb[h].x * inv, vb[h].y * inv, vb[h].z * inv, vb[h].w * inv);
            *(uint2*)(HM8 + (size_t)row * P8 + h * DV + 8 * lane) = o; }
        amax = 0.f;
#pragma unroll
        for (int j = 0; j < 8; ++j) { un8(*(const v4u*)(AT + (size_t)row * PK + 8 * lane + 512 * j), va[j], vb[j]); amax = fmaxf(amax, amax8(va[j], vb[j])); }
        amax = wave_max(amax); inv = amax > 0.f ? 127.0f / amax : 0.f; if (lane == 0) RSAT[row] = amax * (1.0f / 127.0f);
#pragma unroll
        for (int j = 0; j < 8; ++j) { uint2 o; o.x = q4(va[j].x * inv, va[j].y * inv, va[j].z * inv, va[j].w * inv); o.y = q4(vb[j].x * inv, vb[j].y * inv, vb[j].z * inv, vb[j].w * inv);
            *(uint2*)(AT8 + (size_t)row * P8 + 8 * lane + 512 * j) = o; }
    }
}

__device__ __forceinline__ void p8_rows(const Args& A, int lane, int wave, int G) {
    const int gw = blockIdx.x * NWAVES + wave, NGW = G * NWAVES;
    const float* MOD = (const float*)(A.ws + WS_MOD); const float* ng = A.in[6];
    const bf16* MIX = (const bf16*)(A.ws + WS_MIX); unsigned char* U28 = A.ws + WS_U28; float* RS2 = (float*)(A.ws + WS_RS2); bf16* H1 = (bf16*)(A.ws + WS_HB);
    for (int m = gw; m < ML; m += NGW) {
        const int r = m / SEQ; const size_t ro = (size_t)m * DM + 8 * lane; const int co = 8 * lane;
        f32x4 va[8], vb[8]; float ss = 0.f;
#pragma unroll
        for (int j = 0; j < 8; ++j) { un8(*(const v4u*)(MIX + ro + 512 * j), va[j], vb[j]); ss += sq8(va[j], vb[j]); }
        const float rstd = __builtin_amdgcn_rsqf(wave_sum(ss) * (1.0f / DM) + EPS);
        const float* n1 = ng + DM + co; const float* g1 = MOD + r * NMOD + 2 * DM + co; const float* x = A.in[0] + ro; float ss2 = 0.f;
#pragma unroll
        for (int j = 0; j < 8; ++j) { f32x4 xa, xb, na, nb, ga, gb; ld8f_nt(x + 512 * j, xa, xb); ld8f(n1 + 512 * j, na, nb); ld8f(g1 + 512 * j, ga, gb);
            va[j] = xa + ga * (va[j] * rstd * na); vb[j] = xb + gb * (vb[j] * rstd * nb); ss2 += sq8(va[j], vb[j]);
            { v4u hw; hw.x = pk2(va[j].x, va[j].y); hw.y = pk2(va[j].z, va[j].w); hw.z = pk2(vb[j].x, vb[j].y); hw.w = pk2(vb[j].z, vb[j].w); *(v4u*)(H1 + ro + 512 * j) = hw; } }
        const float rstd2 = __builtin_amdgcn_rsqf(wave_sum(ss2) * (1.0f / DM) + EPS);
        const float* n2 = ng + 2 * DM + co; const float* sh2 = MOD + r * NMOD + 3 * DM + co; const float* s2 = MOD + r * NMOD + 4 * DM + co;
        float amax = 0.f;
#pragma unroll
        for (int j = 0; j < 8; ++j) { f32x4 na, nb, ha, hb, sa, sb; ld8f(n2 + 512 * j, na, nb); ld8f(sh2 + 512 * j, ha, hb); ld8f(s2 + 512 * j, sa, sb);
            va[j] = (va[j] * rstd2 * na) * (1.0f + sa) + ha; vb[j] = (vb[j] * rstd2 * nb) * (1.0f + sb) + hb;
            amax = fmaxf(amax, fmaxf(fmaxf(fmaxf(fabsf(va[j].x), fabsf(va[j].y)), fmaxf(fabsf(va[j].z), fabsf(va[j].w))), fmaxf(fmaxf(fabsf(vb[j].x), fabsf(vb[j].y)), fmaxf(fabsf(vb[j].z), fabsf(vb[j].w))))); }
        amax = wave_max(amax); const float inv = amax > 0.f ? 127.0f / amax : 0.f; if (lane == 0) RS2[m] = amax * (1.0f / 127.0f);
#pragma unroll
        for (int j = 0; j < 8; ++j) { uint2 o; o.x = q4(va[j].x * inv, va[j].y * inv, va[j].z * inv, va[j].w * inv); o.y = q4(vb[j].x * inv, vb[j].y * inv, vb[j].z * inv, vb[j].w * inv);
            *(uint2*)(U28 + (size_t)m * P8 + co + 512 * j) = o; }
    }
}

__device__ __forceinline__ void p11_rows(const Args& A, int lane, int wave, int G, bool poison) {
    const int gw = blockIdx.x * NWAVES + wave, NGW = G * NWAVES;
    const float* MOD = (const float*)(A.ws + WS_MOD); const float* ng = A.in[6];
    const bf16* Fb = (const bf16*)(A.ws + WS_F); const bf16* H1 = (const bf16*)(A.ws + WS_HB);
    for (int m = gw; m < ML; m += NGW) {
        const int r = m / SEQ; const size_t ro = (size_t)m * DM + 8 * lane; const int co = 8 * lane;
        f32x4 va[8], vb[8]; float ss = 0.f;
#pragma unroll
        for (int j = 0; j < 8; ++j) { un8(*(const v4u*)(Fb + ro + 512 * j), va[j], vb[j]); ss += sq8(va[j], vb[j]); }
        const float rstd3 = __builtin_amdgcn_rsqf(wave_sum(ss) * (1.0f / DM) + EPS);
        const float* n3 = ng + 3 * DM + co; const float* g2 = MOD + r * NMOD + 5 * DM + co;
        const float qn = __builtin_nanf("");
#pragma unroll
        for (int j = 0; j < 8; ++j) { f32x4 ma, mb, ta, tb, ha, hb; un8(*(const v4u*)(H1 + ro + 512 * j), ma, mb);
            ld8f(n3 + 512 * j, ta, tb); ld8f(g2 + 512 * j, ha, hb);
            f32x4 oa = ma + ha * (va[j] * rstd3 * ta), ob = mb + hb * (vb[j] * rstd3 * tb);
            if (poison) { oa = (f32x4){qn, qn, qn, qn}; ob = oa; }
            __builtin_nontemporal_store(oa, (f32x4*)(A.out + ro + 512 * j)); __builtin_nontemporal_store(ob, (f32x4*)(A.out + ro + 512 * j + 4)); }
    }
}

__global__ void __launch_bounds__(NWAVES * 64, 2) fwd_kernel(Args args) {
    extern __shared__ __attribute__((aligned(16))) unsigned char lds_raw[];
    LAS unsigned char* lds = (LAS unsigned char*)lds_raw;
    volatile LAS unsigned* MISC = (volatile LAS unsigned*)(lds + MISC_OFF);
    const int tid0 = threadIdx.x, wave = __builtin_amdgcn_readfirstlane(tid0 >> 6), G = gridDim.x;
    unsigned char* ws = args.ws;
    gu32* ctl = (gu32*)(ws + WS_CTL);
    for (int u = tid0; u < (LDS_BYTES - LDSCTL_OFF) / 4; u += NWAVES * 64) ((LAS unsigned*)(lds + LDSCTL_OFF))[u] = 0u;
    __syncthreads();
    XcdBarrier bar; bar.wave = wave; bar.bar = (unsigned*)(ctl + CW_BAR); bar.x = 0; bar.st = nullptr;
    if (N_LAUNCHES == 1) bar = xcd_barrier_post((unsigned*)(ctl + CW_BAR), MISC + 8, wave);
    const int lo = args.ph_lo, hi = args.ph_hi;
#define IN(k) (lo <= (k) && (k) < hi)
#define PHASE_IDS const int lane = (int)__builtin_amdgcn_mbcnt_hi(~0u, __builtin_amdgcn_mbcnt_lo(~0u, 0u)); const int tid = wave * 64 + lane
#define SEAM(k) do { if (IN(k) && IN((k) + 1)) xcd_barrier(bar); } while (0)

    if (IN(0)) {
        p0_bigs(args, lds, wave, G);
        __syncthreads();
        int lane; asm volatile("v_mbcnt_lo_u32_b32 %0, -1, 0\n\tv_mbcnt_hi_u32_b32 %0, -1, %0" : "=v"(lane)); const int tid = wave * 64 + lane;
        p0_prologue(args, lds, tid, lane, wave, G); } SEAM(0);
    if (IN(1)) { PHASE_IDS; p1_rows(args, lane, wave, G); } SEAM(1);
    if (IN(2)) { PHASE_IDS;
        { pg8::Gemm g{(const pg8::bf16_t*)(ws + WS_U), (const pg8::bf16_t*)(ws + WS_WIN), MT, NP, DM, PK, PK}; pg8::ProjOrder S; S.init(G, (int)blockIdx.x);
          pg8::Epi8<pg8::FProj> E{{(pg8::bf16_t*)(ws + WS_P), (float*)(ws + WS_G), (const float*)(ws + WS_ROT), NP, OFF_GM / 256}};
          pg8::gemm_phase<pg8::Epi8<pg8::FProj>, pg8::ProjOrder, true, true>(lds + RING_OFF, g, S, E, wave); }
        { pg8::Gemm g{(const pg8::bf16_t*)(ws + WS_U8), (const pg8::bf16_t*)(ws + WS_W8G), MT, N8P, DM / 2, P8 / 2, P8 / 2}; pg8::ProjOrderI8 S; S.init(G, (int)blockIdx.x, 32 * 17 + 4 * 9);
          pg8::Epi8B<pg8::FProjI8> E{{(pg8::bf16_t*)(ws + WS_P), (const float*)(ws + WS_RSU), (const float*)(ws + WS_CSG), (const float*)(ws + WS_ROT), NP, OFF_KM}};
          pg8::gemm_phase<pg8::Epi8B<pg8::FProjI8>, pg8::ProjOrderI8, true, true, true>(lds + RING_OFF, g, S, E, wave); }
    } SEAM(2);
    if (IN(3)) { PHASE_IDS;
        for (int item = blockIdx.x; item < NB * MH * 2 * 4; item += G) ml::mlstm_item(args, lds, tid, lane, wave, item);
        __syncthreads();
        { PHASE_IDS; at::attn_items(args, lds, tid, lane, wave, G); }
        __syncthreads();
    } SEAM(3);
    if (IN(4)) { PHASE_IDS; p5_readout(args, lane, wave, G); } SEAM(4);
    if (IN(5)) { PHASE_IDS;
        { pg8::Gemm g{(const pg8::bf16_t*)(ws + WS_HM8), (const pg8::bf16_t*)(ws + WS_W8OM), ML, DM, DM / 2, P8 / 2, P8 / 2}; pg8::StaticOrder S; S.init(ML, DM, G, (int)blockIdx.x);
          pg8::Epi8B<pg8::FGateM8> E{{(const pg8::bf16_t*)(ws + WS_P) + OFF_BGM, NP, (pg8::bf16_t*)(ws + WS_T), DM, (const float*)(ws + WS_RSHM), (const float*)(ws + WS_CSOM)}};
          pg8::gemm_phase<pg8::Epi8B<pg8::FGateM8>, pg8::StaticOrder, true, true, true>(lds + RING_OFF, g, S, E, wave); }
        { pg8::Gemm g{(const pg8::bf16_t*)(ws + WS_AT8), (const pg8::bf16_t*)(ws + WS_W8OA), ML, DM, DM / 2, P8 / 2, P8 / 2}; pg8::StaticOrder S; S.init(ML, DM, G, (int)blockIdx.x);
          pg8::Epi8B<pg8::FGateA8> E{{(const pg8::bf16_t*)(ws + WS_P) + OFF_BGA, NP, (const pg8::bf16_t*)(ws + WS_T), (pg8::bf16_t*)(ws + WS_YG), DM, PK, (const float*)(ws + WS_RSAT), (const float*)(ws + WS_CSOA)}};
          pg8::gemm_phase<pg8::Epi8B<pg8::FGateA8>, pg8::StaticOrder, true, true, true>(lds + RING_OFF, g, S, E, wave); }
    } SEAM(5);
    if (IN(6)) { PHASE_IDS;
        pg8::Gemm g{(const pg8::bf16_t*)(ws + WS_YG), (const pg8::bf16_t*)(ws + WS_WO), ML, DM, DM, PK, PK}; pg8::StaticOrder S; S.init(ML, DM, G, (int)blockIdx.x);
        pg8::Epi8<pg8::FBf16> E{{(pg8::bf16_t*)(ws + WS_MIX), DM}};
        pg8::gemm_phase<pg8::Epi8<pg8::FBf16>, pg8::StaticOrder, true, true>(lds + RING_OFF, g, S, E, wave);
    } SEAM(6);
    if (IN(7)) { PHASE_IDS; p8_rows(args, lane, wave, G); } SEAM(7);
    if (IN(8)) { PHASE_IDS;
        pg8::Gemm g{(const pg8::bf16_t*)(ws + WS_U28), (const pg8::bf16_t*)(ws + WS_W8F), ML, DFF, DM / 2, P8 / 2, P8 / 2}; pg8::StaticOrder S; S.init(ML, DFF, G, (int)blockIdx.x);
        pg8::Epi8B<pg8::FRelu2I8> E{{(pg8::bf16_t*)(ws + WS_HDN), (const float*)(ws + WS_RS2), (const float*)(ws + WS_CSF), PF}};
        pg8::gemm_phase<pg8::Epi8B<pg8::FRelu2I8>, pg8::StaticOrder, true, true, true>(lds + RING_OFF, g, S, E, wave);
    } SEAM(8);
    if (IN(9)) { PHASE_IDS;
        pg8::Gemm g{(const pg8::bf16_t*)(ws + WS_HDN), (const pg8::bf16_t*)(ws + WS_WF2), ML, DM, DFF, PF, PF}; pg8::StaticOrder S; S.init(ML, DM, G, (int)blockIdx.x);
        pg8::Epi8<pg8::FBf16> E{{(pg8::bf16_t*)(ws + WS_F), DM}};
        pg8::gemm_phase<pg8::Epi8<pg8::FBf16>, pg8::StaticOrder, true, true>(lds + RING_OFF, g, S, E, wave);
    } SEAM(9);
    if (IN(10)) { PHASE_IDS;
        const bool poison = (N_LAUNCHES == 1) && (__hip_atomic_load(ctl + CW_BAR + XB_TMO, RLX_AGENT) != 0u);
        p11_rows(args, lane, wave, G, poison);
    }
#undef IN
#undef SEAM
}

extern "C" void kernel_launch(void* const* d_in, const int* in_sizes, int n_in, void* d_out, int out_size, void* d_ws, size_t ws_size, hipStream_t stream) {
    static int grid = 0;
    if (grid == 0) {
        if (n_in != 16 || out_size != ML * DM || ws_size < WS_END2) { fprintf(stderr, "kernel_launch: unexpected shapes: n_in %d out %d ws %zu (need %zu); nothing launched\n", n_in, out_size, ws_size, (size_t)WS_END2); grid = -1; return; }
        int dev = 0, cus = 0, per_cu = 0;
        if (hipGetDevice(&dev) != hipSuccess || hipDeviceGetAttribute(&cus, hipDeviceAttributeMultiprocessorCount, dev) != hipSuccess) { grid = -1; return; }
        if (hipFuncSetAttribute((const void*)fwd_kernel, hipFuncAttributeMaxDynamicSharedMemorySize, LDS_BYTES) != hipSuccess) { fprintf(stderr, "kernel_launch: hipFuncSetAttribute failed\n"); grid = -1; return; }
        if (hipOccupancyMaxActiveBlocksPerMultiprocessor(&per_cu, (const void*)fwd_kernel, NWAVES * 64, LDS_BYTES) != hipSuccess || per_cu < 1)
            fprintf(stderr, "kernel_launch: note: occupancy query reports %d workgroups per CU\n", per_cu);
        (void)hipGetLastError();
        grid = cus;
    }
    if (grid < 0) return;
    if (hipMemsetAsync((char*)d_ws + WS_CTL, 0, CTL_ZERO_BYTES, stream) != hipSuccess) { fprintf(stderr, "kernel_launch: memset failed\n"); return; }
    Args a{};
    for (int i = 0; i < 16; ++i) a.in[i] = (const float*)d_in[i];
    a.out = (float*)d_out; a.ws = (unsigned char*)d_ws;
    for (int li = 0; li < N_LAUNCHES; ++li) {
        a.ph_lo = (N_LAUNCHES == 1) ? 0 : li; a.ph_hi = (N_LAUNCHES == 1) ? N_PHASES : li + 1;
        hipLaunchKernelGGL(fwd_kernel, dim3(grid), dim3(NWAVES * 64), LDS_BYTES, stream, a);
        const hipError_t le = hipPeekAtLastError();
        if (le != hipSuccess) { fprintf(stderr, "kernel_launch: launch %d failed: %s\n", li, hipGetErrorName(le)); break; }
    }
}
```

```cpp
#define MK_N_LAUNCHES 1
#include <hip/hip_runtime.h>
#include <cstdio>
#include <cstdint>
namespace pg8 {
#define PG8_LAS __attribute__((address_space(3)))
typedef unsigned short bf16_t;
typedef short bf16x8 __attribute__((ext_vector_type(8)));
typedef float f32x4 __attribute__((ext_vector_type(4)));
typedef unsigned u32x4 __attribute__((ext_vector_type(4)));
constexpr int BM = 256, BK = 64, HALF = 128, HTB = HALF * BK * 2  , STAGE_BYTES = 8 * HTB, NXCD = 8, WGM = 8;

__host__ __device__ __forceinline__ int lds_byte(int r, int c) { const int st = (r >> 4) * 2 + (c >> 5), rr = r & 15, cc = c & 31, ob = rr * 64 + cc * 2; return st * 1024 + (ob ^ (((ob >> 9) & 1) << 5)); }
__host__ __device__ __forceinline__ void stage_rc(int b, int& R, int& C) { const int st = b / 1024, sb = b % 1024, swz = sb ^ (((sb >> 9) & 1) << 5); R = (st >> 1) * 16 + swz / 64; C = (st & 1) * 32 + (swz % 64) / 2; }
__host__ __device__ __forceinline__ int perm32(int rho) { const int n = rho >> 4, i = rho & 15; return 8 * (i >> 2) + 4 * n + (i & 3); }

struct Unit { int pm, pn; };
struct Gemm { const bf16_t* A; const bf16_t* Bt; int M, N, K, lda, ldb; };

struct StaticOrder {
    int nM, nN, nwg, G, c;
    __host__ __device__ void init(int M, int N, int G_, int c_) { nM = M / BM; nN = N / BM; nwg = nM * nN; G = G_; c = c_; }
    __host__ __device__ bool next(int i, Unit& u) const { return at((long)i * G + c, u); }
    __host__ __device__ bool at(const long L, Unit& u) const {
        if (L >= nwg) return false;
        int wgid = (int)L; { const int q = nwg / NXCD, r = nwg % NXCD, xcd = wgid % NXCD, off = wgid / NXCD; wgid = (xcd < r ? xcd * (q + 1) : r * (q + 1) + (xcd - r) * q) + off; }
        const int nig = WGM * nN, gid = wgid / nig, fm = gid * WGM, gsz = (nM - fm) < WGM ? (nM - fm) : WGM;
        u.pm = fm + ((wgid % nig) % gsz); u.pn = (wgid % nig) / gsz; return true;
    }
    __device__ __forceinline__ void a_ready(const Unit&) const {}
    __device__ __forceinline__ void done(const Unit&) const {}
};

__device__ __forceinline__ unsigned cvt_pk_bf16(float lo, float hi) { unsigned r; asm volatile("v_cvt_pk_bf16_f32 %0, %1, %2" : "=v"(r) : "v"(lo), "v"(hi)); return r; }
typedef float f32x2 __attribute__((ext_vector_type(2)));

__device__ __forceinline__ float bf_lo(unsigned w) { return __builtin_bit_cast(float, w << 16); }
__device__ __forceinline__ float bf_hi(unsigned w) { return __builtin_bit_cast(float, w & 0xffff0000u); }
__device__ __forceinline__ float sigmoidf_(float x) { return __builtin_amdgcn_rcpf(1.0f + __expf(-x)); }
template <class F> struct Epi8 {
    static constexpr bool PERM = true, AFTER_DRAIN = false;
    F f;
    __device__ __forceinline__ void operator()(const f32x4 (&acc)[2][2][4][2], const Unit& u, int wr, int wc, int fr, int fq) const {
        const int row0 = u.pm * BM + wr * 64 + fr, col0 = u.pn * BM + wc * 32 + 8 * fq;
#pragma unroll
        for (int ai = 0; ai < 2; ++ai)
#pragma unroll
            for (int m = 0; m < 4; ++m) { const int row = row0 + ai * HALF + m * 16;
#pragma unroll
                for (int bj = 0; bj < 2; ++bj) f(row, col0 + bj * HALF, acc[ai][bj][m][0], acc[ai][bj][m][1], u.pn); }
    }
};
struct EpiSt { u32x4* p; u32x4 v; };
template <class F> struct Epi8B {
    static constexpr bool PERM = true, AFTER_DRAIN = false;
    F f;
    __device__ __forceinline__ void operator()(const f32x4 (&acc)[2][2][4][2], const Unit& u, int wr, int wc, int fr, int fq) const {
        const int row0 = u.pm * BM + wr * 64 + fr, col0 = u.pn * BM + wc * 32 + 8 * fq;
        f32x4 cc[2][2]; float rr[2][4];
#pragma unroll
        for (int bj = 0; bj < 2; ++bj) { cc[bj][0] = *(const f32x4*)(f.cs + col0 + bj * HALF); cc[bj][1] = *(const f32x4*)(f.cs + col0 + bj * HALF + 4); }
#pragma unroll
        for (int ai = 0; ai < 2; ++ai)
#pragma unroll
            for (int m = 0; m < 4; ++m) rr[ai][m] = f.rs[row0 + ai * HALF + m * 16];
#pragma unroll
        for (int ai = 0; ai < 2; ++ai) {
            decltype(f.calc(0, 0, acc[0][0][0][0], acc[0][0][0][1], 0, 0.f, cc[0][0], cc[0][1])) st[4][2];
#pragma unroll
            for (int m = 0; m < 4; ++m)
#pragma unroll
                for (int bj = 0; bj < 2; ++bj) st[m][bj] = f.calc(row0 + ai * HALF + m * 16, col0 + bj * HALF, acc[ai][bj][m][0], acc[ai][bj][m][1], u.pn, rr[ai][m], cc[bj][0], cc[bj][1]);
#pragma unroll
            for (int m = 0; m < 4; ++m)
#pragma unroll
                for (int bj = 0; bj < 2; ++bj) f.put(st[m][bj]);
        }
    }
};
__device__ __forceinline__ u32x4 pack8(const f32x4& v0, const f32x4& v1) { u32x4 w; w.x = cvt_pk_bf16(v0[0], v0[1]); w.y = cvt_pk_bf16(v0[2], v0[3]); w.z = cvt_pk_bf16(v1[0], v1[1]); w.w = cvt_pk_bf16(v1[2], v1[3]); return w; }
struct FProj { bf16_t* P; float* G; const float* ROT; int ldp; int gate_pn;
    __device__ __forceinline__ void operator()(int row, int col, const f32x4& v0, const f32x4& v1, int pn) const {
        if (pn == gate_pn) { const int cl = col - gate_pn * BM; if (cl < 32) { *(f32x4*)(G + (size_t)row * 32 + cl) = v0; *(f32x4*)(G + (size_t)row * 32 + cl + 4) = v1; } }
        else if (pn < 8) *(u32x4*)(P + (size_t)row * ldp + col) = pack8(v0 * 0.0625f, v1 * 0.0625f);
        else if (pn >= 48 && pn < 68 && row < 8192) { const int hp = col & 127, t = row & 2047, pos = (hp & 64) ? (t & 63) : (t >> 6), i0 = (hp & 63) >> 1;
            const f32x4 cs = *(const f32x4*)(ROT + pos * 32 + i0), sn = *(const f32x4*)(ROT + 2048 + pos * 32 + i0);
            *(u32x4*)(P + (size_t)row * ldp + col) = pack8(v0 * cs - v1 * sn, v0 * sn + v1 * cs); }
        else *(u32x4*)(P + (size_t)row * ldp + col) = pack8(v0, v1);
    } };
struct ProjOrder {
    StaticOrder base; int G, c;
    __host__ __device__ void init(int G_, int c_) { base.init(8192, 17 * 256, G_, c_); G = G_; c = c_; }
    __host__ __device__ bool next(int i, Unit& u) const { const long L = (long)i * G + c;
        if (L < base.nwg) { base.next(i, u); if (u.pn == 16) u.pn = 104; return true; }
        const int r = (int)(L - base.nwg); if (r >= 4 * 9) return false; u.pm = 32 + (r & 3); const int j = r >> 2; u.pn = j < 8 ? 8 + j : 104; return true; }
    __device__ __forceinline__ void a_ready(const Unit&) const {}
    __device__ __forceinline__ void done(const Unit&) const {}
};
struct ProjOrderI8 {
    StaticOrder base; int G, c, nheavy, qh;
    __host__ __device__ void init(int G_, int c_, int n_bf16_units) { base.init(8192, 88 * 256, G_, 0); G = G_; c = c_; nheavy = n_bf16_units % G_;
        const int ni = base.nwg + 4 * 24; int q = (ni - 2 * (G_ - nheavy) + G_ - 1) / G_; qh = q < 0 ? 0 : q; }
    __host__ __device__ bool next(int i, Unit& u) const {
        long L; if (i < qh) L = (long)i * G + c; else { if (c < nheavy) return false; L = (long)qh * G + (long)(i - qh) * (G - nheavy) + (c - nheavy); }
        if (L < base.nwg) { base.at(L, u); u.pn += 8; return true; }
        const int r = (int)(L - base.nwg); if (r >= 4 * 24) return false; u.pm = 32 + (r & 3); const int j = r >> 2; u.pn = j < 16 ? 8 + j : 40 + j; return true; }
    __device__ __forceinline__ void a_ready(const Unit&) const {}
    __device__ __forceinline__ void done(const Unit&) const {}
};
__device__ __forceinline__ float i2f(float bits) { return (float)__builtin_bit_cast(int, bits); }
__device__ __forceinline__ f32x4 i2f4(const f32x4& v) { return (f32x4){i2f(v[0]), i2f(v[1]), i2f(v[2]), i2f(v[3])}; }
struct FProjI8 { bf16_t* P; const float* rs; const float* cs; const float* ROT; int ldp; int off_a;
    __device__ __forceinline__ void put(const EpiSt& s_) const { *s_.p = s_.v; }
    __device__ __forceinline__ EpiSt calc(int row, int col, const f32x4& v0, const f32x4& v1, int pn, float r, const f32x4& cc0, const f32x4& cc1) const {
        const f32x4 c0 = cc0 * r, c1 = cc1 * r;
        f32x4 a = i2f4(v0) * c0, b = i2f4(v1) * c1;
        const int oc = off_a + col;
        if (pn >= 40 && pn < 60 && row < 8192) { const int hp = oc & 127, t = row & 2047, pos = (hp & 64) ? (t & 63) : (t >> 6), i0 = (hp & 63) >> 1;
            const f32x4 csn = *(const f32x4*)(ROT + pos * 32 + i0), sn = *(const f32x4*)(ROT + 2048 + pos * 32 + i0);
            const f32x4 ra = a * csn - b * sn, rb = a * sn + b * csn; a = ra; b = rb; }
        return EpiSt{(u32x4*)(P + (size_t)row * ldp + oc), pack8(a, b)};
    } };
struct FGateM { const bf16_t* Pg; int ldp; bf16_t* T; int ldt;
    __device__ __forceinline__ void operator()(int row, int col, const f32x4& v0, const f32x4& v1, int) const {
        const u32x4 g = *(const u32x4*)(Pg + (size_t)row * ldp + col);
        f32x4 a, b; a[0] = sigmoidf_(bf_lo(g.x)) * v0[0]; a[1] = sigmoidf_(bf_hi(g.x)) * v0[1]; a[2] = sigmoidf_(bf_lo(g.y)) * v0[2]; a[3] = sigmoidf_(bf_hi(g.y)) * v0[3];
        b[0] = sigmoidf_(bf_lo(g.z)) * v1[0]; b[1] = sigmoidf_(bf_hi(g.z)) * v1[1]; b[2] = sigmoidf_(bf_lo(g.w)) * v1[2]; b[3] = sigmoidf_(bf_hi(g.w)) * v1[3];
        *(u32x4*)(T + (size_t)row * ldt + col) = pack8(a, b);
    } };
struct FGateA { const bf16_t* Pg; int ldp; const bf16_t* T; bf16_t* Y; int ldt, ldy;
    __device__ __forceinline__ void operator()(int row, int col, const f32x4& v0, const f32x4& v1, int) const {
        const u32x4 g = *(const u32x4*)(Pg + (size_t)row * ldp + col), t = *(const u32x4*)(T + (size_t)row * ldt + col);
        f32x4 a, b;
        a[0] = bf_lo(t.x) + sigmoidf_(bf_lo(g.x)) * v0[0]; a[1] = bf_hi(t.x) + sigmoidf_(bf_hi(g.x)) * v0[1]; a[2] = bf_lo(t.y) + sigmoidf_(bf_lo(g.y)) * v0[2]; a[3] = bf_hi(t.y) + sigmoidf_(bf_hi(g.y)) * v0[3];
        b[0] = bf_lo(t.z) + sigmoidf_(bf_lo(g.z)) * v1[0]; b[1] = bf_hi(t.z) + sigmoidf_(bf_hi(g.z)) * v1[1]; b[2] = bf_lo(t.w) + sigmoidf_(bf_lo(g.w)) * v1[2]; b[3] = bf_hi(t.w) + sigmoidf_(bf_hi(g.w)) * v1[3];
        *(u32x4*)(Y + (size_t)row * ldy + col) = pack8(a, b);
    } };
struct FGateM8 { const bf16_t* Pg; int ldp; bf16_t* T; int ldt; const float* rs; const float* cs;
    __device__ __forceinline__ void put(const EpiSt& s_) const { *s_.p = s_.v; }
    __device__ __forceinline__ EpiSt calc(int row, int col, const f32x4& v0, const f32x4& v1, int, float r, const f32x4& cc0, const f32x4& cc1) const {
        const f32x4 c0 = cc0 * r, c1 = cc1 * r;
        const u32x4 g = *(const u32x4*)(Pg + (size_t)row * ldp + col);
        f32x4 a, b; a[0] = sigmoidf_(bf_lo(g.x)) * i2f(v0[0]) * c0[0]; a[1] = sigmoidf_(bf_hi(g.x)) * i2f(v0[1]) * c0[1]; a[2] = sigmoidf_(bf_lo(g.y)) * i2f(v0[2]) * c0[2]; a[3] = sigmoidf_(bf_hi(g.y)) * i2f(v0[3]) * c0[3];
        b[0] = sigmoidf_(bf_lo(g.z)) * i2f(v1[0]) * c1[0]; b[1] = sigmoidf_(bf_hi(g.z)) * i2f(v1[1]) * c1[1]; b[2] = sigmoidf_(bf_lo(g.w)) * i2f(v1[2]) * c1[2]; b[3] = sigmoidf_(bf_hi(g.w)) * i2f(v1[3]) * c1[3];
        return EpiSt{(u32x4*)(T + (size_t)row * ldt + col), pack8(a, b)};
    } };
struct FGateA8 { const bf16_t* Pg; int ldp; const bf16_t* T; bf16_t* Y; int ldt, ldy; const float* rs; const float* cs;
    __device__ __forceinline__ void put(const EpiSt& s_) const { *s_.p = s_.v; }
    __device__ __forceinline__ EpiSt calc(int row, int col, const f32x4& v0, const f32x4& v1, int, float r, const f32x4& cc0, const f32x4& cc1) const {
        const f32x4 c0 = cc0 * r, c1 = cc1 * r;
        const u32x4 g = *(const u32x4*)(Pg + (size_t)row * ldp + col), t = *(const u32x4*)(T + (size_t)row * ldt + col);
        f32x4 a, b;
        a[0] = bf_lo(t.x) + sigmoidf_(bf_lo(g.x)) * i2f(v0[0]) * c0[0]; a[1] = bf_hi(t.x) + sigmoidf_(bf_hi(g.x)) * i2f(v0[1]) * c0[1]; a[2] = bf_lo(t.y) + sigmoidf_(bf_lo(g.y)) * i2f(v0[2]) * c0[2]; a[3] = bf_hi(t.y) + sigmoidf_(bf_hi(g.y)) * i2f(v0[3]) * c0[3];
        b[0] = bf_lo(t.z) + sigmoidf_(bf_lo(g.z)) * i2f(v1[0]) * c1[0]; b[1] = bf_hi(t.z) + sigmoidf_(bf_hi(g.z)) * i2f(v1[1]) * c1[1]; b[2] = bf_lo(t.w) + sigmoidf_(bf_lo(g.w)) * i2f(v1[2]) * c1[2]; b[3] = bf_hi(t.w) + sigmoidf_(bf_hi(g.w)) * i2f(v1[3]) * c1[3];
        return EpiSt{(u32x4*)(Y + (size_t)row * ldy + col), pack8(a, b)};
    } };
struct FF32 { float* C; int ldc;
    __device__ __forceinline__ void operator()(int row, int col, const f32x4& v0, const f32x4& v1, int) const { *(f32x4*)(C + (size_t)row * ldc + col) = v0; *(f32x4*)(C + (size_t)row * ldc + col + 4) = v1; } };
struct FBf16 { bf16_t* O; int ldc;
    __device__ __forceinline__ void operator()(int row, int col, const f32x4& v0, const f32x4& v1, int) const { *(u32x4*)(O + (size_t)row * ldc + col) = pack8(v0, v1); } };
struct FRelu2I8 { bf16_t* O; const float* rs; const float* cs; int ldc;
    __device__ __forceinline__ void put(const EpiSt& s_) const { *s_.p = s_.v; }
    __device__ __forceinline__ EpiSt calc(int row, int col, const f32x4& v0, const f32x4& v1, int, float r, const f32x4& cc0, const f32x4& cc1) const {
        const f32x4 c0 = cc0 * r, c1 = cc1 * r;
        f32x4 a = i2f4(v0) * c0, b = i2f4(v1) * c1;
#pragma unroll
        for (int j = 0; j < 4; ++j) { a[j] = fmaxf(a[j], 0.f); b[j] = fmaxf(b[j], 0.f); }
        a = a * a; b = b * b;
        return EpiSt{(u32x4*)(O + (size_t)row * ldc + col), pack8(a, b)};
    } };
struct FRelu2 { bf16_t* O; int ldc;
    __device__ __forceinline__ void operator()(int row, int col, const f32x4& v0, const f32x4& v1, int) const {
        f32x4 a, b;
#pragma unroll
        for (int j = 0; j < 4; ++j) { const float x = fmaxf(v0[j], 0.f), y = fmaxf(v1[j], 0.f); a[j] = x * x; b[j] = y * y; }
        *(u32x4*)(O + (size_t)row * ldc + col) = pack8(a, b);
    } };

typedef int i32x4 __attribute__((ext_vector_type(4)));
template <bool I8> __device__ __forceinline__ f32x4 mma16(const bf16x8& b, const bf16x8& a, const f32x4& c) {
    if constexpr (I8) return __builtin_bit_cast(f32x4, __builtin_amdgcn_mfma_i32_16x16x64_i8(__builtin_bit_cast(i32x4, b), __builtin_bit_cast(i32x4, a), __builtin_bit_cast(i32x4, c), 0, 0, 0));
    else return __builtin_amdgcn_mfma_f32_16x16x32_bf16(b, a, c, 0, 0, 0);
}
template <class Epi, class Sched, bool ALIGN_EPI = false, bool SP2 = false, bool I8 = false>
__device__ __forceinline__ void gemm_phase(PG8_LAS unsigned char* lds, const Gemm g, const Sched& S, const Epi& E, const int wave_id) {
    const int lane = (int)__builtin_amdgcn_mbcnt_hi(~0u, __builtin_amdgcn_mbcnt_lo(~0u, 0u)), wid = wave_id, tid = wid * 64 + lane,
              wr = wid >> 2, wc = wid & 3, fr = lane & 15, fq = lane >> 4;
    const int K = g.K, nt = K / BK;
    unsigned voffA[2], voffB[2];
#pragma unroll
    for (int i = 0; i < 2; ++i) { int R, C; stage_rc(tid * 16 + i * 8192, R, C); const int Rb = Epi::PERM ? ((R & ~31) + perm32(R & 31)) : R;
        voffA[i] = (unsigned)(R * g.lda + C) * 2u; voffB[i] = (unsigned)(Rb * g.ldb + C) * 2u; }
    const size_t kstep = (size_t)(BK * 2);
    const size_t hstepA = (size_t)HALF * g.lda * 2, hstepB = (size_t)HALF * g.ldb * 2;
    const size_t tstepA = 2 * hstepA, tstepB = 2 * hstepB;
    const unsigned ldsw = (unsigned)wid * 1024u;
    const int aoff = lds_byte(wr * 64 + fr, fq * 8), boff = lds_byte(wc * 32 + fr, fq * 8);
#define PG8_SA(b, h) (((b) * 2 + (h)) * HTB)
#define PG8_SB(b, h) ((4 + (b) * 2 + (h)) * HTB)
#define PG8_STAGE(bufoff, gbase, voff) do { _Pragma("unroll") for (int _i = 0; _i < 2; ++_i) \
        __builtin_amdgcn_global_load_lds((const unsigned*)((const char*)(gbase) + (voff)[_i]), (PG8_LAS unsigned*)(lds + (bufoff) + ldsw + _i * 8192), 16, 0, 0); } while (0)
#define PG8_LDA(dst, b, h) do { _Pragma("unroll") for (int m = 0; m < 4; ++m) _Pragma("unroll") for (int k = 0; k < 2; ++k) dst[m][k] = *(const PG8_LAS bf16x8*)(lds + PG8_SA(b, h) + aoff + m * 2048 + k * 1024); } while (0)
#define PG8_LDB(dst, b, h) do { _Pragma("unroll") for (int n = 0; n < 2; ++n) _Pragma("unroll") for (int k = 0; k < 2; ++k) dst[n][k] = *(const PG8_LAS bf16x8*)(lds + PG8_SB(b, h) + boff + n * 2048 + k * 1024); } while (0)
#define PG8_MMA(ai, bj, At, Bt) do { __builtin_amdgcn_s_setprio(1); _Pragma("unroll") for (int m = 0; m < 4; ++m) _Pragma("unroll") for (int n = 0; n < 2; ++n) _Pragma("unroll") for (int k = 0; k < 2; ++k) \
        acc[ai][bj][m][n] = mma16<I8>(Bt[n][k], At[m][k], acc[ai][bj][m][n]); __builtin_amdgcn_s_setprio(0); } while (0)
#define PG8_WAIT_V(n) asm volatile("s_waitcnt vmcnt(" #n ")" ::: "memory")
#define PG8_WAIT_L(n) asm volatile("s_waitcnt lgkmcnt(" #n ")" ::: "memory")
#define PG8_BAR __builtin_amdgcn_s_barrier()
#define PG8_SCHED __builtin_amdgcn_sched_barrier(0)
    Unit cur, nxt; int ui = 0;
    if (!S.next(0, cur)) return;
    f32x4 acc[2][2][4][2];
#pragma unroll
    for (int a = 0; a < 2; ++a)
#pragma unroll
        for (int b = 0; b < 2; ++b)
#pragma unroll
            for (int m = 0; m < 4; ++m)
#pragma unroll
                for (int n = 0; n < 2; ++n) acc[a][b][m][n] = (f32x4){0.f, 0.f, 0.f, 0.f};
    bf16x8 At[4][2], B0[2][2], B1[2][2];
    const char* cA = (const char*)g.A + (size_t)cur.pm * tstepA; const char* cB = (const char*)g.Bt + (size_t)cur.pn * tstepB;
    S.a_ready(cur);
    if constexpr (SP2) {
        PG8_STAGE(PG8_SB(0, 0), cB, voffB); PG8_STAGE(PG8_SB(0, 1), cB + hstepB, voffB); PG8_STAGE(PG8_SA(0, 0), cA, voffA); PG8_STAGE(PG8_SA(0, 1), cA + hstepA, voffA);
        if (wr == 1) PG8_BAR;
        PG8_WAIT_V(2); PG8_BAR;
        PG8_STAGE(PG8_SB(1, 0), cB + kstep, voffB); PG8_STAGE(PG8_SA(1, 0), cA + kstep, voffA); PG8_STAGE(PG8_SB(1, 1), cB + hstepB + kstep, voffB);
        PG8_WAIT_V(6); PG8_BAR;
    } else {
        PG8_STAGE(PG8_SB(0, 0), cB, voffB); PG8_STAGE(PG8_SA(0, 0), cA, voffA); PG8_STAGE(PG8_SB(0, 1), cB + hstepB, voffB); PG8_STAGE(PG8_SA(0, 1), cA + hstepA, voffA);
        if (wr == 1) PG8_BAR;
        PG8_WAIT_V(4); PG8_BAR;
        PG8_STAGE(PG8_SB(1, 0), cB + kstep, voffB); PG8_STAGE(PG8_SA(1, 0), cA + kstep, voffA); PG8_STAGE(PG8_SB(1, 1), cB + hstepB + kstep, voffB);
        PG8_WAIT_V(6); PG8_BAR;
    }
    for (;;) {
        const bool has_next = S.next(ui + 1, nxt);
        const char* nA = has_next ? (const char*)g.A + (size_t)nxt.pm * tstepA : cA; const char* nB = has_next ? (const char*)g.Bt + (size_t)nxt.pn * tstepB : cB;
        for (int t = 0; t < nt; t += 2) {
            const bool last = (t == nt - 2);
            const char* a1 = cA + (size_t)(t + 1) * kstep;
            const char* a2 = last ? nA : cA + (size_t)(t + 2) * kstep; const char* b2 = last ? nB : cB + (size_t)(t + 2) * kstep;
            const char* a3 = a2 + kstep; const char* b3 = b2 + kstep;
            if (last && has_next) S.a_ready(nxt);
            if constexpr (SP2) {
            PG8_LDB(B0, 0, 0); PG8_LDB(B1, 0, 1); PG8_SCHED; PG8_LDA(At, 0, 0); PG8_STAGE(PG8_SA(1, 1), a1 + hstepA, voffA);
            PG8_WAIT_V(8); PG8_WAIT_L(0); PG8_BAR; PG8_MMA(0, 0, At, B0); PG8_MMA(0, 1, At, B1); PG8_BAR; PG8_SCHED;
            PG8_LDA(At, 0, 1); PG8_STAGE(PG8_SB(0, 0), b2, voffB); PG8_STAGE(PG8_SB(0, 1), b2 + hstepB, voffB); PG8_STAGE(PG8_SA(0, 0), a2, voffA);
            PG8_WAIT_V(8); PG8_WAIT_L(0); PG8_BAR; PG8_MMA(1, 0, At, B0); PG8_MMA(1, 1, At, B1); PG8_BAR; PG8_SCHED;
            PG8_LDB(B0, 1, 0); PG8_LDB(B1, 1, 1); PG8_SCHED; PG8_LDA(At, 1, 0); PG8_STAGE(PG8_SA(0, 1), a2 + hstepA, voffA);
            PG8_WAIT_V(8); PG8_WAIT_L(0); PG8_BAR; PG8_MMA(0, 0, At, B0); PG8_MMA(0, 1, At, B1); PG8_BAR; PG8_SCHED;
            PG8_LDA(At, 1, 1); PG8_STAGE(PG8_SB(1, 0), b3, voffB); PG8_STAGE(PG8_SB(1, 1), b3 + hstepB, voffB); PG8_STAGE(PG8_SA(1, 0), a3, voffA);
            PG8_WAIT_V(8); PG8_WAIT_L(0); PG8_BAR; PG8_MMA(1, 0, At, B0); PG8_MMA(1, 1, At, B1); PG8_BAR; PG8_SCHED;
            } else {
            PG8_LDB(B0, 0, 0); PG8_SCHED; PG8_LDA(At, 0, 0); PG8_STAGE(PG8_SA(1, 1), a1 + hstepA, voffA);
            PG8_WAIT_L(8); PG8_BAR; PG8_WAIT_L(0); PG8_MMA(0, 0, At, B0); PG8_BAR; PG8_SCHED;
            PG8_LDB(B1, 0, 1); PG8_STAGE(PG8_SB(0, 0), b2, voffB);
            PG8_BAR; PG8_WAIT_L(0); PG8_MMA(0, 1, At, B1); PG8_BAR;
            PG8_LDA(At, 0, 1); PG8_STAGE(PG8_SA(0, 0), a2, voffA);
            PG8_BAR; PG8_WAIT_L(0); PG8_MMA(1, 0, At, B0); PG8_BAR; PG8_SCHED;
            PG8_STAGE(PG8_SB(0, 1), b2 + hstepB, voffB);
            PG8_WAIT_V(6); PG8_BAR; PG8_MMA(1, 1, At, B1); PG8_BAR;
            PG8_LDB(B0, 1, 0); PG8_SCHED; PG8_LDA(At, 1, 0); PG8_STAGE(PG8_SA(0, 1), a2 + hstepA, voffA);
            PG8_WAIT_L(8); PG8_BAR; PG8_WAIT_L(0); PG8_MMA(0, 0, At, B0); PG8_BAR; PG8_SCHED;
            PG8_LDB(B1, 1, 1); PG8_STAGE(PG8_SB(1, 0), b3, voffB);
            PG8_BAR; PG8_WAIT_L(0); PG8_MMA(0, 1, At, B1); PG8_BAR;
            PG8_LDA(At, 1, 1); PG8_STAGE(PG8_SA(1, 0), a3, voffA);
            PG8_BAR; PG8_WAIT_L(0); PG8_MMA(1, 0, At, B0); PG8_BAR; PG8_SCHED;
            PG8_STAGE(PG8_SB(1, 1), b3 + hstepB, voffB);
            PG8_WAIT_V(6); PG8_BAR; PG8_MMA(1, 1, At, B1); PG8_BAR;
            }
        }
        if constexpr (ALIGN_EPI) { if (wr == 0) PG8_BAR; }
        if constexpr (!Epi::AFTER_DRAIN) { E(acc, cur, wr, wc, fr, fq); S.done(cur); }
        if (!has_next) break;
#pragma unroll
        for (int a = 0; a < 2; ++a)
#pragma unroll
            for (int b = 0; b < 2; ++b)
#pragma unroll
                for (int m = 0; m < 4; ++m)
#pragma unroll
                    for (int n = 0; n < 2; ++n) acc[a][b][m][n] = (f32x4){0.f, 0.f, 0.f, 0.f};
        cur = nxt; cA = nA; cB = nB; ++ui;
        if constexpr (ALIGN_EPI) { if (wr == 1) PG8_BAR; }
    }
    PG8_WAIT_V(0);
    if constexpr (!ALIGN_EPI) { if (wr == 0) PG8_BAR; }
    PG8_BAR;
    if constexpr (Epi::AFTER_DRAIN) { E.fused(acc, cur, wr, wc, fr, fq, lds, wid, lane); S.done(cur); }
#undef PG8_SA
#undef PG8_SB
#undef PG8_STAGE
#undef PG8_LDA
#undef PG8_LDB
#undef PG8_MMA
#undef PG8_WAIT_V
#undef PG8_WAIT_L
#undef PG8_BAR
#undef PG8_SCHED
}
}

constexpr int NWAVES = 8;
#ifndef MK_N_LAUNCHES
#define MK_N_LAUNCHES 1
#endif
constexpr int N_PHASES = 11;
constexpr int N_LAUNCHES = MK_N_LAUNCHES;
static_assert(N_LAUNCHES == 1 || N_LAUNCHES == N_PHASES, "MK_N_LAUNCHES is 1 or N_PHASES");

constexpr int DM = 4096, NB = 4, SEQ = 2048, CTXL = 256, ML = NB * SEQ, MC = NB * CTXL, MT = ML + MC;
constexpr int DFF = 16384, NMOD = 6 * DM;
constexpr int PK = DM + 64, PF = DFF + 64;
constexpr int NPW = 26656, NP = 26880;
constexpr int OFF_QM = 0, OFF_KM = 2048, OFF_VM = 4096, OFF_OM = 8192, OFF_QA = 12288, OFF_KA = 16384, OFF_VA = 17408, OFF_BGM = 18432, OFF_BGA = 22528, OFF_GM = 26624;
constexpr int MH = 8, DQK = 256, DV = 512, AH = 32, AKV = 8, AD = 128, WIN = 128;
constexpr float EPS = 1e-6f;

constexpr size_t MiB = 1u << 20;
constexpr size_t WS_CTL = 0, CTL_ZERO_BYTES = 1 * MiB;
constexpr size_t WS_MOD = 1 * MiB, WS_ROT = WS_MOD + 512 * 1024, WS_RS1 = WS_ROT + 64 * 1024;
constexpr size_t WS_WIN = 2 * MiB, WS_WOM = 216 * MiB, WS_WOA = 249 * MiB, WS_WO = 282 * MiB, WS_WF1 = 315 * MiB, WS_WF2 = 445 * MiB;
constexpr size_t WS_U = 574 * MiB;
constexpr size_t WS_P = 648 * MiB;
constexpr size_t WS_G = 1121 * MiB;
constexpr size_t WS_HM = 1123 * MiB, WS_AT = 1188 * MiB;
constexpr size_t WS_MIX = 1253 * MiB, WS_HB = 1381 * MiB;
constexpr int P8 = DM + 128;
constexpr int N8P = 24576;
constexpr size_t WS_U8 = 1445 * MiB, WS_W8G = 1483 * MiB, WS_W8F = 1582 * MiB, WS_U28 = WS_AT, WS_END = 1648 * MiB;
constexpr size_t WS_RSU = WS_ROT + 128 * 1024, WS_RS2 = WS_ROT + 192 * 1024, WS_CSG = WS_ROT + 224 * 1024, WS_CSF = WS_ROT + 320 * 1024;
constexpr size_t WS_HM8 = 130 * MiB, WS_AT8 = WS_U8;
constexpr size_t WS_W8OM = WS_HM, WS_W8OA = WS_HM + 17 * MiB, WS_END2 = WS_END;
constexpr size_t WS_RSHM = WS_ROT + 384 * 1024, WS_RSAT = WS_ROT + 416 * 1024, WS_CSOM = WS_ROT + 448 * 1024, WS_CSOA = WS_ROT + 464 * 1024, WS_CMAXO = 768 * 1024;
static_assert(WS_W8OM + (size_t)DM * P8 <= WS_W8OA && WS_W8OA + (size_t)DM * P8 <= WS_AT && WS_CSF + DFF * 4 <= WS_RSHM && WS_CSOA + DM * 4 <= WS_WIN && WS_CMAXO + 2 * DM * 4 <= CTL_ZERO_BYTES, "ws map int8 out");
constexpr size_t WS_CMAXG = 256 * 1024, WS_CMAXF = 512 * 1024;
static_assert(WS_U8 + (size_t)MT * P8 <= WS_W8G && WS_W8G + (size_t)N8P * P8 <= WS_W8F && WS_CSG + N8P * 4 <= WS_CSF && WS_RS2 + ML * 4 <= WS_CSG && WS_RSU + MT * 4 <= WS_RS2 && WS_W8F + (size_t)DFF * P8 <= WS_END && WS_U28 + (size_t)ML * P8 <= WS_MIX && WS_CSF + DFF * 4 <= WS_WIN, "ws map int8");
constexpr size_t WS_HF = 2 * MiB, WS_T = 2 * MiB, WS_U2 = 130 * MiB;
constexpr size_t WS_YG = WS_U, WS_HDN = WS_P, WS_F = WS_MIX + 64 * MiB;
static_assert(WS_WIN + (size_t)NP * PK * 2 <= WS_WOM && WS_WOM + (size_t)DM * PK * 2 <= WS_WOA && WS_WOA + (size_t)DM * PK * 2 <= WS_WO && WS_WO + (size_t)DM * PK * 2 <= WS_WF1 && WS_WF1 + (size_t)DFF * PK * 2 <= WS_WF2 && WS_WF2 + (size_t)DM * PF * 2 <= WS_U, "ws map: weights");
static_assert(WS_U + (size_t)MT * PK * 2 <= WS_P && WS_P + (size_t)MT * NP * 2 <= WS_G && WS_G + (size_t)MT * 32 * 4 <= WS_HM && WS_HM + (size_t)ML * PK * 2 <= WS_AT && WS_AT + (size_t)ML * PK * 2 <= WS_MIX && WS_F + (size_t)ML * DM * 2 <= WS_HB && WS_HB + (size_t)ML * DM * 2 <= WS_END, "ws map");
static_assert(WS_T + (size_t)ML * DM * 4 <= WS_U2 && WS_U2 + (size_t)ML * PK * 2 <= WS_WOM && WS_HDN + (size_t)ML * PF * 2 <= WS_G && WS_YG + (size_t)ML * PK * 2 <= WS_P, "ws map overlays");
constexpr int CW_BAR = 4096;

constexpr int RING_OFF = 0, RING_BYTES = 131072;
constexpr int LDSCTL_OFF = RING_BYTES, MISC_OFF = LDSCTL_OFF + 320;
constexpr int LDS_BYTES = 147456;
static_assert(MISC_OFF + 128 <= LDS_BYTES, "LDS map");
#define GAS __attribute__((address_space(1)))
#define LAS __attribute__((address_space(3)))
typedef unsigned short bf16;
typedef unsigned v4u __attribute__((ext_vector_type(4)));
typedef float f32x4 __attribute__((ext_vector_type(4)));
typedef short bf16x8 __attribute__((ext_vector_type(8)));
typedef GAS unsigned gu32;
typedef GAS unsigned long long gu64;
#define RLX_AGENT __ATOMIC_RELAXED, __HIP_MEMORY_SCOPE_AGENT
#define LDS_WAIT() asm volatile("s_waitcnt lgkmcnt(0)" ::: "memory")
#define VM_WAIT() asm volatile("s_waitcnt vmcnt(0)" ::: "memory")
__device__ __forceinline__ unsigned long long rt() { return __builtin_amdgcn_s_memrealtime(); }
__device__ __forceinline__ unsigned f2bf(float f) { unsigned u = __builtin_bit_cast(unsigned, f); return (u + 0x7fffu + ((u >> 16) & 1u)) >> 16; }
typedef __bf16 pk2_bf2 __attribute__((ext_vector_type(2)));
typedef float pk2_f2 __attribute__((ext_vector_type(2)));
__device__ __forceinline__ unsigned pk2(float lo, float hi) { pk2_f2 v = {lo, hi}; return __builtin_bit_cast(unsigned, __builtin_convertvector(v, pk2_bf2)); }

#define XB_TMO      128
#define XB_XCNT(j)  (256  + 64 * (j))
#define XB_XSUB(j)  (1280 + 64 * (j))
#define XB_XGEN(j)  (2304 + 64 * (j))
#define XB_TOP      3328
#define XB_TOPGEN   3392
#define XCD_BAR_WORDS 3456
#define XB_SPIN_CAP (1u << 18)

__device__ __forceinline__ unsigned xb_ld(unsigned* p)              { return __hip_atomic_load(p, __ATOMIC_RELAXED, __HIP_MEMORY_SCOPE_AGENT); }
__device__ __forceinline__ unsigned xb_add(unsigned* p, unsigned v) { return __hip_atomic_fetch_add(p, v, __ATOMIC_RELAXED, __HIP_MEMORY_SCOPE_AGENT); }
__device__ __forceinline__ unsigned xb_xcc_id() { return (unsigned)__builtin_amdgcn_s_getreg((3 << 11) | 20) & 0xFu; }
#define XB_SPIN(cond, bar) do { unsigned _sp = 0; while (cond) { __builtin_amdgcn_s_sleep(1); \
    if ((++_sp & 255u) == 0u) { if (xb_ld(&(bar)[XB_TMO])) break; if (_sp > XB_SPIN_CAP) { atomicAdd(&(bar)[XB_TMO], 1u); break; } } } } while (0)

struct XcdBarrier {
    int wave;
    unsigned* bar; unsigned x;
    volatile LAS unsigned* st;
};

__device__ __forceinline__ bool xb_leader(int wave) { return wave == 0 && __builtin_amdgcn_mbcnt_hi(~0u, __builtin_amdgcn_mbcnt_lo(~0u, 0u)) == 0u; }
__device__ __forceinline__ XcdBarrier xcd_barrier_post(unsigned* bar, volatile LAS unsigned* st, int wave) {
    XcdBarrier b; b.wave = wave; b.bar = bar; b.x = xb_xcc_id(); b.st = st;
    if (xb_leader(wave)) (void)xb_add(&bar[XB_XCNT(b.x)], 1u);
    return b;
}
__device__ __forceinline__ void xcd_barrier_complete(unsigned* bar, unsigned x, unsigned& nloc, unsigned& nx) {
    const unsigned G = gridDim.x * gridDim.y * gridDim.z;
    unsigned sum, cnt, mine, sp = 0u;
    for (;;) {
        sum = 0u; cnt = 0u; mine = 0u;
#pragma unroll
        for (unsigned j = 0; j < 16; ++j) { const unsigned c = xb_ld(&bar[XB_XCNT(j)]); sum += c; cnt += (c > 0u) ? 1u : 0u; mine = (j == x) ? c : mine; }
        if (sum == G) break;
        __builtin_amdgcn_s_sleep(1);
        if ((++sp & 255u) == 0u) { if (xb_ld(&bar[XB_TMO])) break; if (sp > XB_SPIN_CAP) { atomicAdd(&bar[XB_TMO], 1u); break; } }
    }
    nloc = mine > 0u ? mine : 1u; nx = cnt > 0u ? cnt : 1u;
}

__device__ __forceinline__ void xcd_barrier(const XcdBarrier& b) {
    asm volatile("s_waitcnt vmcnt(0)" ::: "memory");
    __syncthreads();
    if (xb_leader(b.wave)) {
        unsigned* bar = b.bar;
        __builtin_amdgcn_s_waitcnt(0);
        unsigned nloc = b.st[0], nx = b.st[1];
        if (nloc == 0u) { xcd_barrier_complete(bar, b.x, nloc, nx); b.st[0] = nloc; b.st[1] = nx; }
        const unsigned old = xb_add(&bar[XB_XSUB(b.x)], 1u);
        const unsigned gen = old / nloc;
        if (old + 1u == (gen + 1u) * nloc) {
            __builtin_amdgcn_fence(__ATOMIC_RELEASE, "agent");
            asm volatile("s_waitcnt vmcnt(0)" ::: "memory");
            const unsigned og = xb_add(&bar[XB_TOP], 1u);
            const unsigned tg = og / nx;
            if (og + 1u == (tg + 1u) * nx) xb_add(&bar[XB_TOPGEN], 1u);
            else XB_SPIN(xb_ld(&bar[XB_TOPGEN]) == tg, bar);
            __builtin_amdgcn_fence(__ATOMIC_ACQUIRE, "agent");
            xb_add(&bar[XB_XGEN(b.x)], 1u);
            asm volatile("s_waitcnt vmcnt(0)" ::: "memory");
        } else {
            XB_SPIN(xb_ld(&bar[XB_XGEN(b.x)]) == gen, bar);
            __builtin_amdgcn_fence(__ATOMIC_ACQUIRE, "agent");
            asm volatile("s_waitcnt vmcnt(0)" ::: "memory");
        }
    }
    __syncthreads();
}

template <int CTRL> __device__ __forceinline__ float dppx(float v) { return __builtin_bit_cast(float, __builtin_amdgcn_update_dpp(0, __builtin_bit_cast(int, v), CTRL, 0xf, 0xf, true)); }
#define XSWAP(name, insn, comb) __device__ __forceinline__ float name(float x) { float a = x, b = x; asm("s_nop 1\n\t" insn " %0, %1" : "+v"(a), "+v"(b)); return comb; }
XSWAP(xsum16, "v_permlane16_swap_b32", a + b)
XSWAP(xsum32, "v_permlane32_swap_b32", a + b)
XSWAP(xmax16, "v_permlane16_swap_b32", fmaxf(a, b))
XSWAP(xmax32, "v_permlane32_swap_b32", fmaxf(a, b))
#undef XSWAP
__device__ __forceinline__ void rowbcast4(float x, float (&r)[4]) {
    float a = x, b = x; asm("s_nop 1\n\tv_permlane16_swap_b32 %0, %1" : "+v"(a), "+v"(b));
    float a0 = a, a2 = a; asm("s_nop 1\n\tv_permlane32_swap_b32 %0, %1" : "+v"(a0), "+v"(a2));
    float b1 = b, b3 = b; asm("s_nop 1\n\tv_permlane32_swap_b32 %0, %1" : "+v"(b1), "+v"(b3));
    r[0] = a0; r[1] = b1; r[2] = a2; r[3] = b3;
}
__device__ __forceinline__ float wave_sum(float v) {
    v += dppx<0xB1>(v); v += dppx<0x4E>(v); v += dppx<0x141>(v); v += dppx<0x140>(v);
    return xsum32(xsum16(v));
}
__device__ __forceinline__ float wave_max(float v) {
    v = fmaxf(v, dppx<0xB1>(v)); v = fmaxf(v, dppx<0x4E>(v)); v = fmaxf(v, dppx<0x141>(v)); v = fmaxf(v, dppx<0x140>(v));
    return xmax32(xmax16(v));
}
__device__ __forceinline__ float bf2f(bf16 b) { return __builtin_bit_cast(float, (unsigned)b << 16); }
__device__ __forceinline__ float bflo(unsigned w) { return __builtin_bit_cast(float, w << 16); }
typedef __bf16 bf16x2_d __attribute__((ext_vector_type(2)));
__device__ __forceinline__ float dot2bf(unsigned a, unsigned b, float c) { return __builtin_amdgcn_fdot2_f32_bf16(__builtin_bit_cast(bf16x2_d, a), __builtin_bit_cast(bf16x2_d, b), c, false); }
__device__ __forceinline__ float bfhi(unsigned w) { return __builtin_bit_cast(float, w & 0xffff0000u); }
__device__ __forceinline__ float sigm(float x) { return __builtin_amdgcn_rcpf(1.0f + __expf(-x)); }
__device__ __forceinline__ float logsig(float x) { return x < 0.f ? x - log1pf(expf(x)) : -log1pf(expf(-x)); }
__device__ __forceinline__ float logsig_fast(float x) { const float e = __expf(-fabsf(x)); return fminf(x, 0.f) - __logf(1.0f + e); }

#define BAR_LDS() do { asm volatile("s_waitcnt lgkmcnt(0)" ::: "memory"); __builtin_amdgcn_s_barrier(); asm volatile("" ::: "memory"); } while (0)
struct Args { const float* in[16]; float* out; unsigned char* ws; int ph_lo, ph_hi; };

__device__ __forceinline__ int win_map(int n0) { return n0 < 12288 ? n0 : (n0 < 12320 ? OFF_GM + (n0 - 12288) : n0 - 32); }


namespace ml {
typedef short s16x4 __attribute__((ext_vector_type(4)));
typedef short v4i16_t __attribute__((ext_vector_type(4)));
typedef unsigned v2u __attribute__((ext_vector_type(2)));
constexpr int QS = 528, KS = 544, VS = 288, S_PITCH = 144;
constexpr int Q_OFF = 0, K_OFF = Q_OFF + 64 * QS, V_OFF = K_OFF + 64 * KS, S_OFF = V_OFF + 64 * VS, NB_OFF = S_OFF + 64 * S_PITCH, NQ_OFF = NB_OFF + 1024, RS_OFF = NQ_OFF + 2048, WE_OFF = RS_OFF + 512, GG_OFF = WE_OFF + 256, MV_OFF = GG_OFF + 256, FAB_OFF = MV_OFF + 256;
static_assert(FAB_OFF + 8 * 512 <= 131072, "mLSTM LDS map");
__device__ __forceinline__ unsigned off_b(unsigned row, unsigned ch) { return 256u * row + 16u * (ch ^ (((row & 3u) << 2) | ((row >> 2) & 3u))); }
__device__ __forceinline__ unsigned rr16(unsigned lane, unsigned rb, unsigned s) { return off_b((lane & 15u) + 16u * rb, 4u * s + (lane >> 4)); }
__device__ __forceinline__ unsigned tr16(unsigned lane, unsigned c, unsigned ks, unsigned t) { const unsigned g = lane >> 4, q = (lane & 15u) >> 2, p = lane & 3u; return off_b(32u * ks + 8u * g + 4u * t + q, 2u * c + (p >> 1)) + 8u * (p & 1u); }
__device__ __forceinline__ s16x4 trd(LAS unsigned char* p) { return __builtin_bit_cast(s16x4, __builtin_amdgcn_ds_read_tr16_b64_v4i16((LAS v4i16_t*)p)); }
__device__ __forceinline__ bf16x8 cat8(s16x4 lo, s16x4 hi) { return __builtin_shufflevector(lo, hi, 0, 1, 2, 3, 4, 5, 6, 7); }
__device__ __forceinline__ unsigned cvtpk(float lo, float hi) { unsigned r; asm volatile("v_cvt_pk_bf16_f32 %0, %1, %2" : "=v"(r) : "v"(lo), "v"(hi)); return r; }
template <int CTRL, int ROWMASK> __device__ __forceinline__ float dppf(float old, float src) { return __builtin_bit_cast(float, __builtin_amdgcn_update_dpp(__builtin_bit_cast(int, old), __builtin_bit_cast(int, src), CTRL, ROWMASK, 0xf, false)); }
__device__ __forceinline__ float scan_add(float v) { v += dppf<0x111, 0xf>(0.f, v); v += dppf<0x112, 0xf>(0.f, v); v += dppf<0x114, 0xf>(0.f, v); v += dppf<0x118, 0xf>(0.f, v); v += dppf<0x142, 0xa>(0.f, v); v += dppf<0x143, 0xc>(0.f, v); return v; }
__device__ __forceinline__ float scan_max(float v) { const float ni = -INFINITY; v = fmaxf(v, dppf<0x111, 0xf>(ni, v)); v = fmaxf(v, dppf<0x112, 0xf>(ni, v)); v = fmaxf(v, dppf<0x114, 0xf>(ni, v)); v = fmaxf(v, dppf<0x118, 0xf>(ni, v)); v = fmaxf(v, dppf<0x142, 0xa>(ni, v)); v = fmaxf(v, dppf<0x143, 0xc>(ni, v)); return v; }
__device__ __forceinline__ int scan_row(int b, int dir, int st) { return st < CTXL ? ML + b * CTXL + (dir ? CTXL - 1 - st : st) : b * SEQ + (dir ? SEQ - 1 - (st - CTXL) : st - CTXL); }

__device__ __forceinline__ void mlstm_item(const Args& A, LAS unsigned char* lds, int tid_in, int lane_in, int wave, int item) {
    int tid = tid_in, lane = lane_in;
    const int vs = item & 3, dir = (item >> 2) & 1, h = (item >> 3) & 7, b = item >> 6;
    const bf16* P = (const bf16*)(A.ws + WS_P); const float* Gt = (const float*)(A.ws + WS_G);
    bf16* Hb = (bf16*)(A.ws + (dir ? WS_HB : WS_HF));
    const float bi = A.in[8][(2 * dir) * 8 + h], bfg = A.in[8][(2 * dir + 1) * 8 + h];
    LAS float* NBUF = (LAS float*)(lds + NB_OFF); LAS float* NQ = (LAS float*)(lds + NQ_OFF); LAS float* RS = (LAS float*)(lds + RS_OFF); LAS float* WE = (LAS float*)(lds + WE_OFF); LAS float* GGT = (LAS float*)(lds + GG_OFF); LAS float* MVT = (LAS float*)(lds + MV_OFF); LAS float* FAB = (LAS float*)(lds + FAB_OFF + wave * 512);
    { int t0 = tid_in; asm volatile("" : "+v"(t0)); if (t0 < 256) NBUF[t0] = 0.f; }
    asm volatile("" ::: "memory");
    f32x4 X[16];
#pragma unroll
    for (int i = 0; i < 16; ++i) X[i] = (f32x4){0.f, 0.f, 0.f, 0.f};
    float m = 0.f;
    const f32x4 z4 = (f32x4){0.f, 0.f, 0.f, 0.f};
    v4u pq[4], pk[4], pv[2]; float pgi, pgf;
    const int sgn = dir ? -1 : 1;
    const int goff_qk = sgn * (tid_in >> 5) * NP + h * DQK + (tid_in & 31) * 8, goff_v = sgn * (tid_in >> 4) * NP + OFF_VM + h * DV + vs * 128 + (tid_in & 15) * 8, goff_g = sgn * lane_in * 32 + (2 * dir) * 8 + h;
    const unsigned lds_q = (unsigned)(QS * (tid_in >> 5) + 16 * (tid_in & 31)), lds_k = (unsigned)(KS * (tid_in >> 5) + 64 * ((tid_in & 31) >> 2) + 8 * (tid_in & 3)), lds_v = (unsigned)(VS * (tid_in >> 4) + 16 * (tid_in & 15));
    const int hoff = sgn * (lane_in & 15) * DM + h * DV + vs * 128 + 16 * wave + 4 * (lane_in >> 4);
#define ML_LOAD(cc) do { const int row0_ = scan_row(b, dir, 64 * (cc)); const bf16* pb_ = P + (size_t)row0_ * NP; \
        _Pragma("unroll") for (int i = 0; i < 4; ++i) { pq[i] = *(const v4u*)(pb_ + (goff_qk + OFF_QM + sgn * 16 * i * NP)); pk[i] = *(const v4u*)(pb_ + (goff_qk + OFF_KM + sgn * 16 * i * NP)); } \
        _Pragma("unroll") for (int i = 0; i < 2; ++i) pv[i] = *(const v4u*)(pb_ + (goff_v + sgn * 32 * i * NP)); \
        { const float* gb_ = Gt + (size_t)row0_ * 32; pgi = gb_[goff_g]; pgf = gb_[goff_g + 8]; } } while (0)
#define ML_STORE() do { _Pragma("unroll") for (int i = 0; i < 4; ++i) { *(LAS v4u*)(lds + Q_OFF + lds_q + 16 * QS * i) = pq[i]; { v2u k0_, k1_; k0_.x = pk[i].x; k0_.y = pk[i].y; k1_.x = pk[i].z; k1_.y = pk[i].w; *(LAS v2u*)(lds + K_OFF + lds_k + 16 * KS * i) = k0_; *(LAS v2u*)(lds + K_OFF + lds_k + 16 * KS * i + 32) = k1_; } } \
        _Pragma("unroll") for (int i = 0; i < 2; ++i) *(LAS v4u*)(lds + V_OFF + lds_v + 32 * VS * i) = pv[i]; } while (0)
    ML_LOAD(0); ML_STORE();
#pragma unroll 1
    for (int c = 0; c < (CTXL + SEQ) / 64; ++c) {
        const bool latent = c >= CTXL / 64;
        { int lo_ = lane_in, to_ = tid_in; asm volatile("" : "+v"(lo_), "+v"(to_)); lane = lo_; tid = to_; }
        const unsigned q4 = (unsigned)lane >> 4, l15 = (unsigned)lane & 15u;
        const unsigned sperm = 16u * (q4 >> 1) + 4u * (q4 & 1u) + (l15 >> 2);
        LAS unsigned char* qacc = lds + Q_OFF + QS * l15 + 16u * q4;
        LAS unsigned char* qrow = lds + Q_OFF + QS * l15 + 32u * (q4 & 1u) + 8u * (q4 >> 1);
        LAS unsigned char* krow = lds + K_OFF + KS * l15 + 16u * q4;
        LAS unsigned char* ktr = lds + K_OFF + KS * sperm + 8u * (lane & 3);
        LAS unsigned char* vtr = lds + V_OFF + VS * sperm + 8u * (lane & 3) + 32u * wave;
        LAS unsigned char* srd = lds + S_OFF + S_PITCH * l15 + 32u * (q4 >> 1) + 16u * (q4 & 1u);
        const int wperm = 16 * (int)(q4 >> 1) + 4 * (int)(q4 & 1u);
        float bcs, gg, Mv;
        { const float ig = pgi + bi, lf = logsig_fast(pgf + bfg);
          bcs = scan_add(lf); gg = ig - bcs; Mv = fmaxf(m, scan_max(gg)); }
        const float bL = __builtin_bit_cast(float, __builtin_amdgcn_readlane(__builtin_bit_cast(int, bcs), 63)), M63 = __builtin_bit_cast(float, __builtin_amdgcn_readlane(__builtin_bit_cast(int, Mv), 63));
        const float decay = __expf(m - M63);
        if (wave == 0) { WE[lane] = __expf(gg - M63); GGT[lane] = gg; MVT[lane] = Mv; }
        BAR_LDS();
        if (c + 1 < (CTXL + SEQ) / 64) ML_LOAD(c + 1);
        f32x4 accI[4];
        if (latent) {
            bf16x8 nfrag; f32x4 accN[4];
            { const f32x4 n0 = *(const LAS f32x4*)(NBUF + 32 * wave + 4 * (int)q4), n1 = *(const LAS f32x4*)(NBUF + 32 * wave + 16 + 4 * (int)q4);
              v4u nb; nb.x = cvtpk(n0[0], n0[1]); nb.y = cvtpk(n0[2], n0[3]); nb.z = cvtpk(n1[0], n1[1]); nb.w = cvtpk(n1[2], n1[3]);
              nfrag = __builtin_bit_cast(bf16x8, nb); }
            const int tb = wave >> 1, sb0 = 2 * (wave & 1);
            f32x4 st0, st1;
            const int tl = 16 * tb + (int)l15; const float Mt = MVT[tl];
            const f32x4 gs0 = *(const LAS f32x4*)(GGT + 16 * sb0 + 4 * (int)q4), gs1 = *(const LAS f32x4*)(GGT + 16 * sb0 + 16 + 4 * (int)q4);
            st0 = z4; st1 = z4;
            if (sb0 + 1 <= tb) {
#pragma unroll
                for (int ks = 0; ks < 8; ++ks) {
                    const bf16x8 qb = cat8(*(const LAS s16x4*)(qrow + 16 * QS * tb + 64 * ks), *(const LAS s16x4*)(qrow + 16 * QS * tb + 64 * ks + 16));
                    const bf16x8 k0 = *(const LAS bf16x8*)(krow + 16 * KS * sb0 + 64 * ks), k1 = *(const LAS bf16x8*)(krow + 16 * KS * (sb0 + 1) + 64 * ks);
                    st0 = __builtin_amdgcn_mfma_f32_16x16x32_bf16(k0, qb, st0, 0, 0, 0); st1 = __builtin_amdgcn_mfma_f32_16x16x32_bf16(k1, qb, st1, 0, 0, 0); }
            } else if (sb0 <= tb) {
#pragma unroll
                for (int ks = 0; ks < 8; ++ks) {
                    const bf16x8 qb = cat8(*(const LAS s16x4*)(qrow + 16 * QS * tb + 64 * ks), *(const LAS s16x4*)(qrow + 16 * QS * tb + 64 * ks + 16));
                    const bf16x8 k0 = *(const LAS bf16x8*)(krow + 16 * KS * sb0 + 64 * ks);
                    st0 = __builtin_amdgcn_mfma_f32_16x16x32_bf16(k0, qb, st0, 0, 0, 0); }
            }
            float rs = 0.f;
#pragma unroll
            for (int r = 0; r < 4; ++r) { const int s0 = 16 * sb0 + 4 * (int)q4 + r, s1 = s0 + 16;
                st0[r] = s0 <= tl ? st0[r] * __expf(gs0[r] - Mt) : 0.f; st1[r] = s1 <= tl ? st1[r] * __expf(gs1[r] - Mt) : 0.f; rs += st0[r] + st1[r]; }
            rs = xsum32(xsum16(rs));
            if (q4 == 0) RS[(wave & 1) * 64 + tl] = rs;
            { v2u w0, w1; w0.x = cvtpk(st0[0], st0[1]); w0.y = cvtpk(st0[2], st0[3]); w1.x = cvtpk(st1[0], st1[1]); w1.y = cvtpk(st1[2], st1[3]);
              const int pq_ = (int)(((q4 & 1u) << 1) | (q4 >> 1));
              *(LAS v2u*)(lds + S_OFF + tl * S_PITCH + 32 * sb0 + 8 * pq_) = w0; *(LAS v2u*)(lds + S_OFF + tl * S_PITCH + 32 * sb0 + 32 + 8 * pq_) = w1; }
            { const unsigned qb0 = (unsigned)(size_t)qacc, qb1 = qb0 + 16 * QS, qb2 = qb0 + 32 * QS, qb3 = qb0 + 48 * QS;
              bf16x8 fa0, fa1, fa2, fa3, fb0, fb1, fb2, fb3;
#define ML_RD4(f0, f1, f2, f3, kp) do { asm volatile("ds_read_b128 %0, %4 offset:%8\n\tds_read_b128 %1, %5 offset:%8\n\tds_read_b128 %2, %6 offset:%8\n\tds_read_b128 %3, %7 offset:%8" \
                  : "=&v"(f0), "=&v"(f1), "=&v"(f2), "=&v"(f3) : "v"(qb0), "v"(qb1), "v"(qb2), "v"(qb3), "n"(64 * (kp)) : "memory"); } while (0)
#define ML_WT4(f0, f1, f2, f3, n) asm volatile("s_waitcnt lgkmcnt(" #n ")" : "+v"(f0), "+v"(f1), "+v"(f2), "+v"(f3))
#define ML_MM4(f0, f1, f2, f3, kp) do { v4u xb; xb.x = cvtpk(X[2 * (kp)][0], X[2 * (kp)][1]); xb.y = cvtpk(X[2 * (kp)][2], X[2 * (kp)][3]); xb.z = cvtpk(X[2 * (kp) + 1][0], X[2 * (kp) + 1][1]); xb.w = cvtpk(X[2 * (kp) + 1][2], X[2 * (kp) + 1][3]); \
                  const bf16x8 xf = __builtin_bit_cast(bf16x8, xb); \
                  accI[0] = __builtin_amdgcn_mfma_f32_16x16x32_bf16(xf, f0, (kp) ? accI[0] : z4, 0, 0, 0); accI[1] = __builtin_amdgcn_mfma_f32_16x16x32_bf16(xf, f1, (kp) ? accI[1] : z4, 0, 0, 0); \
                  accI[2] = __builtin_amdgcn_mfma_f32_16x16x32_bf16(xf, f2, (kp) ? accI[2] : z4, 0, 0, 0); accI[3] = __builtin_amdgcn_mfma_f32_16x16x32_bf16(xf, f3, (kp) ? accI[3] : z4, 0, 0, 0); \
                  if (wave == (kp)) { accN[0] = __builtin_amdgcn_mfma_f32_16x16x32_bf16(nfrag, f0, z4, 0, 0, 0); accN[1] = __builtin_amdgcn_mfma_f32_16x16x32_bf16(nfrag, f1, z4, 0, 0, 0); \
                      accN[2] = __builtin_amdgcn_mfma_f32_16x16x32_bf16(nfrag, f2, z4, 0, 0, 0); accN[3] = __builtin_amdgcn_mfma_f32_16x16x32_bf16(nfrag, f3, z4, 0, 0, 0); } } while (0)
              asm volatile("s_waitcnt lgkmcnt(0)" ::: "memory");
              ML_RD4(fa0, fa1, fa2, fa3, 0);
              ML_RD4(fb0, fb1, fb2, fb3, 1); ML_WT4(fa0, fa1, fa2, fa3, 4); ML_MM4(fa0, fa1, fa2, fa3, 0);
              ML_RD4(fa0, fa1, fa2, fa3, 2); ML_WT4(fb0, fb1, fb2, fb3, 4); ML_MM4(fb0, fb1, fb2, fb3, 1);
              ML_RD4(fb0, fb1, fb2, fb3, 3); ML_WT4(fa0, fa1, fa2, fa3, 4); ML_MM4(fa0, fa1, fa2, fa3, 2);
              ML_RD4(fa0, fa1, fa2, fa3, 4); ML_WT4(fb0, fb1, fb2, fb3, 4); ML_MM4(fb0, fb1, fb2, fb3, 3);
              ML_RD4(fb0, fb1, fb2, fb3, 5); ML_WT4(fa0, fa1, fa2, fa3, 4); ML_MM4(fa0, fa1, fa2, fa3, 4);
              ML_RD4(fa0, fa1, fa2, fa3, 6); ML_WT4(fb0, fb1, fb2, fb3, 4); ML_MM4(fb0, fb1, fb2, fb3, 5);
              ML_RD4(fb0, fb1, fb2, fb3, 7); ML_WT4(fa0, fa1, fa2, fa3, 4); ML_MM4(fa0, fa1, fa2, fa3, 6);
              ML_WT4(fb0, fb1, fb2, fb3, 0); ML_MM4(fb0, fb1, fb2, fb3, 7);
#undef ML_RD4
#undef ML_WT4
#undef ML_MM4
            }
            if (q4 == 0) {
#pragma unroll
                for (int tt = 0; tt < 4; ++tt) NQ[wave * 64 + 16 * tt + (int)l15] = accN[tt][0]; }
        }
        bf16x8 vf[2], vw[2]; f32x4 wA[2], wB[2];
#pragma unroll
        for (int ks = 0; ks < 2; ++ks) { const s16x4 lo = trd(vtr + VS * (32 * ks)), hi = trd(vtr + VS * (32 * ks + 8)); vf[ks] = cat8(lo, hi);
            wA[ks] = *(const LAS f32x4*)(WE + 32 * ks + wperm); wB[ks] = *(const LAS f32x4*)(WE + 32 * ks + wperm + 8); const f32x4 w0 = wA[ks], w1 = wB[ks];
            const v4u vu = __builtin_bit_cast(v4u, vf[ks]); v4u o;
            o.x = cvtpk(bflo(vu.x) * w0[0], bfhi(vu.x) * w0[1]); o.y = cvtpk(bflo(vu.y) * w0[2], bfhi(vu.y) * w0[3]);
            o.z = cvtpk(bflo(vu.z) * w1[0], bfhi(vu.z) * w1[1]); o.w = cvtpk(bflo(vu.w) * w1[2], bfhi(vu.w) * w1[3]);
            vw[ks] = __builtin_bit_cast(bf16x8, o); }
        { float na[2]; v4u wq[2];
#pragma unroll
          for (int ks = 0; ks < 2; ++ks) { wq[ks].x = cvtpk(wA[ks][0], wA[ks][1]); wq[ks].y = cvtpk(wA[ks][2], wA[ks][3]); wq[ks].z = cvtpk(wB[ks][0], wB[ks][1]); wq[ks].w = cvtpk(wB[ks][2], wB[ks][3]); }
#pragma unroll
          for (int e = 0; e < 2; ++e) { LAS unsigned char* kp_ = ktr + 64u * wave + 32 * e; float a = 0.f;
#pragma unroll
              for (int ks = 0; ks < 2; ++ks) { const v4u ku = __builtin_bit_cast(v4u, cat8(trd(kp_ + KS * (32 * ks)), trd(kp_ + KS * (32 * ks + 8))));
                  a = dot2bf(ku.x, wq[ks].x, a); a = dot2bf(ku.y, wq[ks].y, a); a = dot2bf(ku.z, wq[ks].z, a); a = dot2bf(ku.w, wq[ks].w, a); }
              na[e] = xsum32(xsum16(a)); }
          if (q4 == 0) { const int d0 = 32 * wave + (int)l15; NBUF[d0] = decay * NBUF[d0] + na[0]; NBUF[d0 + 16] = decay * NBUF[d0 + 16] + na[1]; } }
        { s16x4 kA[4][2][2], kB[4][2][2];
#define ML_KRD(buf, ig) _Pragma("unroll") for (int i4 = 0; i4 < 4; ++i4) { _Pragma("unroll") for (int ks = 0; ks < 2; ++ks) { \
            buf[i4][ks][0] = trd(ktr + KS * (32 * ks) + 32 * (4 * (ig) + i4)); buf[i4][ks][1] = trd(ktr + KS * (32 * ks + 8) + 32 * (4 * (ig) + i4)); } }
#define ML_KMM(buf, ig) _Pragma("unroll") for (int i4 = 0; i4 < 4; ++i4) { const int i = 4 * (ig) + i4; X[i] *= decay; \
            _Pragma("unroll") for (int ks = 0; ks < 2; ++ks) X[i] = __builtin_amdgcn_mfma_f32_16x16x32_bf16(cat8(buf[i4][ks][0], buf[i4][ks][1]), vw[ks], X[i], 0, 0, 0); }
          ML_KRD(kA, 0) ML_KRD(kB, 1) ML_KMM(kA, 0) ML_KRD(kA, 2) ML_KMM(kB, 1) ML_KRD(kB, 3) ML_KMM(kA, 2) ML_KMM(kB, 3)
#undef ML_KRD
#undef ML_KMM
        }
        if (latent) {
            BAR_LDS();
            bf16x8 sa0[4], sa1[2]; float nqv[8];
#pragma unroll
            for (int tt = 0; tt < 4; ++tt) sa0[tt] = *(const LAS bf16x8*)(srd + 16 * S_PITCH * tt);
#pragma unroll
            for (int tt = 2; tt < 4; ++tt) sa1[tt - 2] = *(const LAS bf16x8*)(srd + 16 * S_PITCH * tt + 64);
#pragma unroll
            for (int w = 0; w < 8; ++w) nqv[w] = NQ[w * 64 + lane];
            const float rs0 = RS[lane], rs1 = RS[64 + lane];
            if (c + 1 < (CTXL + SEQ) / 64) ML_STORE();
            float FA, FB;
            { const float nq = ((nqv[0] + nqv[1]) + (nqv[2] + nqv[3])) + ((nqv[4] + nqv[5]) + (nqv[6] + nqv[7]));
              const float inter = __expf(m - Mv), den = inter * nq + rs0 + rs1;
              FB = __builtin_amdgcn_rcpf(fmaxf(fabsf(den), __expf(-(bcs + Mv)))); FA = inter * FB; }
            f32x4 accS[4];
#pragma unroll
            for (int tt = 0; tt < 4; ++tt) {
                accS[tt] = __builtin_amdgcn_mfma_f32_16x16x32_bf16(vf[0], sa0[tt], z4, 0, 0, 0);
                if (tt >= 2) accS[tt] = __builtin_amdgcn_mfma_f32_16x16x32_bf16(vf[1], sa1[tt - 2], accS[tt], 0, 0, 0); }
            bf16* hb_ = Hb + (size_t)scan_row(b, dir, 64 * c) * DM; float fav[4], fbv[4]; rowbcast4(FA, fav); rowbcast4(FB, fbv);
#pragma unroll
            for (int tt = 0; tt < 4; ++tt) { const float fa = fav[tt], fb = fbv[tt];
                v2u w; w.x = cvtpk(fa * accI[tt][0] + fb * accS[tt][0], fa * accI[tt][1] + fb * accS[tt][1]); w.y = cvtpk(fa * accI[tt][2] + fb * accS[tt][2], fa * accI[tt][3] + fb * accS[tt][3]);
                *(v2u*)(hb_ + (hoff + sgn * 16 * tt * DM)) = w; }
        } else {
            BAR_LDS();
            if (c + 1 < (CTXL + SEQ) / 64) ML_STORE();
        }
        m = bL + M63;
    }
#undef ML_LOAD
#undef ML_STORE
    BAR_LDS();
}
}


namespace at {
typedef float f32x16 __attribute__((ext_vector_type(16)));
typedef __bf16 bf16x2_t __attribute__((ext_vector_type(2)));
typedef float f32x2_t __attribute__((ext_vector_type(2)));
constexpr int KSTR = 272, VSTR = 320, VOFF = 64 * KSTR, BUFSZ = 64 * KSTR + 64 * VSTR;
__device__ __forceinline__ float max3f(float a, float b, float c) { float r; asm("v_max3_f32 %0, %1, %2, %3" : "=v"(r) : "v"(a), "v"(b), "v"(c)); return r; }
__device__ __forceinline__ unsigned cvt2(float lo, float hi) { f32x2_t v = {lo, hi}; bf16x2_t b = __builtin_convertvector(v, bf16x2_t); return __builtin_bit_cast(unsigned, b); }
__device__ __forceinline__ bf16x8 pack_step(const f32x16& x, int s) { v4u p; p.x = cvt2(x[8 * s], x[8 * s + 1]); p.y = cvt2(x[8 * s + 2], x[8 * s + 3]); p.z = cvt2(x[8 * s + 4], x[8 * s + 5]); p.w = cvt2(x[8 * s + 6], x[8 * s + 7]); return __builtin_bit_cast(bf16x8, p); }

struct TagT { static constexpr bool v = true; }; struct TagF { static constexpr bool v = false; };
__device__ __forceinline__ void attn_items(const Args& A, LAS unsigned char* lds, int tid_in, int lane_in, int wave, int G) {
    constexpr int NIT = NB * AKV * (SEQ / 64);
    int item = blockIdx.x;
    if (item >= NIT) return;
    constexpr bool late = false;
    const bf16* P = (const bf16*)(A.ws + WS_P); bf16* AT = (bf16*)(A.ws + WS_AT);
    int lane = lane_in, tid = tid_in;
    { asm volatile("" : "+v"(lane), "+v"(tid)); }
    const int l31 = lane & 31, hh = lane >> 5;
    const float cl2 = 0.08838834764831845f * 1.4426950408889634f;
    bf16x8 qf[8], qn[8]; v4u pk[2], pv[2];
#define AT_GEOM(it, b_, hkv_, hq_, q0_, qw_, ks_, nwt_) const int b_ = (it) >> 8, hkv_ = ((it) >> 5) & 7, hq_ = hkv_ * 4 + (wave & 3), q0_ = 64 * ((it) & 31), qw_ = q0_ + 32 * (wave >> 2), \
        ks_ = q0_ - WIN < 0 ? 0 : q0_ - WIN, nwt_ = ((q0_ + 64 + WIN > SEQ ? SEQ : q0_ + 64 + WIN) - ks_) >> 6
#define AT_QLOAD(qd, b_, qw_, hq_) do { const bf16* qp_ = P + (size_t)((b_) * SEQ + (qw_) + l31) * NP + OFF_QA + (hq_) * AD + 8 * hh; \
        _Pragma("unroll") for (int ks = 0; ks < 8; ++ks) qd[ks] = *(const bf16x8*)(qp_ + 16 * ks); } while (0)
#define AT_LOAD(b_, hkv_, ks_, nwt_, i) do { const int r0_ = (i) < (nwt_) ? (b_) * SEQ + (ks_) + 64 * (i) : ML + (b_) * CTXL + 64 * ((i) - (nwt_)); \
        _Pragma("unroll") for (int j = 0; j < 2; ++j) { const int idx = tidl + 512 * j; const bf16* gp = P + (size_t)(r0_ + (idx >> 4)) * NP + (hkv_) * AD + (idx & 15) * 8; \
            pk[j] = *(const v4u*)(gp + OFF_KA); pv[j] = *(const v4u*)(gp + OFF_VA); } } while (0)
#define AT_STORE(bufo) do { _Pragma("unroll") for (int j = 0; j < 2; ++j) { const int idx = tid + 512 * j; \
            *(LAS v4u*)(lds + (unsigned)(bufo) + KSTR * (idx >> 4) + 16 * (idx & 15)) = pk[j]; *(LAS v4u*)(lds + (unsigned)(bufo) + VOFF + VSTR * (idx >> 4) + 16 * (idx & 15)) = pv[j]; } } while (0)
#define AT_PV(Vb) do { LAS unsigned char* vp_ = (Vb) + vbase; _Pragma("unroll") for (int f = 0; f < 4; ++f) { _Pragma("unroll") for (int d = 0; d < 4; ++d) { \
            const ml::s16x4 lo = ml::trd(vp_ + VSTR * (16 * f) + 64 * d), hi = ml::trd(vp_ + VSTR * (16 * f + 8) + 64 * d);     \
            O[d] = __builtin_amdgcn_mfma_f32_32x32x16_bf16(ml::cat8(lo, hi), pb[f], O[d], 0, 0, 0); } } } while (0)
    const unsigned kbase = (unsigned)(KSTR * l31 + 16 * hh), vbase = (unsigned)(VSTR * (4 * hh + ((lane & 15) >> 2)) + 32 * ((lane >> 4) & 1) + 8 * (lane & 3));
    int cb, chkv, chq, cq0, cqw, cks, cnwt;
    { AT_GEOM(item, b0, hkv0, hq0, q00, qw0, ks0, nwt0); cb = b0; chkv = hkv0; chq = hq0; cq0 = q00; cqw = qw0; cks = ks0; cnwt = nwt0; }
    int tidl = tid;
    AT_LOAD(cb, chkv, cks, cnwt, 0); AT_QLOAD(qf, cb, cqw, chq);
    AT_STORE(0);
    asm volatile("" : "+v"(qf[0]), "+v"(qf[1]), "+v"(qf[2]), "+v"(qf[3]), "+v"(qf[4]), "+v"(qf[5]), "+v"(qf[6]), "+v"(qf[7]));
#pragma unroll
    for (int ks = 0; ks < 8; ++ks) qn[ks] = qf[ks];
#pragma unroll 1
    for (;;) {
        const int b = cb, hkv = chkv, hq = chq, q0 = cq0, qw = cqw, kstart = cks, nwt = cnwt, nt = nwt + CTXL / 64;
        const int nxt = item + G; const bool more = nxt < NIT;
        AT_GEOM(more ? nxt : item, nb, nhkv, nhq, nq0, nqw, nks, nnwt);
        asm volatile("" : "+v"(tidl));
        float m = A.in[10][hq] * 1.4426950408889634f, l = hh == 0 ? 1.0f : 0.0f;
        f32x16 O[4];
#pragma unroll
        for (int d = 0; d < 4; ++d)
#pragma unroll
            for (int r = 0; r < 16; ++r) O[d][r] = 0.f;
        bf16x8 pb[4];
        int bo = 0, bprev = 0;
        auto trip = [&](const int i, auto last) {
            const int bo1 = bo == 2 * BUFSZ ? 0 : bo + BUFSZ;
            BAR_LDS();
            if (!decltype(last)::v) AT_LOAD(b, hkv, kstart, nwt, i + 1); else if (more) { AT_LOAD(nb, nhkv, nks, nnwt, 0); AT_QLOAD(qn, nb, nqw, nhq); }
            if (late && i > 0) AT_PV(lds + bprev + VOFF);
            LAS unsigned char* Kb = lds + bo + kbase;
            f32x16 S0, S1;
            { const f32x16 z16 = {0.f, 0.f, 0.f, 0.f, 0.f, 0.f, 0.f, 0.f, 0.f, 0.f, 0.f, 0.f, 0.f, 0.f, 0.f, 0.f};
              S0 = __builtin_amdgcn_mfma_f32_32x32x16_bf16(*(const LAS bf16x8*)(Kb), qf[0], z16, 0, 0, 0); S1 = __builtin_amdgcn_mfma_f32_32x32x16_bf16(*(const LAS bf16x8*)(Kb + 32 * KSTR), qf[0], z16, 0, 0, 0); }
#pragma unroll
            for (int ks = 1; ks < 8; ++ks) { const bf16x8 k0 = *(const LAS bf16x8*)(Kb + 32 * ks), k1 = *(const LAS bf16x8*)(Kb + 32 * KSTR + 32 * ks);
                S0 = __builtin_amdgcn_mfma_f32_32x32x16_bf16(k0, qf[ks], S0, 0, 0, 0); S1 = __builtin_amdgcn_mfma_f32_32x32x16_bf16(k1, qf[ks], S1, 0, 0, 0); }
            float mx = -INFINITY;
            if (i < nwt && (kstart + 64 * i + WIN == q0 || kstart + 64 * i == q0 + WIN)) {
                const int dlt = kstart + 64 * i + 4 * hh - (qw + l31);
#pragma unroll
                for (int r = 0; r < 16; ++r) { const int d0 = dlt + (r & 3) + 8 * (r >> 2), d1 = d0 + 32;
                    S0[r] = (d0 >= -WIN && d0 <= WIN) ? S0[r] : -INFINITY; S1[r] = (d1 >= -WIN && d1 <= WIN) ? S1[r] : -INFINITY; } }
#pragma unroll
            for (int r = 0; r < 16; ++r) mx = max3f(mx, S0[r], S1[r]);
            mx = xmax32(mx);
            if (!__all(mx * cl2 - m <= 8.0f)) { const float mn = fmaxf(m, mx * cl2), alpha = __builtin_amdgcn_exp2f(m - mn); m = mn; l *= alpha;
#pragma unroll
                for (int d = 0; d < 4; ++d)
#pragma unroll
                    for (int r = 0; r < 16; ++r) O[d][r] *= alpha; }
            float ls = 0.f;
#pragma unroll
            for (int r = 0; r < 16; ++r) { S0[r] = __builtin_amdgcn_exp2f(S0[r] * cl2 - m); S1[r] = __builtin_amdgcn_exp2f(S1[r] * cl2 - m); ls += S0[r] + S1[r]; }
            l += ls;
            pb[0] = pack_step(S0, 0); pb[1] = pack_step(S0, 1); pb[2] = pack_step(S1, 0); pb[3] = pack_step(S1, 1);
            if (!late) AT_PV(lds + bo + VOFF);
            if (!decltype(last)::v) AT_STORE(bo1);
            bprev = bo; bo = bo1;
        };
#pragma unroll 1
        for (int i = 0; i + 1 < nt; ++i) trip(i, TagF{});
        trip(nt - 1, TagT{});
        if (late) AT_PV(lds + bprev + VOFF);
        BAR_LDS();
        if (more) AT_STORE(0);
        const float inv = __builtin_amdgcn_rcpf(xsum32(l));
        int l2 = lane; asm volatile("" : "+v"(l2));
        bf16* op = AT + (size_t)(b * SEQ + qw + (l2 & 31)) * PK + hq * AD + 4 * (l2 >> 5);
#pragma unroll
        for (int d = 0; d < 4; ++d)
#pragma unroll
            for (int g = 0; g < 4; ++g) { ml::v2u w; w.x = cvt2(O[d][4 * g] * inv, O[d][4 * g + 1] * inv); w.y = cvt2(O[d][4 * g + 2] * inv, O[d][4 * g + 3] * inv);
                *(ml::v2u*)(op + 32 * d + 8 * g) = w; }
        if (!more) break;
#pragma unroll
        for (int ks = 0; ks < 8; ++ks) qf[ks] = qn[ks];
        item = nxt; cb = nb; chkv = nhkv; chq = nhq; cq0 = nq0; cqw = nqw; cks = nks; cnwt = nnwt;
    }
#undef AT_GEOM
#undef AT_QLOAD
#undef AT_LOAD
#undef AT_STORE
#undef AT_PV
    BAR_LDS();
}
}

__device__ __forceinline__ unsigned q4(float a, float b, float c, float d) {
    const float M = 12582912.0f;
    const unsigned ua = __builtin_bit_cast(unsigned, a + M), ub = __builtin_bit_cast(unsigned, b + M), uc = __builtin_bit_cast(unsigned, c + M), ud = __builtin_bit_cast(unsigned, d + M);
    const unsigned lo = __builtin_amdgcn_perm(ub, ua, 0x0c0c0400u), hi = __builtin_amdgcn_perm(ud, uc, 0x0c0c0400u);
    return __builtin_amdgcn_perm(hi, lo, 0x05040100u); }
struct TItem { const float* src; bf16* dst; int N, K; };
constexpr int P0_NB_IN = 129, P0_I_IN = (DM / 64) * P0_NB_IN, P0_I_SQ = (DM / 64) * (DM / 32), P0_NSMALL = P0_I_IN + P0_I_SQ + (DFF / 64) * (DM / 32);
__device__ __forceinline__ TItem p0_item(const Args& A, int it, int lane) {
    unsigned char* ws = A.ws; const float* W; bf16* WT; int N, K, kb, nb; bool remap = false; int r = it;
    if (r < P0_I_IN) { W = A.in[7]; WT = (bf16*)(ws + WS_WIN); N = NPW; K = DM; remap = true; kb = r / P0_NB_IN; nb = r - kb * P0_NB_IN; if (nb == 128) nb = 12288 / 32; }
    else if ((r -= P0_I_IN) < P0_I_SQ) { W = A.in[13]; WT = (bf16*)(ws + WS_WO); N = DM; K = DM; kb = r >> 7; nb = r & 127; }
    else { r -= P0_I_SQ; W = A.in[15]; WT = (bf16*)(ws + WS_WF2); N = DM; K = DFF; kb = r >> 7; nb = r & 127; }
    const int k0 = 64 * kb, n0 = 32 * nb, d0 = remap ? win_map(n0) : n0;
    TItem t; t.src = W + (size_t)(k0 + (lane >> 5)) * N + n0 + (lane & 31); t.dst = WT + (size_t)d0 * (K + 64) + k0; t.N = N; t.K = K + 64; return t;
}
__device__ __forceinline__ void p0_load(const TItem& t, float (&wv)[32]) {
#pragma unroll
    for (int i = 0; i < 32; ++i) wv[i] = __builtin_nontemporal_load(t.src + (size_t)(2 * i) * t.N);
}
__device__ __forceinline__ void p0_emit(const TItem& t, const float (&wv)[32], LAS float* scr, int lane) {
#pragma unroll
    for (int i = 0; i < 32; ++i) scr[(2 * i + (lane >> 5)) * 33 + (lane & 31)] = wv[i];
    LDS_WAIT(); asm volatile("" ::: "memory");
    const int c = lane & 7;
#pragma unroll
    for (int j = 0; j < 4; ++j) { const int n = (lane >> 3) + 8 * j; const LAS float* s = scr + (8 * c) * 33 + n;
        v4u o; o.x = pk2(s[0 * 33], s[1 * 33]); o.y = pk2(s[2 * 33], s[3 * 33]); o.z = pk2(s[4 * 33], s[5 * 33]); o.w = pk2(s[6 * 33], s[7 * 33]);
        *(GAS v4u*)(t.dst + (size_t)n * t.K + 8 * c) = o; }
    LDS_WAIT(); asm volatile("" ::: "memory");
}
constexpr int P0_NBIG_IN = 704, P0_NBIG = P0_NBIG_IN + 2 * (DM / 32) + DFF / 32;
struct BigItem { const char* W; unsigned char* dst; float* cs; int N, n0, rbase; bool rot; };
__device__ __forceinline__ BigItem p0_big_item(const Args& A, int item) {
    unsigned char* ws = A.ws; BigItem t; t.rot = false;
    if (item < P0_NBIG_IN) { t.W = (const char*)A.in[7]; t.N = NPW; t.n0 = item < 256 ? OFF_VM + 32 * item : 12320 + 32 * (item - 256); const int d0 = win_map(t.n0); t.rot = d0 >= OFF_QA && d0 < OFF_VA;
        t.rbase = (t.rot ? (d0 & ~63) + ((d0 & 32) ? 4 : 0) : d0) - OFF_KM; t.dst = ws + WS_W8G; t.cs = (float*)(ws + WS_CSG); }
    else if (item < P0_NBIG_IN + 128) { t.W = (const char*)A.in[11]; t.N = DM; t.n0 = 32 * (item - P0_NBIG_IN); t.rbase = t.n0; t.dst = ws + WS_W8OM; t.cs = (float*)(ws + WS_CSOM); }
    else if (item < P0_NBIG_IN + 256) { t.W = (const char*)A.in[12]; t.N = DM; t.n0 = 32 * (item - P0_NBIG_IN - 128); t.rbase = t.n0; t.dst = ws + WS_W8OA; t.cs = (float*)(ws + WS_CSOA); }
    else { t.W = (const char*)A.in[14]; t.N = DFF; t.n0 = 32 * (item - P0_NBIG_IN - 256); t.rbase = t.n0; t.dst = ws + WS_W8F; t.cs = (float*)(ws + WS_CSF); }
    return t;
}
__device__ __forceinline__ unsigned p0_big_voff(const BigItem& t, int wave) {
    int t1; asm volatile("v_mbcnt_lo_u32_b32 %0, -1, 0\n\tv_mbcnt_hi_u32_b32 %0, -1, %0" : "=v"(t1)); t1 += wave * 64;
    return (unsigned)((64 * (t1 >> 3)) * t.N + t.n0 + 4 * (t1 & 7)) * 4u;
}
__device__ __forceinline__ void p0_bigs(const Args& A, LAS unsigned char* lds, int wave, int G) {
    int item = blockIdx.x;
    if (item >= P0_NBIG) return;
    BigItem cur = p0_big_item(A, item);
    unsigned voff = p0_big_voff(cur, wave);
    f32x4 ta[8], tb[8];
#define P0B_LD(t, b, it) _Pragma("unroll") for (int u = 0; u < 8; ++u) t[u] = __builtin_nontemporal_load((const f32x4*)((it).W + (size_t)(8 * (b) + u) * (size_t)(4 * (it).N) + voff));
#define P0B_CV(t, b) _Pragma("unroll") for (int u = 0; u < 8; ++u) { const int p = 8 * (b) + u; d[2 * p] = at::cvt2(t[u].x, t[u].y); d[2 * p + 1] = at::cvt2(t[u].z, t[u].w); \
        a0 = fmaxf(a0, fabsf(t[u].x)); a1 = fmaxf(a1, fabsf(t[u].y)); a2 = fmaxf(a2, fabsf(t[u].z)); a3 = fmaxf(a3, fabsf(t[u].w)); \
        asm volatile("" : "+v"(d[2 * p]), "+v"(d[2 * p + 1]), "+v"(a0), "+v"(a1), "+v"(a2), "+v"(a3)); }
    P0B_LD(ta, 0, cur) P0B_LD(tb, 1, cur)
    for (;;) {
        unsigned d[128]; float a0 = 0.f, a1 = 0.f, a2 = 0.f, a3 = 0.f;
        __builtin_amdgcn_sched_barrier(0);
#pragma unroll
        for (int b = 0; b < 8; b += 2) {
            P0B_CV(ta, b) __builtin_amdgcn_sched_barrier(0);
            if (b + 2 < 8) { P0B_LD(ta, b + 2, cur) } __builtin_amdgcn_sched_barrier(0);
            P0B_CV(tb, b + 1) __builtin_amdgcn_sched_barrier(0);
            if (b + 3 < 8) { P0B_LD(tb, b + 3, cur) } __builtin_amdgcn_sched_barrier(0);
        }
        const int nxt = item + G; const bool more = nxt < P0_NBIG;
        const BigItem nx = p0_big_item(A, more ? nxt : item);
        if (more) { voff = p0_big_voff(nx, wave); P0B_LD(ta, 0, nx) P0B_LD(tb, 1, nx) }
        __builtin_amdgcn_sched_barrier(0);
        int t2; asm volatile("v_mbcnt_lo_u32_b32 %0, -1, 0\n\tv_mbcnt_hi_u32_b32 %0, -1, %0" : "=v"(t2)); t2 += wave * 64;
        const int r8 = t2 >> 3, c4 = t2 & 7, ln = t2 & 63;
        a0 = xmax32(xmax16(fmaxf(a0, dppx<0x128>(a0)))); a1 = xmax32(xmax16(fmaxf(a1, dppx<0x128>(a1)))); a2 = xmax32(xmax16(fmaxf(a2, dppx<0x128>(a2)))); a3 = xmax32(xmax16(fmaxf(a3, dppx<0x128>(a3))));
        LAS float* red = (LAS float*)(lds + LDSCTL_OFF + 1024);
        if (ln < 8) { red[wave * 32 + 4 * ln] = a0; red[wave * 32 + 4 * ln + 1] = a1; red[wave * 32 + 4 * ln + 2] = a2; red[wave * 32 + 4 * ln + 3] = a3; }
        BAR_LDS();
#pragma unroll
        for (int w = 0; w < 8; ++w) { a0 = fmaxf(a0, red[w * 32 + 4 * c4]); a1 = fmaxf(a1, red[w * 32 + 4 * c4 + 1]); a2 = fmaxf(a2, red[w * 32 + 4 * c4 + 2]); a3 = fmaxf(a3, red[w * 32 + 4 * c4 + 3]); }
        const float i0 = a0 > 0.f ? 127.0f / a0 : 0.f, i1 = a1 > 0.f ? 127.0f / a1 : 0.f, i2 = a2 > 0.f ? 127.0f / a2 : 0.f, i3 = a3 > 0.f ? 127.0f / a3 : 0.f;
        const int rbase = cur.rbase; const bool rot = cur.rot;
        if (t2 < 8) { const int nb4 = 4 * c4; float* cs = cur.cs;
            cs[rbase + (rot ? 8 * ((nb4 + 0) >> 2) + ((nb4 + 0) & 3) : nb4 + 0)] = a0 * (1.0f / 127.0f); cs[rbase + (rot ? 8 * ((nb4 + 1) >> 2) + ((nb4 + 1) & 3) : nb4 + 1)] = a1 * (1.0f / 127.0f);
            cs[rbase + (rot ? 8 * ((nb4 + 2) >> 2) + ((nb4 + 2) & 3) : nb4 + 2)] = a2 * (1.0f / 127.0f); cs[rbase + (rot ? 8 * ((nb4 + 3) >> 2) + ((nb4 + 3) & 3) : nb4 + 3)] = a3 * (1.0f / 127.0f); }
        LAS unsigned char* img = lds + c4 * 4096;
#pragma unroll
        for (int j = 0; j < 4; ++j) { const int ch = ((4 * r8 + j) ^ c4) << 4; v4u o0, o1, o2, o3;
#pragma unroll
            for (int e = 0; e < 4; ++e) { const int p = 16 * j + 4 * e;
                o0[e] = q4(bflo(d[2 * p]) * i0, bflo(d[2 * p + 2]) * i0, bflo(d[2 * p + 4]) * i0, bflo(d[2 * p + 6]) * i0);
                o1[e] = q4(bfhi(d[2 * p]) * i1, bfhi(d[2 * p + 2]) * i1, bfhi(d[2 * p + 4]) * i1, bfhi(d[2 * p + 6]) * i1);
                o2[e] = q4(bflo(d[2 * p + 1]) * i2, bflo(d[2 * p + 3]) * i2, bflo(d[2 * p + 5]) * i2, bflo(d[2 * p + 7]) * i2);
                o3[e] = q4(bfhi(d[2 * p + 1]) * i3, bfhi(d[2 * p + 3]) * i3, bfhi(d[2 * p + 5]) * i3, bfhi(d[2 * p + 7]) * i3); }
            *(LAS v4u*)(img + 0 * 32768 + ch) = o0; *(LAS v4u*)(img + 1 * 32768 + ch) = o1; *(LAS v4u*)(img + 2 * 32768 + ch) = o2; *(LAS v4u*)(img + 3 * 32768 + ch) = o3; }
        BAR_LDS();
        int l3; asm volatile("v_mbcnt_lo_u32_b32 %0, -1, 0\n\tv_mbcnt_hi_u32_b32 %0, -1, %0" : "=v"(l3));
#pragma unroll
        for (int i = 0; i < 4; ++i) { const int rho = 4 * wave + i, n = 4 * (rho & 7) + (rho >> 3);
            unsigned char* drow = cur.dst + (size_t)(rbase + (rot ? 8 * (n >> 2) + (n & 3) : n)) * P8;
#pragma unroll
            for (int q = 0; q < 4; ++q) { const int ch = 64 * q + l3; *(GAS v4u*)(drow + 16 * ch) = *(const LAS v4u*)(lds + rho * 4096 + ((ch ^ (rho & 7)) << 4)); } }
        if (!more) break;
        item = nxt; cur = nx;
    }
#undef P0B_LD
#undef P0B_CV
}

__device__ __forceinline__ void p0_prologue(const Args& A, LAS unsigned char* lds, int tid, int lane, int wave, int G) {
    unsigned char* ws = A.ws;
    LAS float* scr = (LAS float*)(lds + wave * 16384);
    const int gw = blockIdx.x * NWAVES + wave, NGW = G * NWAVES;
    { const int maxbig = (P0_NBIG + G - 1) / G, ndefw = (G * maxbig - P0_NBIG) * NWAVES, nextra = 7 * ndefw <= P0_NSMALL ? 7 : 0;
      const int rb = (P0_NSMALL - nextra * ndefw) / NGW, t0 = rb * NGW, t1 = t0 + nextra * ndefw;
      const int wdef = gw - (NGW - ndefw);
      auto sidx = [&](int i) -> int {
          if (i < rb) return i * NGW + gw;
          int j = i - rb;
          if (wdef >= 0) { if (j < nextra) return t0 + j * ndefw + wdef; j -= nextra; }
          return (j == 0 && t1 + gw < P0_NSMALL) ? t1 + gw : -1; };
      float wa[32], wb[32]; int i = 0, ia = sidx(0);
      TItem ta = p0_item(A, ia >= 0 ? ia : 0, lane), tb = ta;
      if (ia >= 0) p0_load(ta, wa);
      while (ia >= 0) {
          const int ib = sidx(i + 1);
          if (ib >= 0) { tb = p0_item(A, ib, lane); p0_load(tb, wb); }
          p0_emit(ta, wa, scr, lane);
          if (ib < 0) break;
          ia = sidx(i + 2);
          if (ia >= 0) { ta = p0_item(A, ia, lane); p0_load(ta, wa); }
          p0_emit(tb, wb, scr, lane);
          i += 2;
      } }
    { float* ROT = (float*)(ws + WS_ROT); const int e = blockIdx.x * NWAVES * 64 + tid;
      if (e < 64 * 32) { const int pos = e >> 5, i = e & 31; const float freq = expf(-(float)i * (1.0f / 32.0f) * 9.210340371976184f), ang = (float)pos * freq; ROT[e] = cosf(ang); ROT[2048 + e] = sinf(ang); } }
    __syncthreads();
    LAS float* sc = (LAS float*)lds;
    LAS float* red = sc + 5 * DM;
    const float* cvec = A.in[1]; const float* cctx = A.in[3]; const float* wmod = A.in[4]; const float* bmod = A.in[5];
    float* MOD = (float*)(ws + WS_MOD);
    for (int e = tid; e < 5 * DM; e += NWAVES * 64) { const int r = e >> 12, k = e & (DM - 1); const float cv = r < 4 ? cvec[r * DM + k] : cctx[k]; sc[e] = cv / (1.0f + expf(-cv)); }
    __syncthreads();
    for (int cg = blockIdx.x; cg < NMOD / 96; cg += G) {
        const int kg = tid >> 5, cl = tid & 31;
        float a0[5], a1[5], a2[5];
#pragma unroll
        for (int r = 0; r < 5; ++r) { a0[r] = 0.f; a1[r] = 0.f; a2[r] = 0.f; }
#pragma unroll 8
        for (int k = kg; k < DM; k += 16) {
            const float* wr = wmod + (size_t)k * NMOD + cg * 96 + cl;
            const float w0 = __builtin_nontemporal_load(wr), w1 = __builtin_nontemporal_load(wr + 32), w2 = __builtin_nontemporal_load(wr + 64);
#pragma unroll
            for (int r = 0; r < 5; ++r) { const float s = sc[r * DM + k]; a0[r] += s * w0; a1[r] += s * w1; a2[r] += s * w2; }
        }
#pragma unroll
        for (int r = 0; r < 5; ++r) { red[((kg * 3 + 0) * 5 + r) * 32 + cl] = a0[r]; red[((kg * 3 + 1) * 5 + r) * 32 + cl] = a1[r]; red[((kg * 3 + 2) * 5 + r) * 32 + cl] = a2[r]; }
        __syncthreads();
        if (tid < 480) { const int cc = tid / 160, r = (tid / 32) % 5, c2 = tid & 31; float s = 0.f;
#pragma unroll
            for (int g = 0; g < 16; ++g) s += red[((g * 3 + cc) * 5 + r) * 32 + c2];
            const int col = cg * 96 + cc * 32 + c2; MOD[r * NMOD + col] = s + bmod[col]; }
        __syncthreads();
    }
}

__device__ __forceinline__ void p1_rows(const Args& A, int lane, int wave, int G) {
    const int gw = blockIdx.x * NWAVES + wave, NGW = G * NWAVES;
    const float* MOD = (const float*)(A.ws + WS_MOD); const float* ng = A.in[6];
    bf16* U = (bf16*)(A.ws + WS_U); unsigned char* U8 = A.ws + WS_U8; float* RSU = (float*)(A.ws + WS_RSU);
    for (int m = gw; m < MT; m += NGW) {
        const float* xr = m < ML ? A.in[0] + (size_t)m * DM : A.in[2] + (size_t)(m - ML) * DM;
        const int r = m < ML ? m / SEQ : 4;
        const f32x4* x4 = (const f32x4*)xr + lane;
        f32x4 v[16]; float ss = 0.f;
#pragma unroll
        for (int j = 0; j < 16; ++j) { v[j] = __builtin_nontemporal_load(x4 + 64 * j); ss += (v[j].x * v[j].x + v[j].y * v[j].y) + (v[j].z * v[j].z + v[j].w * v[j].w); }
        const float rstd = __builtin_amdgcn_rsqf(wave_sum(ss) * (1.0f / DM) + EPS);
        const f32x4* g4 = (const f32x4*)ng + lane; const f32x4* sh4 = (const f32x4*)(MOD + r * NMOD) + lane; const f32x4* s4 = (const f32x4*)(MOD + r * NMOD + DM) + lane;
        unsigned long long* o8 = (unsigned long long*)(U + (size_t)m * PK) + lane; float amax = 0.f;
#pragma unroll
        for (int j = 0; j < 16; ++j) { const f32x4 g = g4[64 * j], sh = sh4[64 * j], s = s4[64 * j]; const f32x4 y = v[j] * rstd * g; const f32x4 u = y * (1.0f + s) + sh; v[j] = u;
            amax = fmaxf(amax, fmaxf(fmaxf(fabsf(u.x), fabsf(u.y)), fmaxf(fabsf(u.z), fabsf(u.w))));
            o8[64 * j] = (unsigned long long)pk2(u.x, u.y) | ((unsigned long long)pk2(u.z, u.w) << 32); }
        { amax = wave_max(amax); const float inv = amax > 0.f ? 127.0f / amax : 0.f; if (lane == 0) RSU[m] = amax * (1.0f / 127.0f);
            unsigned* d8 = (unsigned*)(U8 + (size_t)m * P8) + lane;
#pragma unroll
            for (int j = 0; j < 16; ++j) d8[64 * j] = q4(v[j].x * inv, v[j].y * inv, v[j].z * inv, v[j].w * inv); }
    }
}

__device__ __forceinline__ void ld8f(const float* p, f32x4& a, f32x4& b) { a = *(const f32x4*)p; b = *(const f32x4*)(p + 4); }
__device__ __forceinline__ void ld8f_nt(const float* p, f32x4& a, f32x4& b) { a = __builtin_nontemporal_load((const f32x4*)p); b = __builtin_nontemporal_load((const f32x4*)(p + 4)); }
__device__ __forceinline__ void un8(const v4u w, f32x4& a, f32x4& b) { a = (f32x4){bflo(w.x), bfhi(w.x), bflo(w.y), bfhi(w.y)}; b = (f32x4){bflo(w.z), bfhi(w.z), bflo(w.w), bfhi(w.w)}; }
__device__ __forceinline__ float sq8(const f32x4& a, const f32x4& b) { return (a.x * a.x + a.y * a.y) + (a.z * a.z + a.w * a.w) + (b.x * b.x + b.y * b.y) + (b.z * b.z + b.w * b.w); }
__device__ __forceinline__ float amax8(const f32x4& a, const f32x4& b) { return fmaxf(fmaxf(fmaxf(fabsf(a.x), fabsf(a.y)), fmaxf(fabsf(a.z), fabsf(a.w))), fmaxf(fmaxf(fabsf(b.x), fabsf(b.y)), fmaxf(fabsf(b.z), fabsf(b.w)))); }
__device__ __forceinline__ void p5_readout(const Args& A, int lane, int wave, int G) {
    const int gw = blockIdx.x * NWAVES + wave, NGW = G * NWAVES;
    const bf16* HF = (const bf16*)(A.ws + WS_HF); const bf16* HB = (const bf16*)(A.ws + WS_HB); const bf16* AT = (const bf16*)(A.ws + WS_AT);
    const bf16* P = (const bf16*)(A.ws + WS_P); const float* mng = A.in[9];
    unsigned char* HM8 = A.ws + WS_HM8; unsigned char* AT8 = A.ws + WS_AT8; float* RSHM = (float*)(A.ws + WS_RSHM); float* RSAT = (float*)(A.ws + WS_RSAT);
    for (int row = gw; row < ML; row += NGW) {
        f32x4 va[8], vb[8]; float amax = 0.f;
#pragma unroll
        for (int h = 0; h < 8; ++h) { const size_t off = (size_t)row * DM + h * DV + 8 * lane;
            const v4u hf = *(const v4u*)(HF + off), hb = *(const v4u*)(HB + off); const v4u om = *(const v4u*)(P + (size_t)row * NP + OFF_OM + h * DV + 8 * lane);
            f32x4 a0 = (f32x4){bflo(hf.x) + bflo(hb.x), bfhi(hf.x) + bfhi(hb.x), bflo(hf.y) + bflo(hb.y), bfhi(hf.y) + bfhi(hb.y)}, a1 = (f32x4){bflo(hf.z) + bflo(hb.z), bfhi(hf.z) + bfhi(hb.z), bflo(hf.w) + bflo(hb.w), bfhi(hf.w) + bfhi(hb.w)};
            const float rstd = __builtin_amdgcn_rsqf(wave_sum(sq8(a0, a1)) * (1.0f / DV) + EPS);
            const f32x4 g0 = *(const f32x4*)(mng + h * DV + 8 * lane), g1 = *(const f32x4*)(mng + h * DV + 8 * lane + 4);
            a0 = a0 * rstd * g0 * (f32x4){sigm(bflo(om.x)), sigm(bfhi(om.x)), sigm(bflo(om.y)), sigm(bfhi(om.y))}; a1 = a1 * rstd * g1 * (f32x4){sigm(bflo(om.z)), sigm(bfhi(om.z)), sigm(bflo(om.w)), sigm(bfhi(om.w))};
            va[h] = a0; vb[h] = a1; amax = fmaxf(amax, amax8(a0, a1)); }
        amax = wave_max(amax); float inv = amax > 0.f ? 127.0f / amax : 0.f; if (lane == 0) RSHM[row] = amax * (1.0f / 127.0f);
#pragma unroll
        for (int h = 0; h < 8; ++h) { uint2 o; o.x = q4(va[h].x * inv, va[h].y * inv, va[h].z * inv, va[h].w * inv); o.y = q4(vb[h].x * inv, vb[h].y * inv, vb[h].z * inv, vb[h].w * inv);
            *(uint2*)(HM8 + (size_t)row * P8 + h * DV + 8 * lane) = o; }
        amax = 0.f;
#pragma unroll
        for (int j = 0; j < 8; ++j) { un8(*(const v4u*)(AT + (size_t)row * PK + 8 * lane + 512 * j), va[j], vb[j]); amax = fmaxf(amax, amax8(va[j], vb[j])); }
        amax = wave_max(amax); inv = amax > 0.f ? 127.0f / amax : 0.f; if (lane == 0) RSAT[row] = amax * (1.0f / 127.0f);
#pragma unroll
        for (int j = 0; j < 8; ++j) { uint2 o; o.x = q4(va[j].x * inv, va[j].y * inv, va[j].z * inv, va[j].w * inv); o.y = q4(vb[j].x * inv, vb[j].y * inv, vb[j].z * inv, vb[j].w * inv);
            *(uint2*)(AT8 + (size_t)row * P8 + 8 * lane + 512 * j) = o; }
    }
}

__device__ __forceinline__ void p8_rows(const Args& A, int lane, int wave, int G) {
    const int gw = blockIdx.x * NWAVES + wave, NGW = G * NWAVES;
    const float* MOD = (const float*)(A.ws + WS_MOD); const float* ng = A.in[6];
    const bf16* MIX = (const bf16*)(A.ws + WS_MIX); unsigned char* U28 = A.ws + WS_U28; float* RS2 = (float*)(A.ws + WS_RS2); bf16* H1 = (bf16*)(A.ws + WS_HB);
    for (int m = gw; m < ML; m += NGW) {
        const int r = m / SEQ; const size_t ro = (size_t)m * DM + 8 * lane; const int co = 8 * lane;
        f32x4 va[8], vb[8]; float ss = 0.f;
#pragma unroll
        for (int j = 0; j < 8; ++j) { un8(*(const v4u*)(MIX + ro + 512 * j), va[j], vb[j]); ss += sq8(va[j], vb[j]); }
        const float rstd = __builtin_amdgcn_rsqf(wave_sum(ss) * (1.0f / DM) + EPS);
        const float* n1 = ng + DM + co; const float* g1 = MOD + r * NMOD + 2 * DM + co; const float* x = A.in[0] + ro; float ss2 = 0.f;
#pragma unroll
        for (int j = 0; j < 8; ++j) { f32x4 xa, xb, na, nb, ga, gb; ld8f_nt(x + 512 * j, xa, xb); ld8f(n1 + 512 * j, na, nb); ld8f(g1 + 512 * j, ga, gb);
            va[j] = xa + ga * (va[j] * rstd * na); vb[j] = xb + gb * (vb[j] * rstd * nb); ss2 += sq8(va[j], vb[j]);
            { v4u hw; hw.x = pk2(va[j].x, va[j].y); hw.y = pk2(va[j].z, va[j].w); hw.z = pk2(vb[j].x, vb[j].y); hw.w = pk2(vb[j].z, vb[j].w); *(v4u*)(H1 + ro + 512 * j) = hw; } }
        const float rstd2 = __builtin_amdgcn_rsqf(wave_sum(ss2) * (1.0f / DM) + EPS);
        const float* n2 = ng + 2 * DM + co; const float* sh2 = MOD + r * NMOD + 3 * DM + co; const float* s2 = MOD + r * NMOD + 4 * DM + co;
        float amax = 0.f;
#pragma unroll
        for (int j = 0; j < 8; ++j) { f32x4 na, nb, ha, hb, sa, sb; ld8f(n2 + 512 * j, na, nb); ld8f(sh2 + 512 * j, ha, hb); ld8f(s2 + 512 * j, sa, sb);
            va[j] = (va[j] * rstd2 * na) * (1.0f + sa) + ha; vb[j] = (vb[j] * rstd2 * nb) * (1.0f + sb) + hb;
            amax = fmaxf(amax, fmaxf(fmaxf(fmaxf(fabsf(va[j].x), fabsf(va[j].y)), fmaxf(fabsf(va[j].z), fabsf(va[j].w))), fmaxf(fmaxf(fabsf(vb[j].x), fabsf(vb[j].y)), fmaxf(fabsf(vb[j].z), fabsf(vb[j].w))))); }
        amax = wave_max(amax); const float inv = amax > 0.f ? 127.0f / amax : 0.f; if (lane == 0) RS2[m] = amax * (1.0f / 127.0f);
#pragma unroll
        for (int j = 0; j < 8; ++j) { uint2 o; o.x = q4(va[j].x * inv, va[j].y * inv, va[j].z * inv, va[j].w * inv); o.y = q4(vb[j].x * inv, vb[j].y * inv, vb[j].z * inv, vb[j].w * inv);
            *(uint2*)(U28 + (size_t)m * P8 + co + 512 * j) = o; }
    }
}

__device__ __forceinline__ void p11_rows(const Args& A, int lane, int wave, int G, bool poison) {
    const int gw = blockIdx.x * NWAVES + wave, NGW = G * NWAVES;
    const float* MOD = (const float*)(A.ws + WS_MOD); const float* ng = A.in[6];
    const bf16* Fb = (const bf16*)(A.ws + WS_F); const bf16* H1 = (const bf16*)(A.ws + WS_HB);
    for (int m = gw; m < ML; m += NGW) {
        const int r = m / SEQ; const size_t ro = (size_t)m * DM + 8 * lane; const int co = 8 * lane;
        f32x4 va[8], vb[8]; float ss = 0.f;
#pragma unroll
        for (int j = 0; j < 8; ++j) { un8(*(const v4u*)(Fb + ro + 512 * j), va[j], vb[j]); ss += sq8(va[j], vb[j]); }
        const float rstd3 = __builtin_amdgcn_rsqf(wave_sum(ss) * (1.0f / DM) + EPS);
        const float* n3 = ng + 3 * DM + co; const float* g2 = MOD + r * NMOD + 5 * DM + co;
        const float qn = __builtin_nanf("");
#pragma unroll
        for (int j = 0; j < 8; ++j) { f32x4 ma, mb, ta, tb, ha, hb; un8(*(const v4u*)(H1 + ro + 512 * j), ma, mb);
            ld8f(n3 + 512 * j, ta, tb); ld8f(g2 + 512 * j, ha, hb);
            f32x4 oa = ma + ha * (va[j] * rstd3 * ta), ob = mb + hb * (vb[j] * rstd3 * tb);
            if (poison) { oa = (f32x4){qn, qn, qn, qn}; ob = oa; }
            __builtin_nontemporal_store(oa, (f32x4*)(A.out + ro + 512 * j)); __builtin_nontemporal_store(ob, (f32x4*)(A.out + ro + 512 * j + 4)); }
    }
}

__global__ void __launch_bounds__(NWAVES * 64, 2) fwd_kernel(Args args) {
    extern __shared__ __attribute__((aligned(16))) unsigned char lds_raw[];
    LAS unsigned char* lds = (LAS unsigned char*)lds_raw;
    volatile LAS unsigned* MISC = (volatile LAS unsigned*)(lds + MISC_OFF);
    const int tid0 = threadIdx.x, wave = __builtin_amdgcn_readfirstlane(tid0 >> 6), G = gridDim.x;
    unsigned char* ws = args.ws;
    gu32* ctl = (gu32*)(ws + WS_CTL);
    for (int u = tid0; u < (LDS_BYTES - LDSCTL_OFF) / 4; u += NWAVES * 64) ((LAS unsigned*)(lds + LDSCTL_OFF))[u] = 0u;
    __syncthreads();
    XcdBarrier bar; bar.wave = wave; bar.bar = (unsigned*)(ctl + CW_BAR); bar.x = 0; bar.st = nullptr;
    if (N_LAUNCHES == 1) bar = xcd_barrier_post((unsigned*)(ctl + CW_BAR), MISC + 8, wave);
    const int lo = args.ph_lo, hi = args.ph_hi;
#define IN(k) (lo <= (k) && (k) < hi)
#define PHASE_IDS const int lane = (int)__builtin_amdgcn_mbcnt_hi(~0u, __builtin_amdgcn_mbcnt_lo(~0u, 0u)); const int tid = wave * 64 + lane
#define SEAM(k) do { if (IN(k) && IN((k) + 1)) xcd_barrier(bar); } while (0)

    if (IN(0)) {
        p0_bigs(args, lds, wave, G);
        __syncthreads();
        int lane; asm volatile("v_mbcnt_lo_u32_b32 %0, -1, 0\n\tv_mbcnt_hi_u32_b32 %0, -1, %0" : "=v"(lane)); const int tid = wave * 64 + lane;
        p0_prologue(args, lds, tid, lane, wave, G); } SEAM(0);
    if (IN(1)) { PHASE_IDS; p1_rows(args, lane, wave, G); } SEAM(1);
    if (IN(2)) { PHASE_IDS;
        { pg8::Gemm g{(const pg8::bf16_t*)(ws + WS_U), (const pg8::bf16_t*)(ws + WS_WIN), MT, NP, DM, PK, PK}; pg8::ProjOrder S; S.init(G, (int)blockIdx.x);
          pg8::Epi8<pg8::FProj> E{{(pg8::bf16_t*)(ws + WS_P), (float*)(ws + WS_G), (const float*)(ws + WS_ROT), NP, OFF_GM / 256}};
          pg8::gemm_phase<pg8::Epi8<pg8::FProj>, pg8::ProjOrder, true, true>(lds + RING_OFF, g, S, E, wave); }
        { pg8::Gemm g{(const pg8::bf16_t*)(ws + WS_U8), (const pg8::bf16_t*)(ws + WS_W8G), MT, N8P, DM / 2, P8 / 2, P8 / 2}; pg8::ProjOrderI8 S; S.init(G, (int)blockIdx.x, 32 * 17 + 4 * 9);
          pg8::Epi8B<pg8::FProjI8> E{{(pg8::bf16_t*)(ws + WS_P), (const float*)(ws + WS_RSU), (const float*)(ws + WS_CSG), (const float*)(ws + WS_ROT), NP, OFF_KM}};
          pg8::gemm_phase<pg8::Epi8B<pg8::FProjI8>, pg8::ProjOrderI8, true, true, true>(lds + RING_OFF, g, S, E, wave); }
    } SEAM(2);
    if (IN(3)) { PHASE_IDS;
        for (int item = blockIdx.x; item < NB * MH * 2 * 4; item += G) ml::mlstm_item(args, lds, tid, lane, wave, item);
        __syncthreads();
        { PHASE_IDS; at::attn_items(args, lds, tid, lane, wave, G); }
        __syncthreads();
    } SEAM(3);
    if (IN(4)) { PHASE_IDS; p5_readout(args, lane, wave, G); } SEAM(4);
    if (IN(5)) { PHASE_IDS;
        { pg8::Gemm g{(const pg8::bf16_t*)(ws + WS_HM8), (const pg8::bf16_t*)(ws + WS_W8OM), ML, DM, DM / 2, P8 / 2, P8 / 2}; pg8::StaticOrder S; S.init(ML, DM, G, (int)blockIdx.x);
          pg8::Epi8B<pg8::FGateM8> E{{(const pg8::bf16_t*)(ws + WS_P) + OFF_BGM, NP, (pg8::bf16_t*)(ws + WS_T), DM, (const float*)(ws + WS_RSHM), (const float*)(ws + WS_CSOM)}};
          pg8::gemm_phase<pg8::Epi8B<pg8::FGateM8>, pg8::StaticOrder, true, true, true>(lds + RING_OFF, g, S, E, wave); }
        { pg8::Gemm g{(const pg8::bf16_t*)(ws + WS_AT8), (const pg8::bf16_t*)(ws + WS_W8OA), ML, DM, DM / 2, P8 / 2, P8 / 2}; pg8::StaticOrder S; S.init(ML, DM, G, (int)blockIdx.x);
          pg8::Epi8B<pg8::FGateA8> E{{(const pg8::bf16_t*)(ws + WS_P) + OFF_BGA, NP, (const pg8::bf16_t*)(ws + WS_T), (pg8::bf16_t*)(ws + WS_YG), DM, PK, (const float*)(ws + WS_RSAT), (const float*)(ws + WS_CSOA)}};
          pg8::gemm_phase<pg8::Epi8B<pg8::FGateA8>, pg8::StaticOrder, true, true, true>(lds + RING_OFF, g, S, E, wave); }
    } SEAM(5);
    if (IN(6)) { PHASE_IDS;
        pg8::Gemm g{(const pg8::bf16_t*)(ws + WS_YG), (const pg8::bf16_t*)(ws + WS_WO), ML, DM, DM, PK, PK}; pg8::StaticOrder S; S.init(ML, DM, G, (int)blockIdx.x);
        pg8::Epi8<pg8::FBf16> E{{(pg8::bf16_t*)(ws + WS_MIX), DM}};
        pg8::gemm_phase<pg8::Epi8<pg8::FBf16>, pg8::StaticOrder, true, true>(lds + RING_OFF, g, S, E, wave);
    } SEAM(6);
    if (IN(7)) { PHASE_IDS; p8_rows(args, lane, wave, G); } SEAM(7);
    if (IN(8)) { PHASE_IDS;
        pg8::Gemm g{(const pg8::bf16_t*)(ws + WS_U28), (const pg8::bf16_t*)(ws + WS_W8F), ML, DFF, DM / 2, P8 / 2, P8 / 2}; pg8::StaticOrder S; S.init(ML, DFF, G, (int)blockIdx.x);
        pg8::Epi8B<pg8::FRelu2I8> E{{(pg8::bf16_t*)(ws + WS_HDN), (const float*)(ws + WS_RS2), (const float*)(ws + WS_CSF), PF}};
        pg8::gemm_phase<pg8::Epi8B<pg8::FRelu2I8>, pg8::StaticOrder, true, true, true>(lds + RING_OFF, g, S, E, wave);
    } SEAM(8);
    if (IN(9)) { PHASE_IDS;
        pg8::Gemm g{(const pg8::bf16_t*)(ws + WS_HDN), (const pg8::bf16_t*)(ws + WS_WF2), ML, DM, DFF, PF, PF}; pg8::StaticOrder S; S.init(ML, DM, G, (int)blockIdx.x);
        pg8::Epi8<pg8::FBf16> E{{(pg8::bf16_t*)(ws + WS_F), DM}};
        pg8::gemm_phase<pg8::Epi8<pg8::FBf16>, pg8::StaticOrder, true, true>(lds + RING_OFF, g, S, E, wave);
    } SEAM(9);
    if (IN(10)) { PHASE_IDS;
        const bool poison = (N_LAUNCHES == 1) && (__hip_atomic_load(ctl + CW_BAR + XB_TMO, RLX_AGENT) != 0u);
        p11_rows(args, lane, wave, G, poison);
    }
#undef IN
#undef SEAM
}

extern "C" void kernel_launch(void* const* d_in, const int* in_sizes, int n_in, void* d_out, int out_size, void* d_ws, size_t ws_size, hipStream_t stream) {
    static int grid = 0;
    if (grid == 0) {
        if (n_in != 16 || out_size != ML * DM || ws_size < WS_END2) { fprintf(stderr, "kernel_launch: unexpected shapes: n_in %d out %d ws %zu (need %zu); nothing launched\n", n_in, out_size, ws_size, (size_t)WS_END2); grid = -1; return; }
        int dev = 0, cus = 0, per_cu = 0;
        if (hipGetDevice(&dev) != hipSuccess || hipDeviceGetAttribute(&cus, hipDeviceAttributeMultiprocessorCount, dev) != hipSuccess) { grid = -1; return; }
        if (hipFuncSetAttribute((const void*)fwd_kernel, hipFuncAttributeMaxDynamicSharedMemorySize, LDS_BYTES) != hipSuccess) { fprintf(stderr, "kernel_launch: hipFuncSetAttribute failed\n"); grid = -1; return; }
        if (hipOccupancyMaxActiveBlocksPerMultiprocessor(&per_cu, (const void*)fwd_kernel, NWAVES * 64, LDS_BYTES) != hipSuccess || per_cu < 1)
            fprintf(stderr, "kernel_launch: note: occupancy query reports %d workgroups per CU\n", per_cu);
        (void)hipGetLastError();
        grid = cus;
    }
    if (grid < 0) return;
    if (hipMemsetAsync((char*)d_ws + WS_CTL, 0, CTL_ZERO_BYTES, stream) != hipSuccess) { fprintf(stderr, "kernel_launch: memset failed\n"); return; }
    Args a{};
    for (int i = 0; i < 16; ++i) a.in[i] = (const float*)d_in[i];
    a.out = (float*)d_out; a.ws = (unsigned char*)d_ws;
    for (int li = 0; li < N_LAUNCHES; ++li) {
        a.ph_lo = (N_LAUNCHES == 1) ? 0 : li; a.ph_hi = (N_LAUNCHES == 1) ? N_PHASES : li + 1;
        hipLaunchKernelGGL(fwd_kernel, dim3(grid), dim3(NWAVES * 64), LDS_BYTES, stream, a);
        const hipError_t le = hipPeekAtLastError();
        if (le != hipSuccess) { fprintf(stderr, "kernel_launch: launch %d failed: %s\n", li, hipGetErrorName(le)); break; }
    }
}
```

```cpp
#define MK_N_LAUNCHES 1
#include <hip/hip_runtime.h>
#include <cstdio>
#include <cstdint>
namespace pg8 {
#define PG8_LAS __attribute__((address_space(3)))
typedef unsigned short bf16_t;
typedef short bf16x8 __attribute__((ext_vector_type(8)));
typedef float f32x4 __attribute__((ext_vector_type(4)));
typedef unsigned u32x4 __attribute__((ext_vector_type(4)));
constexpr int BM = 256, BK = 64, HALF = 128, HTB = HALF * BK * 2  , STAGE_BYTES = 8 * HTB, NXCD = 8, WGM = 8;

__host__ __device__ __forceinline__ int lds_byte(int r, int c) { const int st = (r >> 4) * 2 + (c >> 5), rr = r & 15, cc = c & 31, ob = rr * 64 + cc * 2; return st * 1024 + (ob ^ (((ob >> 9) & 1) << 5)); }
__host__ __device__ __forceinline__ void stage_rc(int b, int& R, int& C) { const int st = b / 1024, sb = b % 1024, swz = sb ^ (((sb >> 9) & 1) << 5); R = (st >> 1) * 16 + swz / 64; C = (st & 1) * 32 + (swz % 64) / 2; }
__host__ __device__ __forceinline__ int perm32(int rho) { const int n = rho >> 4, i = rho & 15; return 8 * (i >> 2) + 4 * n + (i & 3); }

struct Unit { int pm, pn; };
struct Gemm { const bf16_t* A; const bf16_t* Bt; int M, N, K, lda, ldb; };

struct StaticOrder {
    int nM, nN, nwg, G, c;
    __host__ __device__ void init(int M, int N, int G_, int c_) { nM = M / BM; nN = N / BM; nwg = nM * nN; G = G_; c = c_; }
    __host__ __device__ bool next(int i, Unit& u) const { return at((long)i * G + c, u); }
    __host__ __device__ bool at(const long L, Unit& u) const {
        if (L >= nwg) return false;
        int wgid = (int)L; { const int q = nwg / NXCD, r = nwg % NXCD, xcd = wgid % NXCD, off = wgid / NXCD; wgid = (xcd < r ? xcd * (q + 1) : r * (q + 1) + (xcd - r) * q) + off; }
        const int nig = WGM * nN, gid = wgid / nig, fm = gid * WGM, gsz = (nM - fm) < WGM ? (nM - fm) : WGM;
        u.pm = fm + ((wgid % nig) % gsz); u.pn = (wgid % nig) / gsz; return true;
    }
    __device__ __forceinline__ void a_ready(const Unit&) const {}
    __device__ __forceinline__ void done(const Unit&) const {}
};

__device__ __forceinline__ unsigned cvt_pk_bf16(float lo, float hi) { unsigned r; asm volatile("v_cvt_pk_bf16_f32 %0, %1, %2" : "=v"(r) : "v"(lo), "v"(hi)); return r; }
typedef float f32x2 __attribute__((ext_vector_type(2)));

__device__ __forceinline__ float bf_lo(unsigned w) { return __builtin_bit_cast(float, w << 16); }
__device__ __forceinline__ float bf_hi(unsigned w) { return __builtin_bit_cast(float, w & 0xffff0000u); }
__device__ __forceinline__ float sigmoidf_(float x) { return __builtin_amdgcn_rcpf(1.0f + __expf(-x)); }
template <class F> struct Epi8 {
    static constexpr bool PERM = true, AFTER_DRAIN = false;
    F f;
    __device__ __forceinline__ void operator()(const f32x4 (&acc)[2][2][4][2], const Unit& u, int wr, int wc, int fr, int fq) const {
        const int row0 = u.pm * BM + wr * 64 + fr, col0 = u.pn * BM + wc * 32 + 8 * fq;
#pragma unroll
        for (int ai = 0; ai < 2; ++ai)
#pragma unroll
            for (int m = 0; m < 4; ++m) { const int row = row0 + ai * HALF + m * 16;
#pragma unroll
                for (int bj = 0; bj < 2; ++bj) f(row, col0 + bj * HALF, acc[ai][bj][m][0], acc[ai][bj][m][1], u.pn); }
    }
};
__device__ __forceinline__ u32x4 pack8(const f32x4& v0, const f32x4& v1) { u32x4 w; w.x = cvt_pk_bf16(v0[0], v0[1]); w.y = cvt_pk_bf16(v0[2], v0[3]); w.z = cvt_pk_bf16(v1[0], v1[1]); w.w = cvt_pk_bf16(v1[2], v1[3]); return w; }
struct FProj { bf16_t* P; float* G; const float* ROT; int ldp; int gate_pn;
    __device__ __forceinline__ void operator()(int row, int col, const f32x4& v0, const f32x4& v1, int pn) const {
        if (pn == gate_pn) { const int cl = col - gate_pn * BM; if (cl < 32) { *(f32x4*)(G + (size_t)row * 32 + cl) = v0; *(f32x4*)(G + (size_t)row * 32 + cl + 4) = v1; } }
        else if (pn < 8) *(u32x4*)(P + (size_t)row * ldp + col) = pack8(v0 * 0.0625f, v1 * 0.0625f);
        else if (pn >= 48 && pn < 68 && row < 8192) { const int hp = col & 127, t = row & 2047, pos = (hp & 64) ? (t & 63) : (t >> 6), i0 = (hp & 63) >> 1;
            const f32x4 cs = *(const f32x4*)(ROT + pos * 32 + i0), sn = *(const f32x4*)(ROT + 2048 + pos * 32 + i0);
            *(u32x4*)(P + (size_t)row * ldp + col) = pack8(v0 * cs - v1 * sn, v0 * sn + v1 * cs); }
        else *(u32x4*)(P + (size_t)row * ldp + col) = pack8(v0, v1);
    } };
struct ProjOrder {
    StaticOrder base; int G, c;
    __host__ __device__ void init(int G_, int c_) { base.init(8192, 17 * 256, G_, c_); G = G_; c = c_; }
    __host__ __device__ bool next(int i, Unit& u) const { const long L = (long)i * G + c;
        if (L < base.nwg) { base.next(i, u); if (u.pn == 16) u.pn = 104; return true; }
        const int r = (int)(L - base.nwg); if (r >= 4 * 9) return false; u.pm = 32 + (r & 3); const int j = r >> 2; u.pn = j < 8 ? 8 + j : 104; return true; }
    __device__ __forceinline__ void a_ready(const Unit&) const {}
    __device__ __forceinline__ void done(const Unit&) const {}
};
struct ProjOrderI8 {
    StaticOrder base; int G, c, nheavy, qh;
    __host__ __device__ void init(int G_, int c_, int n_bf16_units) { base.init(8192, 88 * 256, G_, 0); G = G_; c = c_; nheavy = n_bf16_units % G_;
        const int ni = base.nwg + 4 * 24; int q = (ni - 2 * (G_ - nheavy) + G_ - 1) / G_; qh = q < 0 ? 0 : q; }
    __host__ __device__ bool next(int i, Unit& u) const {
        long L; if (i < qh) L = (long)i * G + c; else { if (c < nheavy) return false; L = (long)qh * G + (long)(i - qh) * (G - nheavy) + (c - nheavy); }
        if (L < base.nwg) { base.at(L, u); u.pn += 8; return true; }
        const int r = (int)(L - base.nwg); if (r >= 4 * 24) return false; u.pm = 32 + (r & 3); const int j = r >> 2; u.pn = j < 16 ? 8 + j : 40 + j; return true; }
    __device__ __forceinline__ void a_ready(const Unit&) const {}
    __device__ __forceinline__ void done(const Unit&) const {}
};
__device__ __forceinline__ float i2f(float bits) { return (float)__builtin_bit_cast(int, bits); }
__device__ __forceinline__ f32x4 i2f4(const f32x4& v) { return (f32x4){i2f(v[0]), i2f(v[1]), i2f(v[2]), i2f(v[3])}; }
struct FProjI8 { bf16_t* P; const float* rs; const float* cs; const float* ROT; int ldp; int off_a;
    __device__ __forceinline__ void operator()(int row, int col, const f32x4& v0, const f32x4& v1, int pn) const {
        const float r = rs[row]; const f32x4 c0 = *(const f32x4*)(cs + col) * r, c1 = *(const f32x4*)(cs + col + 4) * r;
        f32x4 a = i2f4(v0) * c0, b = i2f4(v1) * c1;
        const int oc = off_a + col;
        if (pn >= 40 && pn < 60 && row < 8192) { const int hp = oc & 127, t = row & 2047, pos = (hp & 64) ? (t & 63) : (t >> 6), i0 = (hp & 63) >> 1;
            const f32x4 csn = *(const f32x4*)(ROT + pos * 32 + i0), sn = *(const f32x4*)(ROT + 2048 + pos * 32 + i0);
            const f32x4 ra = a * csn - b * sn, rb = a * sn + b * csn; a = ra; b = rb; }
        *(u32x4*)(P + (size_t)row * ldp + oc) = pack8(a, b);
    } };
struct FGateM { const bf16_t* Pg; int ldp; bf16_t* T; int ldt;
    __device__ __forceinline__ void operator()(int row, int col, const f32x4& v0, const f32x4& v1, int) const {
        const u32x4 g = *(const u32x4*)(Pg + (size_t)row * ldp + col);
        f32x4 a, b; a[0] = sigmoidf_(bf_lo(g.x)) * v0[0]; a[1] = sigmoidf_(bf_hi(g.x)) * v0[1]; a[2] = sigmoidf_(bf_lo(g.y)) * v0[2]; a[3] = sigmoidf_(bf_hi(g.y)) * v0[3];
        b[0] = sigmoidf_(bf_lo(g.z)) * v1[0]; b[1] = sigmoidf_(bf_hi(g.z)) * v1[1]; b[2] = sigmoidf_(bf_lo(g.w)) * v1[2]; b[3] = sigmoidf_(bf_hi(g.w)) * v1[3];
        *(u32x4*)(T + (size_t)row * ldt + col) = pack8(a, b);
    } };
struct FGateA { const bf16_t* Pg; int ldp; const bf16_t* T; bf16_t* Y; int ldt, ldy;
    __device__ __forceinline__ void operator()(int row, int col, const f32x4& v0, const f32x4& v1, int) const {
        const u32x4 g = *(const u32x4*)(Pg + (size_t)row * ldp + col), t = *(const u32x4*)(T + (size_t)row * ldt + col);
        f32x4 a, b;
        a[0] = bf_lo(t.x) + sigmoidf_(bf_lo(g.x)) * v0[0]; a[1] = bf_hi(t.x) + sigmoidf_(bf_hi(g.x)) * v0[1]; a[2] = bf_lo(t.y) + sigmoidf_(bf_lo(g.y)) * v0[2]; a[3] = bf_hi(t.y) + sigmoidf_(bf_hi(g.y)) * v0[3];
        b[0] = bf_lo(t.z) + sigmoidf_(bf_lo(g.z)) * v1[0]; b[1] = bf_hi(t.z) + sigmoidf_(bf_hi(g.z)) * v1[1]; b[2] = bf_lo(t.w) + sigmoidf_(bf_lo(g.w)) * v1[2]; b[3] = bf_hi(t.w) + sigmoidf_(bf_hi(g.w)) * v1[3];
        *(u32x4*)(Y + (size_t)row * ldy + col) = pack8(a, b);
    } };
struct FGateM8 { const bf16_t* Pg; int ldp; bf16_t* T; int ldt; const float* rs; const float* cs;
    __device__ __forceinline__ void operator()(int row, int col, const f32x4& v0, const f32x4& v1, int) const {
        const float r = rs[row]; const f32x4 c0 = *(const f32x4*)(cs + col) * r, c1 = *(const f32x4*)(cs + col + 4) * r;
        const u32x4 g = *(const u32x4*)(Pg + (size_t)row * ldp + col);
        f32x4 a, b; a[0] = sigmoidf_(bf_lo(g.x)) * i2f(v0[0]) * c0[0]; a[1] = sigmoidf_(bf_hi(g.x)) * i2f(v0[1]) * c0[1]; a[2] = sigmoidf_(bf_lo(g.y)) * i2f(v0[2]) * c0[2]; a[3] = sigmoidf_(bf_hi(g.y)) * i2f(v0[3]) * c0[3];
        b[0] = sigmoidf_(bf_lo(g.z)) * i2f(v1[0]) * c1[0]; b[1] = sigmoidf_(bf_hi(g.z)) * i2f(v1[1]) * c1[1]; b[2] = sigmoidf_(bf_lo(g.w)) * i2f(v1[2]) * c1[2]; b[3] = sigmoidf_(bf_hi(g.w)) * i2f(v1[3]) * c1[3];
        *(u32x4*)(T + (size_t)row * ldt + col) = pack8(a, b);
    } };
struct FGateA8 { const bf16_t* Pg; int ldp; const bf16_t* T; bf16_t* Y; int ldt, ldy; const float* rs; const float* cs; unsigned* rmax;
    __device__ __forceinline__ void operator()(int row, int col, const f32x4& v0, const f32x4& v1, int) const {
        const float r = rs[row]; const f32x4 c0 = *(const f32x4*)(cs + col) * r, c1 = *(const f32x4*)(cs + col + 4) * r;
        const u32x4 g = *(const u32x4*)(Pg + (size_t)row * ldp + col), t = *(const u32x4*)(T + (size_t)row * ldt + col);
        f32x4 a, b;
        a[0] = bf_lo(t.x) + sigmoidf_(bf_lo(g.x)) * i2f(v0[0]) * c0[0]; a[1] = bf_hi(t.x) + sigmoidf_(bf_hi(g.x)) * i2f(v0[1]) * c0[1]; a[2] = bf_lo(t.y) + sigmoidf_(bf_lo(g.y)) * i2f(v0[2]) * c0[2]; a[3] = bf_hi(t.y) + sigmoidf_(bf_hi(g.y)) * i2f(v0[3]) * c0[3];
        b[0] = bf_lo(t.z) + sigmoidf_(bf_lo(g.z)) * i2f(v1[0]) * c1[0]; b[1] = bf_hi(t.z) + sigmoidf_(bf_hi(g.z)) * i2f(v1[1]) * c1[1]; b[2] = bf_lo(t.w) + sigmoidf_(bf_lo(g.w)) * i2f(v1[2]) * c1[2]; b[3] = bf_hi(t.w) + sigmoidf_(bf_hi(g.w)) * i2f(v1[3]) * c1[3];
        *(u32x4*)(Y + (size_t)row * ldy + col) = pack8(a, b);
        float mx = fmaxf(fmaxf(fmaxf(fabsf(a[0]), fabsf(a[1])), fmaxf(fabsf(a[2]), fabsf(a[3]))), fmaxf(fmaxf(fabsf(b[0]), fabsf(b[1])), fmaxf(fabsf(b[2]), fabsf(b[3]))));
        mx = fmaxf(mx, __shfl_xor(mx, 16)); mx = fmaxf(mx, __shfl_xor(mx, 32));
        if ((__builtin_amdgcn_mbcnt_hi(~0u, __builtin_amdgcn_mbcnt_lo(~0u, 0u)) >> 4) == 0u) atomicMax(rmax + row, __builtin_bit_cast(unsigned, mx));
    } };
struct FF32 { float* C; int ldc;
    __device__ __forceinline__ void operator()(int row, int col, const f32x4& v0, const f32x4& v1, int) const { *(f32x4*)(C + (size_t)row * ldc + col) = v0; *(f32x4*)(C + (size_t)row * ldc + col + 4) = v1; } };
struct FBf16 { bf16_t* O; int ldc;
    __device__ __forceinline__ void operator()(int row, int col, const f32x4& v0, const f32x4& v1, int) const { *(u32x4*)(O + (size_t)row * ldc + col) = pack8(v0, v1); } };
struct FBf16I8 { bf16_t* O; const float* rs; const float* cs; int ldc;
    __device__ __forceinline__ void operator()(int row, int col, const f32x4& v0, const f32x4& v1, int) const {
        const float r = rs[row]; const f32x4 c0 = *(const f32x4*)(cs + col) * r, c1 = *(const f32x4*)(cs + col + 4) * r;
        const f32x4 a = i2f4(v0) * c0, b = i2f4(v1) * c1;
        *(u32x4*)(O + (size_t)row * ldc + col) = pack8(a, b);
    } };
struct FRelu2I8 { bf16_t* O; const float* rs; const float* cs; int ldc;
    __device__ __forceinline__ void operator()(int row, int col, const f32x4& v0, const f32x4& v1, int) const {
        const float r = rs[row]; const f32x4 c0 = *(const f32x4*)(cs + col) * r, c1 = *(const f32x4*)(cs + col + 4) * r;
        f32x4 a = i2f4(v0) * c0, b = i2f4(v1) * c1;
#pragma unroll
        for (int j = 0; j < 4; ++j) { a[j] = fmaxf(a[j], 0.f); b[j] = fmaxf(b[j], 0.f); }
        a = a * a; b = b * b;
        *(u32x4*)(O + (size_t)row * ldc + col) = pack8(a, b);
    } };
struct FRelu2 { bf16_t* O; int ldc;
    __device__ __forceinline__ void operator()(int row, int col, const f32x4& v0, const f32x4& v1, int) const {
        f32x4 a, b;
#pragma unroll
        for (int j = 0; j < 4; ++j) { const float x = fmaxf(v0[j], 0.f), y = fmaxf(v1[j], 0.f); a[j] = x * x; b[j] = y * y; }
        *(u32x4*)(O + (size_t)row * ldc + col) = pack8(a, b);
    } };

typedef int i32x4 __attribute__((ext_vector_type(4)));
template <bool I8> __device__ __forceinline__ f32x4 mma16(const bf16x8& b, const bf16x8& a, const f32x4& c) {
    if constexpr (I8) return __builtin_bit_cast(f32x4, __builtin_amdgcn_mfma_i32_16x16x64_i8(__builtin_bit_cast(i32x4, b), __builtin_bit_cast(i32x4, a), __builtin_bit_cast(i32x4, c), 0, 0, 0));
    else return __builtin_amdgcn_mfma_f32_16x16x32_bf16(b, a, c, 0, 0, 0);
}
template <class Epi, class Sched, bool ALIGN_EPI = false, bool SP2 = false, bool I8 = false>
__device__ __forceinline__ void gemm_phase(PG8_LAS unsigned char* lds, const Gemm g, const Sched& S, const Epi& E, const int wave_id) {
    const int lane = (int)__builtin_amdgcn_mbcnt_hi(~0u, __builtin_amdgcn_mbcnt_lo(~0u, 0u)), wid = wave_id, tid = wid * 64 + lane,
              wr = wid >> 2, wc = wid & 3, fr = lane & 15, fq = lane >> 4;
    const int K = g.K, nt = K / BK;
    unsigned voffA[2], voffB[2];
#pragma unroll
    for (int i = 0; i < 2; ++i) { int R, C; stage_rc(tid * 16 + i * 8192, R, C); const int Rb = Epi::PERM ? ((R & ~31) + perm32(R & 31)) : R;
        voffA[i] = (unsigned)(R * g.lda + C) * 2u; voffB[i] = (unsigned)(Rb * g.ldb + C) * 2u; }
    const size_t kstep = (size_t)(BK * 2);
    const size_t hstepA = (size_t)HALF * g.lda * 2, hstepB = (size_t)HALF * g.ldb * 2;
    const size_t tstepA = 2 * hstepA, tstepB = 2 * hstepB;
    const unsigned ldsw = (unsigned)wid * 1024u;
    const int aoff = lds_byte(wr * 64 + fr, fq * 8), boff = lds_byte(wc * 32 + fr, fq * 8);
#define PG8_SA(b, h) (((b) * 2 + (h)) * HTB)
#define PG8_SB(b, h) ((4 + (b) * 2 + (h)) * HTB)
#define PG8_STAGE(bufoff, gbase, voff) do { _Pragma("unroll") for (int _i = 0; _i < 2; ++_i) \
        __builtin_amdgcn_global_load_lds((const unsigned*)((const char*)(gbase) + (voff)[_i]), (PG8_LAS unsigned*)(lds + (bufoff) + ldsw + _i * 8192), 16, 0, 0); } while (0)
#define PG8_LDA(dst, b, h) do { _Pragma("unroll") for (int m = 0; m < 4; ++m) _Pragma("unroll") for (int k = 0; k < 2; ++k) dst[m][k] = *(const PG8_LAS bf16x8*)(lds + PG8_SA(b, h) + aoff + m * 2048 + k * 1024); } while (0)
#define PG8_LDB(dst, b, h) do { _Pragma("unroll") for (int n = 0; n < 2; ++n) _Pragma("unroll") for (int k = 0; k < 2; ++k) dst[n][k] = *(const PG8_LAS bf16x8*)(lds + PG8_SB(b, h) + boff + n * 2048 + k * 1024); } while (0)
#define PG8_MMA(ai, bj, At, Bt) do { __builtin_amdgcn_s_setprio(1); _Pragma("unroll") for (int m = 0; m < 4; ++m) _Pragma("unroll") for (int n = 0; n < 2; ++n) _Pragma("unroll") for (int k = 0; k < 2; ++k) \
        acc[ai][bj][m][n] = mma16<I8>(Bt[n][k], At[m][k], acc[ai][bj][m][n]); __builtin_amdgcn_s_setprio(0); } while (0)
#define PG8_WAIT_V(n) asm volatile("s_waitcnt vmcnt(" #n ")" ::: "memory")
#define PG8_WAIT_L(n) asm volatile("s_waitcnt lgkmcnt(" #n ")" ::: "memory")
#define PG8_BAR __builtin_amdgcn_s_barrier()
#define PG8_SCHED __builtin_amdgcn_sched_barrier(0)
    Unit cur, nxt; int ui = 0;
    if (!S.next(0, cur)) return;
    f32x4 acc[2][2][4][2];
#pragma unroll
    for (int a = 0; a < 2; ++a)
#pragma unroll
        for (int b = 0; b < 2; ++b)
#pragma unroll
            for (int m = 0; m < 4; ++m)
#pragma unroll
                for (int n = 0; n < 2; ++n) acc[a][b][m][n] = (f32x4){0.f, 0.f, 0.f, 0.f};
    bf16x8 At[4][2], B0[2][2], B1[2][2];
    const char* cA = (const char*)g.A + (size_t)cur.pm * tstepA; const char* cB = (const char*)g.Bt + (size_t)cur.pn * tstepB;
    S.a_ready(cur);
    if constexpr (SP2) {
        PG8_STAGE(PG8_SB(0, 0), cB, voffB); PG8_STAGE(PG8_SB(0, 1), cB + hstepB, voffB); PG8_STAGE(PG8_SA(0, 0), cA, voffA); PG8_STAGE(PG8_SA(0, 1), cA + hstepA, voffA);
        if (wr == 1) PG8_BAR;
        PG8_WAIT_V(2); PG8_BAR;
        PG8_STAGE(PG8_SB(1, 0), cB + kstep, voffB); PG8_STAGE(PG8_SA(1, 0), cA + kstep, voffA); PG8_STAGE(PG8_SB(1, 1), cB + hstepB + kstep, voffB);
        PG8_WAIT_V(6); PG8_BAR;
    } else {
        PG8_STAGE(PG8_SB(0, 0), cB, voffB); PG8_STAGE(PG8_SA(0, 0), cA, voffA); PG8_STAGE(PG8_SB(0, 1), cB + hstepB, voffB); PG8_STAGE(PG8_SA(0, 1), cA + hstepA, voffA);
        if (wr == 1) PG8_BAR;
        PG8_WAIT_V(4); PG8_BAR;
        PG8_STAGE(PG8_SB(1, 0), cB + kstep, voffB); PG8_STAGE(PG8_SA(1, 0), cA + kstep, voffA); PG8_STAGE(PG8_SB(1, 1), cB + hstepB + kstep, voffB);
        PG8_WAIT_V(6); PG8_BAR;
    }
    for (;;) {
        const bool has_next = S.next(ui + 1, nxt);
        const char* nA = has_next ? (const char*)g.A + (size_t)nxt.pm * tstepA : cA; const char* nB = has_next ? (const char*)g.Bt + (size_t)nxt.pn * tstepB : cB;
        for (int t = 0; t < nt; t += 2) {
            const bool last = (t == nt - 2);
            const char* a1 = cA + (size_t)(t + 1) * kstep;
            const char* a2 = last ? nA : cA + (size_t)(t + 2) * kstep; const char* b2 = last ? nB : cB + (size_t)(t + 2) * kstep;
            const char* a3 = a2 + kstep; const char* b3 = b2 + kstep;
            if (last && has_next) S.a_ready(nxt);
            if constexpr (SP2) {
            PG8_LDB(B0, 0, 0); PG8_LDB(B1, 0, 1); PG8_SCHED; PG8_LDA(At, 0, 0); PG8_STAGE(PG8_SA(1, 1), a1 + hstepA, voffA);
            PG8_WAIT_V(8); PG8_WAIT_L(0); PG8_BAR; PG8_MMA(0, 0, At, B0); PG8_MMA(0, 1, At, B1); PG8_BAR; PG8_SCHED;
            PG8_LDA(At, 0, 1); PG8_STAGE(PG8_SB(0, 0), b2, voffB); PG8_STAGE(PG8_SB(0, 1), b2 + hstepB, voffB); PG8_STAGE(PG8_SA(0, 0), a2, voffA);
            PG8_WAIT_V(8); PG8_WAIT_L(0); PG8_BAR; PG8_MMA(1, 0, At, B0); PG8_MMA(1, 1, At, B1); PG8_BAR; PG8_SCHED;
            PG8_LDB(B0, 1, 0); PG8_LDB(B1, 1, 1); PG8_SCHED; PG8_LDA(At, 1, 0); PG8_STAGE(PG8_SA(0, 1), a2 + hstepA, voffA);
            PG8_WAIT_V(8); PG8_WAIT_L(0); PG8_BAR; PG8_MMA(0, 0, At, B0); PG8_MMA(0, 1, At, B1); PG8_BAR; PG8_SCHED;
            PG8_LDA(At, 1, 1); PG8_STAGE(PG8_SB(1, 0), b3, voffB); PG8_STAGE(PG8_SB(1, 1), b3 + hstepB, voffB); PG8_STAGE(PG8_SA(1, 0), a3, voffA);
            PG8_WAIT_V(8); PG8_WAIT_L(0); PG8_BAR; PG8_MMA(1, 0, At, B0); PG8_MMA(1, 1, At, B1); PG8_BAR; PG8_SCHED;
            } else {
            PG8_LDB(B0, 0, 0); PG8_SCHED; PG8_LDA(At, 0, 0); PG8_STAGE(PG8_SA(1, 1), a1 + hstepA, voffA);
            PG8_WAIT_L(8); PG8_BAR; PG8_WAIT_L(0); PG8_MMA(0, 0, At, B0); PG8_BAR; PG8_SCHED;
            PG8_LDB(B1, 0, 1); PG8_STAGE(PG8_SB(0, 0), b2, voffB);
            PG8_BAR; PG8_WAIT_L(0); PG8_MMA(0, 1, At, B1); PG8_BAR;
            PG8_LDA(At, 0, 1); PG8_STAGE(PG8_SA(0, 0), a2, voffA);
            PG8_BAR; PG8_WAIT_L(0); PG8_MMA(1, 0, At, B0); PG8_BAR; PG8_SCHED;
            PG8_STAGE(PG8_SB(0, 1), b2 + hstepB, voffB);
            PG8_WAIT_V(6); PG8_BAR; PG8_MMA(1, 1, At, B1); PG8_BAR;
            PG8_LDB(B0, 1, 0); PG8_SCHED; PG8_LDA(At, 1, 0); PG8_STAGE(PG8_SA(0, 1), a2 + hstepA, voffA);
            PG8_WAIT_L(8); PG8_BAR; PG8_WAIT_L(0); PG8_MMA(0, 0, At, B0); PG8_BAR; PG8_SCHED;
            PG8_LDB(B1, 1, 1); PG8_STAGE(PG8_SB(1, 0), b3, voffB);
            PG8_BAR; PG8_WAIT_L(0); PG8_MMA(0, 1, At, B1); PG8_BAR;
            PG8_LDA(At, 1, 1); PG8_STAGE(PG8_SA(1, 0), a3, voffA);
            PG8_BAR; PG8_WAIT_L(0); PG8_MMA(1, 0, At, B0); PG8_BAR; PG8_SCHED;
            PG8_STAGE(PG8_SB(1, 1), b3 + hstepB, voffB);
            PG8_WAIT_V(6); PG8_BAR; PG8_MMA(1, 1, At, B1); PG8_BAR;
            }
        }
        if constexpr (ALIGN_EPI) { if (wr == 0) PG8_BAR; }
        if constexpr (!Epi::AFTER_DRAIN) { E(acc, cur, wr, wc, fr, fq); S.done(cur); }
        if (!has_next) break;
#pragma unroll
        for (int a = 0; a < 2; ++a)
#pragma unroll
            for (int b = 0; b < 2; ++b)
#pragma unroll
                for (int m = 0; m < 4; ++m)
#pragma unroll
                    for (int n = 0; n < 2; ++n) acc[a][b][m][n] = (f32x4){0.f, 0.f, 0.f, 0.f};
        cur = nxt; cA = nA; cB = nB; ++ui;
        if constexpr (ALIGN_EPI) { if (wr == 1) PG8_BAR; }
    }
    PG8_WAIT_V(0);
    if constexpr (!ALIGN_EPI) { if (wr == 0) PG8_BAR; }
    PG8_BAR;
    if constexpr (Epi::AFTER_DRAIN) { E.fused(acc, cur, wr, wc, fr, fq, lds, wid, lane); S.done(cur); }
#undef PG8_SA
#undef PG8_SB
#undef PG8_STAGE
#undef PG8_LDA
#undef PG8_LDB
#undef PG8_MMA
#undef PG8_WAIT_V
#undef PG8_WAIT_L
#undef PG8_BAR
#undef PG8_SCHED
}
}

constexpr int NWAVES = 8;
#ifndef MK_N_LAUNCHES
#define MK_N_LAUNCHES 1
#endif
constexpr int N_PHASES = 12;
constexpr int N_LAUNCHES = MK_N_LAUNCHES;
static_assert(N_LAUNCHES == 1 || N_LAUNCHES == N_PHASES, "MK_N_LAUNCHES is 1 or N_PHASES");

constexpr int DM = 4096, NB = 4, SEQ = 2048, CTXL = 256, ML = NB * SEQ, MC = NB * CTXL, MT = ML + MC;
constexpr int DFF = 16384, NMOD = 6 * DM;
constexpr int PK = DM + 64, PF = DFF + 64;
constexpr int NPW = 26656, NP = 26880;
constexpr int OFF_QM = 0, OFF_KM = 2048, OFF_VM = 4096, OFF_OM = 8192, OFF_QA = 12288, OFF_KA = 16384, OFF_VA = 17408, OFF_BGM = 18432, OFF_BGA = 22528, OFF_GM = 26624;
constexpr int MH = 8, DQK = 256, DV = 512, AH = 32, AKV = 8, AD = 128, WIN = 128;
constexpr float EPS = 1e-6f;

constexpr size_t MiB = 1u << 20;
constexpr size_t WS_CTL = 0, CTL_ZERO_BYTES = 1 * MiB;
constexpr size_t WS_MOD = 1 * MiB, WS_ROT = WS_MOD + 512 * 1024, WS_RS1 = WS_ROT + 64 * 1024;
constexpr size_t WS_WIN = 2 * MiB, WS_WOM = 216 * MiB, WS_WOA = 249 * MiB, WS_WO = 282 * MiB, WS_WF1 = 315 * MiB, WS_WF2 = 445 * MiB;
constexpr size_t WS_U = 574 * MiB;
constexpr size_t WS_P = 648 * MiB;
constexpr size_t WS_G = 1121 * MiB;
constexpr size_t WS_HM = 1123 * MiB, WS_AT = 1188 * MiB;
constexpr size_t WS_MIX = 1253 * MiB, WS_HB = 1381 * MiB;
constexpr int P8 = DM + 128;
constexpr int N8P = 24576;
constexpr size_t WS_U8 = 1445 * MiB, WS_W8G = 1483 * MiB, WS_W8F = 1582 * MiB, WS_U28 = WS_AT, WS_END = 1648 * MiB;
constexpr size_t WS_RSU = WS_ROT + 128 * 1024, WS_RS2 = WS_ROT + 192 * 1024, WS_CSG = WS_ROT + 224 * 1024, WS_CSF = WS_ROT + 320 * 1024;
constexpr size_t WS_HM8 = 130 * MiB, WS_AT8 = WS_U8;
constexpr size_t WS_W8OM = WS_HM, WS_W8OA = WS_HM + 17 * MiB, WS_END2 = WS_END;
constexpr size_t WS_RSHM = WS_ROT + 384 * 1024, WS_RSAT = WS_ROT + 416 * 1024, WS_CSOM = WS_ROT + 448 * 1024, WS_CSOA = WS_ROT + 464 * 1024, WS_CMAXO = 768 * 1024;
static_assert(WS_W8OM + (size_t)DM * P8 <= WS_W8OA && WS_W8OA + (size_t)DM * P8 <= WS_AT && WS_CSF + DFF * 4 <= WS_RSHM && WS_CSOA + DM * 4 <= WS_WIN && WS_CMAXO + 2 * DM * 4 <= CTL_ZERO_BYTES, "ws map int8 out");
constexpr size_t WS_W8O = WS_HM + 34 * MiB, WS_YG8 = WS_U8;
constexpr size_t WS_CSO = WS_ROT + 480 * 1024, WS_RSY = WS_MOD + 480 * 1024, WS_RMAXY = 832 * 1024;
static_assert(WS_W8O + (size_t)DM * P8 <= WS_AT && WS_CSO + DM * 4 <= WS_WIN && WS_RSY + ML * 4 <= WS_ROT && WS_RMAXY + ML * 4 <= CTL_ZERO_BYTES, "ws map int8 wo");
constexpr size_t WS_CMAXG = 256 * 1024, WS_CMAXF = 512 * 1024;
static_assert(WS_U8 + (size_t)MT * P8 <= WS_W8G && WS_W8G + (size_t)N8P * P8 <= WS_W8F && WS_CSG + N8P * 4 <= WS_CSF && WS_RS2 + ML * 4 <= WS_CSG && WS_RSU + MT * 4 <= WS_RS2 && WS_W8F + (size_t)DFF * P8 <= WS_END && WS_U28 + (size_t)ML * P8 <= WS_MIX && WS_CSF + DFF * 4 <= WS_WIN, "ws map int8");
constexpr size_t WS_HF = 2 * MiB, WS_T = 2 * MiB, WS_U2 = 130 * MiB;
constexpr size_t WS_YG = WS_U, WS_HDN = WS_P, WS_F = WS_MIX + 64 * MiB;
static_assert(WS_WIN + (size_t)NP * PK * 2 <= WS_WOM && WS_WOM + (size_t)DM * PK * 2 <= WS_WOA && WS_WOA + (size_t)DM * PK * 2 <= WS_WO && WS_WO + (size_t)DM * PK * 2 <= WS_WF1 && WS_WF1 + (size_t)DFF * PK * 2 <= WS_WF2 && WS_WF2 + (size_t)DM * PF * 2 <= WS_U, "ws map: weights");
static_assert(WS_U + (size_t)MT * PK * 2 <= WS_P && WS_P + (size_t)MT * NP * 2 <= WS_G && WS_G + (size_t)MT * 32 * 4 <= WS_HM && WS_HM + (size_t)ML * PK * 2 <= WS_AT && WS_AT + (size_t)ML * PK * 2 <= WS_MIX && WS_F + (size_t)ML * DM * 2 <= WS_HB && WS_HB + (size_t)ML * DM * 2 <= WS_END, "ws map");
static_assert(WS_T + (size_t)ML * DM * 4 <= WS_U2 && WS_U2 + (size_t)ML * PK * 2 <= WS_WOM && WS_HDN + (size_t)ML * PF * 2 <= WS_G && WS_YG + (size_t)ML * PK * 2 <= WS_P, "ws map overlays");
constexpr int CW_BAR = 4096;

constexpr int RING_OFF = 0, RING_BYTES = 131072;
constexpr int LDSCTL_OFF = RING_BYTES, MISC_OFF = LDSCTL_OFF + 320;
constexpr int LDS_BYTES = 147456;
static_assert(MISC_OFF + 128 <= LDS_BYTES, "LDS map");
#define GAS __attribute__((address_space(1)))
#define LAS __attribute__((address_space(3)))
typedef unsigned short bf16;
typedef unsigned v4u __attribute__((ext_vector_type(4)));
typedef float f32x4 __attribute__((ext_vector_type(4)));
typedef short bf16x8 __attribute__((ext_vector_type(8)));
typedef GAS unsigned gu32;
typedef GAS unsigned long long gu64;
#define RLX_AGENT __ATOMIC_RELAXED, __HIP_MEMORY_SCOPE_AGENT
#define LDS_WAIT() asm volatile("s_waitcnt lgkmcnt(0)" ::: "memory")
#define VM_WAIT() asm volatile("s_waitcnt vmcnt(0)" ::: "memory")
__device__ __forceinline__ unsigned long long rt() { return __builtin_amdgcn_s_memrealtime(); }
__device__ __forceinline__ unsigned f2bf(float f) { unsigned u = __builtin_bit_cast(unsigned, f); return (u + 0x7fffu + ((u >> 16) & 1u)) >> 16; }
typedef __bf16 pk2_bf2 __attribute__((ext_vector_type(2)));
typedef float pk2_f2 __attribute__((ext_vector_type(2)));
__device__ __forceinline__ unsigned pk2(float lo, float hi) { pk2_f2 v = {lo, hi}; return __builtin_bit_cast(unsigned, __builtin_convertvector(v, pk2_bf2)); }

#define XB_TMO      128
#define XB_XCNT(j)  (256  + 64 * (j))
#define XB_XSUB(j)  (1280 + 64 * (j))
#define XB_XGEN(j)  (2304 + 64 * (j))
#define XB_TOP      3328
#define XB_TOPGEN   3392
#define XCD_BAR_WORDS 3456
#define XB_SPIN_CAP (1u << 18)

__device__ __forceinline__ unsigned xb_ld(unsigned* p)              { return __hip_atomic_load(p, __ATOMIC_RELAXED, __HIP_MEMORY_SCOPE_AGENT); }
__device__ __forceinline__ unsigned xb_add(unsigned* p, unsigned v) { return __hip_atomic_fetch_add(p, v, __ATOMIC_RELAXED, __HIP_MEMORY_SCOPE_AGENT); }
__device__ __forceinline__ unsigned xb_xcc_id() { return (unsigned)__builtin_amdgcn_s_getreg((3 << 11) | 20) & 0xFu; }
#define XB_SPIN(cond, bar) do { unsigned _sp = 0; while (cond) { __builtin_amdgcn_s_sleep(1); \
    if ((++_sp & 255u) == 0u) { if (xb_ld(&(bar)[XB_TMO])) break; if (_sp > XB_SPIN_CAP) { atomicAdd(&(bar)[XB_TMO], 1u); break; } } } } while (0)

struct XcdBarrier {
    int wave;
    unsigned* bar; unsigned x;
    volatile LAS unsigned* st;
};

__device__ __forceinline__ bool xb_leader(int wave) { return wave == 0 && __builtin_amdgcn_mbcnt_hi(~0u, __builtin_amdgcn_mbcnt_lo(~0u, 0u)) == 0u; }
__device__ __forceinline__ XcdBarrier xcd_barrier_post(unsigned* bar, volatile LAS unsigned* st, int wave) {
    XcdBarrier b; b.wave = wave; b.bar = bar; b.x = xb_xcc_id(); b.st = st;
    if (xb_leader(wave)) (void)xb_add(&bar[XB_XCNT(b.x)], 1u);
    return b;
}
__device__ __forceinline__ void xcd_barrier_complete(unsigned* bar, unsigned x, unsigned& nloc, unsigned& nx) {
    const unsigned G = gridDim.x * gridDim.y * gridDim.z;
    unsigned sum, cnt, mine, sp = 0u;
    for (;;) {
        sum = 0u; cnt = 0u; mine = 0u;
#pragma unroll
        for (unsigned j = 0; j < 16; ++j) { const unsigned c = xb_ld(&bar[XB_XCNT(j)]); sum += c; cnt += (c > 0u) ? 1u : 0u; mine = (j == x) ? c : mine; }
        if (sum == G) break;
        __builtin_amdgcn_s_sleep(1);
        if ((++sp & 255u) == 0u) { if (xb_ld(&bar[XB_TMO])) break; if (sp > XB_SPIN_CAP) { atomicAdd(&bar[XB_TMO], 1u); break; } }
    }
    nloc = mine > 0u ? mine : 1u; nx = cnt > 0u ? cnt : 1u;
}

__device__ __forceinline__ void xcd_barrier(const XcdBarrier& b) {
    asm volatile("s_waitcnt vmcnt(0)" ::: "memory");
    __syncthreads();
    if (xb_leader(b.wave)) {
        unsigned* bar = b.bar;
        __builtin_amdgcn_s_waitcnt(0);
        unsigned nloc = b.st[0], nx = b.st[1];
        if (nloc == 0u) { xcd_barrier_complete(bar, b.x, nloc, nx); b.st[0] = nloc; b.st[1] = nx; }
        const unsigned old = xb_add(&bar[XB_XSUB(b.x)], 1u);
        const unsigned gen = old / nloc;
        if (old + 1u == (gen + 1u) * nloc) {
            __builtin_amdgcn_fence(__ATOMIC_RELEASE, "agent");
            asm volatile("s_waitcnt vmcnt(0)" ::: "memory");
            const unsigned og = xb_add(&bar[XB_TOP], 1u);
            const unsigned tg = og / nx;
            if (og + 1u == (tg + 1u) * nx) xb_add(&bar[XB_TOPGEN], 1u);
            else XB_SPIN(xb_ld(&bar[XB_TOPGEN]) == tg, bar);
            __builtin_amdgcn_fence(__ATOMIC_ACQUIRE, "agent");
            xb_add(&bar[XB_XGEN(b.x)], 1u);
            asm volatile("s_waitcnt vmcnt(0)" ::: "memory");
        } else {
            XB_SPIN(xb_ld(&bar[XB_XGEN(b.x)]) == gen, bar);
            __builtin_amdgcn_fence(__ATOMIC_ACQUIRE, "agent");
            asm volatile("s_waitcnt vmcnt(0)" ::: "memory");
        }
    }
    __syncthreads();
}

template <int CTRL> __device__ __forceinline__ float dppx(float v) { return __builtin_bit_cast(float, __builtin_amdgcn_update_dpp(0, __builtin_bit_cast(int, v), CTRL, 0xf, 0xf, true)); }
#define XSWAP(name, insn, comb) __device__ __forceinline__ float name(float x) { float a = x, b = x; asm("s_nop 1\n\t" insn " %0, %1" : "+v"(a), "+v"(b)); return comb; }
XSWAP(xsum16, "v_permlane16_swap_b32", a + b)
XSWAP(xsum32, "v_permlane32_swap_b32", a + b)
XSWAP(xmax16, "v_permlane16_swap_b32", fmaxf(a, b))
XSWAP(xmax32, "v_permlane32_swap_b32", fmaxf(a, b))
#undef XSWAP
__device__ __forceinline__ void rowbcast4(float x, float (&r)[4]) {
    float a = x, b = x; asm("s_nop 1\n\tv_permlane16_swap_b32 %0, %1" : "+v"(a), "+v"(b));
    float a0 = a, a2 = a; asm("s_nop 1\n\tv_permlane32_swap_b32 %0, %1" : "+v"(a0), "+v"(a2));
    float b1 = b, b3 = b; asm("s_nop 1\n\tv_permlane32_swap_b32 %0, %1" : "+v"(b1), "+v"(b3));
    r[0] = a0; r[1] = b1; r[2] = a2; r[3] = b3;
}
__device__ __forceinline__ float wave_sum(float v) {
    v += dppx<0xB1>(v); v += dppx<0x4E>(v); v += dppx<0x141>(v); v += dppx<0x140>(v);
    return xsum32(xsum16(v));
}
__device__ __forceinline__ float wave_max(float v) {
    v = fmaxf(v, dppx<0xB1>(v)); v = fmaxf(v, dppx<0x4E>(v)); v = fmaxf(v, dppx<0x141>(v)); v = fmaxf(v, dppx<0x140>(v));
    return xmax32(xmax16(v));
}
__device__ __forceinline__ float bf2f(bf16 b) { return __builtin_bit_cast(float, (unsigned)b << 16); }
__device__ __forceinline__ float bflo(unsigned w) { return __builtin_bit_cast(float, w << 16); }
typedef __bf16 bf16x2_d __attribute__((ext_vector_type(2)));
__device__ __forceinline__ float dot2bf(unsigned a, unsigned b, float c) { return __builtin_amdgcn_fdot2_f32_bf16(__builtin_bit_cast(bf16x2_d, a), __builtin_bit_cast(bf16x2_d, b), c, false); }
__device__ __forceinline__ float bfhi(unsigned w) { return __builtin_bit_cast(float, w & 0xffff0000u); }
__device__ __forceinline__ float sigm(float x) { return __builtin_amdgcn_rcpf(1.0f + __expf(-x)); }
__device__ __forceinline__ float logsig(float x) { return x < 0.f ? x - log1pf(expf(x)) : -log1pf(expf(-x)); }
__device__ __forceinline__ float logsig_fast(float x) { const float e = __expf(-fabsf(x)); return fminf(x, 0.f) - __logf(1.0f + e); }

#define BAR_LDS() do { asm volatile("s_waitcnt lgkmcnt(0)" ::: "memory"); __builtin_amdgcn_s_barrier(); asm volatile("" ::: "memory"); } while (0)
struct Args { const float* in[16]; float* out; unsigned char* ws; int ph_lo, ph_hi; };

__device__ __forceinline__ int win_map(int n0) { return n0 < 12288 ? n0 : (n0 < 12320 ? OFF_GM + (n0 - 12288) : n0 - 32); }


namespace ml {
typedef short s16x4 __attribute__((ext_vector_type(4)));
typedef short v4i16_t __attribute__((ext_vector_type(4)));
typedef unsigned v2u __attribute__((ext_vector_type(2)));
constexpr int QS = 528, KS = 544, VS = 288, S_PITCH = 144;
constexpr int Q_OFF = 0, K_OFF = Q_OFF + 64 * QS, V_OFF = K_OFF + 64 * KS, S_OFF = V_OFF + 64 * VS, NB_OFF = S_OFF + 64 * S_PITCH, NQ_OFF = NB_OFF + 1024, RS_OFF = NQ_OFF + 2048, WE_OFF = RS_OFF + 512, GG_OFF = WE_OFF + 256, MV_OFF = GG_OFF + 256, FAB_OFF = MV_OFF + 256;
static_assert(FAB_OFF + 8 * 512 <= 131072, "mLSTM LDS map");
__device__ __forceinline__ unsigned off_b(unsigned row, unsigned ch) { return 256u * row + 16u * (ch ^ (((row & 3u) << 2) | ((row >> 2) & 3u))); }
__device__ __forceinline__ unsigned rr16(unsigned lane, unsigned rb, unsigned s) { return off_b((lane & 15u) + 16u * rb, 4u * s + (lane >> 4)); }
__device__ __forceinline__ unsigned tr16(unsigned lane, unsigned c, unsigned ks, unsigned t) { const unsigned g = lane >> 4, q = (lane & 15u) >> 2, p = lane & 3u; return off_b(32u * ks + 8u * g + 4u * t + q, 2u * c + (p >> 1)) + 8u * (p & 1u); }
__device__ __forceinline__ s16x4 trd(LAS unsigned char* p) { return __builtin_bit_cast(s16x4, __builtin_amdgcn_ds_read_tr16_b64_v4i16((LAS v4i16_t*)p)); }
__device__ __forceinline__ bf16x8 cat8(s16x4 lo, s16x4 hi) { return __builtin_shufflevector(lo, hi, 0, 1, 2, 3, 4, 5, 6, 7); }
__device__ __forceinline__ unsigned cvtpk(float lo, float hi) { unsigned r; asm volatile("v_cvt_pk_bf16_f32 %0, %1, %2" : "=v"(r) : "v"(lo), "v"(hi)); return r; }
template <int CTRL, int ROWMASK> __device__ __forceinline__ float dppf(float old, float src) { return __builtin_bit_cast(float, __builtin_amdgcn_update_dpp(__builtin_bit_cast(int, old), __builtin_bit_cast(int, src), CTRL, ROWMASK, 0xf, false)); }
__device__ __forceinline__ float scan_add(float v) { v += dppf<0x111, 0xf>(0.f, v); v += dppf<0x112, 0xf>(0.f, v); v += dppf<0x114, 0xf>(0.f, v); v += dppf<0x118, 0xf>(0.f, v); v += dppf<0x142, 0xa>(0.f, v); v += dppf<0x143, 0xc>(0.f, v); return v; }
__device__ __forceinline__ float scan_max(float v) { const float ni = -INFINITY; v = fmaxf(v, dppf<0x111, 0xf>(ni, v)); v = fmaxf(v, dppf<0x112, 0xf>(ni, v)); v = fmaxf(v, dppf<0x114, 0xf>(ni, v)); v = fmaxf(v, dppf<0x118, 0xf>(ni, v)); v = fmaxf(v, dppf<0x142, 0xa>(ni, v)); v = fmaxf(v, dppf<0x143, 0xc>(ni, v)); return v; }
__device__ __forceinline__ int scan_row(int b, int dir, int st) { return st < CTXL ? ML + b * CTXL + (dir ? CTXL - 1 - st : st) : b * SEQ + (dir ? SEQ - 1 - (st - CTXL) : st - CTXL); }

__device__ __forceinline__ void mlstm_item(const Args& A, LAS unsigned char* lds, int tid_in, int lane_in, int wave, int item) {
    int tid = tid_in, lane = lane_in;
    const int vs = item & 3, dir = (item >> 2) & 1, h = (item >> 3) & 7, b = item >> 6;
    const bf16* P = (const bf16*)(A.ws + WS_P); const float* Gt = (const float*)(A.ws + WS_G);
    bf16* Hb = (bf16*)(A.ws + (dir ? WS_HB : WS_HF));
    const float bi = A.in[8][(2 * dir) * 8 + h], bfg = A.in[8][(2 * dir + 1) * 8 + h];
    LAS float* NBUF = (LAS float*)(lds + NB_OFF); LAS float* NQ = (LAS float*)(lds + NQ_OFF); LAS float* RS = (LAS float*)(lds + RS_OFF); LAS float* WE = (LAS float*)(lds + WE_OFF); LAS float* GGT = (LAS float*)(lds + GG_OFF); LAS float* MVT = (LAS float*)(lds + MV_OFF); LAS float* FAB = (LAS float*)(lds + FAB_OFF + wave * 512);
    { int t0 = tid_in; asm volatile("" : "+v"(t0)); if (t0 < 256) NBUF[t0] = 0.f; }
    asm volatile("" ::: "memory");
    f32x4 X[16];
#pragma unroll
    for (int i = 0; i < 16; ++i) X[i] = (f32x4){0.f, 0.f, 0.f, 0.f};
    float m = 0.f;
    const f32x4 z4 = (f32x4){0.f, 0.f, 0.f, 0.f};
    v4u pq[4], pk[4], pv[2]; float pgi, pgf;
    const int sgn = dir ? -1 : 1;
    const int goff_qk = sgn * (tid_in >> 5) * NP + h * DQK + (tid_in & 31) * 8, goff_v = sgn * (tid_in >> 4) * NP + OFF_VM + h * DV + vs * 128 + (tid_in & 15) * 8, goff_g = sgn * lane_in * 32 + (2 * dir) * 8 + h;
    const unsigned lds_q = (unsigned)(QS * (tid_in >> 5) + 16 * (tid_in & 31)), lds_k = (unsigned)(KS * (tid_in >> 5) + 64 * ((tid_in & 31) >> 2) + 8 * (tid_in & 3)), lds_v = (unsigned)(VS * (tid_in >> 4) + 16 * (tid_in & 15));
    const int hoff = sgn * (lane_in & 15) * DM + h * DV + vs * 128 + 16 * wave + 4 * (lane_in >> 4);
#define ML_LOAD(cc) do { const int row0_ = scan_row(b, dir, 64 * (cc)); const bf16* pb_ = P + (size_t)row0_ * NP; \
        _Pragma("unroll") for (int i = 0; i < 4; ++i) { pq[i] = *(const v4u*)(pb_ + (goff_qk + OFF_QM + sgn * 16 * i * NP)); pk[i] = *(const v4u*)(pb_ + (goff_qk + OFF_KM + sgn * 16 * i * NP)); } \
        _Pragma("unroll") for (int i = 0; i < 2; ++i) pv[i] = *(const v4u*)(pb_ + (goff_v + sgn * 32 * i * NP)); \
        { const float* gb_ = Gt + (size_t)row0_ * 32; pgi = gb_[goff_g]; pgf = gb_[goff_g + 8]; } } while (0)
#define ML_STORE() do { _Pragma("unroll") for (int i = 0; i < 4; ++i) { *(LAS v4u*)(lds + Q_OFF + lds_q + 16 * QS * i) = pq[i]; { v2u k0_, k1_; k0_.x = pk[i].x; k0_.y = pk[i].y; k1_.x = pk[i].z; k1_.y = pk[i].w; *(LAS v2u*)(lds + K_OFF + lds_k + 16 * KS * i) = k0_; *(LAS v2u*)(lds + K_OFF + lds_k + 16 * KS * i + 32) = k1_; } } \
        _Pragma("unroll") for (int i = 0; i < 2; ++i) *(LAS v4u*)(lds + V_OFF + lds_v + 32 * VS * i) = pv[i]; } while (0)
    ML_LOAD(0); ML_STORE();
#pragma unroll 1
    for (int c = 0; c < (CTXL + SEQ) / 64; ++c) {
        const bool latent = c >= CTXL / 64;
        { int lo_ = lane_in, to_ = tid_in; asm volatile("" : "+v"(lo_), "+v"(to_)); lane = lo_; tid = to_; }
        const unsigned q4 = (unsigned)lane >> 4, l15 = (unsigned)lane & 15u;
        const unsigned sperm = 16u * (q4 >> 1) + 4u * (q4 & 1u) + (l15 >> 2);
        LAS unsigned char* qacc = lds + Q_OFF + QS * l15 + 16u * q4;
        LAS unsigned char* qrow = lds + Q_OFF + QS * l15 + 32u * (q4 & 1u) + 8u * (q4 >> 1);
        LAS unsigned char* krow = lds + K_OFF + KS * l15 + 16u * q4;
        LAS unsigned char* ktr = lds + K_OFF + KS * sperm + 8u * (lane & 3);
        LAS unsigned char* vtr = lds + V_OFF + VS * sperm + 8u * (lane & 3) + 32u * wave;
        LAS unsigned char* srd = lds + S_OFF + S_PITCH * l15 + 32u * (q4 >> 1) + 16u * (q4 & 1u);
        const int wperm = 16 * (int)(q4 >> 1) + 4 * (int)(q4 & 1u);
        float bcs, gg, Mv;
        { const float ig = pgi + bi, lf = logsig_fast(pgf + bfg);
          bcs = scan_add(lf); gg = ig - bcs; Mv = fmaxf(m, scan_max(gg)); }
        const float bL = __builtin_bit_cast(float, __builtin_amdgcn_readlane(__builtin_bit_cast(int, bcs), 63)), M63 = __builtin_bit_cast(float, __builtin_amdgcn_readlane(__builtin_bit_cast(int, Mv), 63));
        const float decay = __expf(m - M63);
        if (wave == 0) { WE[lane] = __expf(gg - M63); GGT[lane] = gg * 1.4426950408889634f; MVT[lane] = Mv * 1.4426950408889634f; }
        BAR_LDS();
        if (c + 1 < (CTXL + SEQ) / 64) ML_LOAD(c + 1);
        f32x4 accI[4];
        if (latent) {
            bf16x8 nfrag; f32x4 accN[4];
            { const f32x4 n0 = *(const LAS f32x4*)(NBUF + 32 * wave + 4 * (int)q4), n1 = *(const LAS f32x4*)(NBUF + 32 * wave + 16 + 4 * (int)q4);
              v4u nb; nb.x = cvtpk(n0[0], n0[1]); nb.y = cvtpk(n0[2], n0[3]); nb.z = cvtpk(n1[0], n1[1]); nb.w = cvtpk(n1[2], n1[3]);
              nfrag = __builtin_bit_cast(bf16x8, nb); }
            const int tb = wave >> 1, sb0 = 2 * (wave & 1);
            f32x4 st0, st1;
            const int tl = 16 * tb + (int)l15; const float Mt = MVT[tl];
            const f32x4 gs0 = *(const LAS f32x4*)(GGT + 16 * sb0 + 4 * (int)q4), gs1 = *(const LAS f32x4*)(GGT + 16 * sb0 + 16 + 4 * (int)q4);
            st0 = z4; st1 = z4;
            if (sb0 + 1 <= tb) {
#pragma unroll
                for (int ks = 0; ks < 8; ++ks) {
                    const bf16x8 qb = cat8(*(const LAS s16x4*)(qrow + 16 * QS * tb + 64 * ks), *(const LAS s16x4*)(qrow + 16 * QS * tb + 64 * ks + 16));
                    const bf16x8 k0 = *(const LAS bf16x8*)(krow + 16 * KS * sb0 + 64 * ks), k1 = *(const LAS bf16x8*)(krow + 16 * KS * (sb0 + 1) + 64 * ks);
                    st0 = __builtin_amdgcn_mfma_f32_16x16x32_bf16(k0, qb, st0, 0, 0, 0); st1 = __builtin_amdgcn_mfma_f32_16x16x32_bf16(k1, qb, st1, 0, 0, 0); }
            } else if (sb0 <= tb) {
#pragma unroll
                for (int ks = 0; ks < 8; ++ks) {
                    const bf16x8 qb = cat8(*(const LAS s16x4*)(qrow + 16 * QS * tb + 64 * ks), *(const LAS s16x4*)(qrow + 16 * QS * tb + 64 * ks + 16));
                    const bf16x8 k0 = *(const LAS bf16x8*)(krow + 16 * KS * sb0 + 64 * ks);
                    st0 = __builtin_amdgcn_mfma_f32_16x16x32_bf16(k0, qb, st0, 0, 0, 0); }
            }
            float rs = 0.f;
#pragma unroll
            for (int r = 0; r < 4; ++r) { const int s0 = 16 * sb0 + 4 * (int)q4 + r, s1 = s0 + 16;
                st0[r] = s0 <= tl ? st0[r] * __builtin_amdgcn_exp2f(gs0[r] - Mt) : 0.f; st1[r] = s1 <= tl ? st1[r] * __builtin_amdgcn_exp2f(gs1[r] - Mt) : 0.f; rs += st0[r] + st1[r]; }
            rs = xsum32(xsum16(rs));
            if (q4 == 0) RS[(wave & 1) * 64 + tl] = rs;
            { v2u w0, w1; w0.x = cvtpk(st0[0], st0[1]); w0.y = cvtpk(st0[2], st0[3]); w1.x = cvtpk(st1[0], st1[1]); w1.y = cvtpk(st1[2], st1[3]);
              const int pq_ = (int)(((q4 & 1u) << 1) | (q4 >> 1));
              *(LAS v2u*)(lds + S_OFF + tl * S_PITCH + 32 * sb0 + 8 * pq_) = w0; *(LAS v2u*)(lds + S_OFF + tl * S_PITCH + 32 * sb0 + 32 + 8 * pq_) = w1; }
            { const unsigned qb0 = (unsigned)(size_t)qacc, qb1 = qb0 + 16 * QS, qb2 = qb0 + 32 * QS, qb3 = qb0 + 48 * QS;
              bf16x8 fa0, fa1, fa2, fa3, fb0, fb1, fb2, fb3;
#define ML_RD4(f0, f1, f2, f3, kp) do { asm volatile("ds_read_b128 %0, %4 offset:%8\n\tds_read_b128 %1, %5 offset:%8\n\tds_read_b128 %2, %6 offset:%8\n\tds_read_b128 %3, %7 offset:%8" \
                  : "=&v"(f0), "=&v"(f1), "=&v"(f2), "=&v"(f3) : "v"(qb0), "v"(qb1), "v"(qb2), "v"(qb3), "n"(64 * (kp)) : "memory"); } while (0)
#define ML_WT4(f0, f1, f2, f3, n) asm volatile("s_waitcnt lgkmcnt(" #n ")" : "+v"(f0), "+v"(f1), "+v"(f2), "+v"(f3))
#define ML_MM4(f0, f1, f2, f3, kp) do { v4u xb; xb.x = cvtpk(X[2 * (kp)][0], X[2 * (kp)][1]); xb.y = cvtpk(X[2 * (kp)][2], X[2 * (kp)][3]); xb.z = cvtpk(X[2 * (kp) + 1][0], X[2 * (kp) + 1][1]); xb.w = cvtpk(X[2 * (kp) + 1][2], X[2 * (kp) + 1][3]); \
                  const bf16x8 xf = __builtin_bit_cast(bf16x8, xb); \
                  accI[0] = __builtin_amdgcn_mfma_f32_16x16x32_bf16(xf, f0, (kp) ? accI[0] : z4, 0, 0, 0); accI[1] = __builtin_amdgcn_mfma_f32_16x16x32_bf16(xf, f1, (kp) ? accI[1] : z4, 0, 0, 0); \
                  accI[2] = __builtin_amdgcn_mfma_f32_16x16x32_bf16(xf, f2, (kp) ? accI[2] : z4, 0, 0, 0); accI[3] = __builtin_amdgcn_mfma_f32_16x16x32_bf16(xf, f3, (kp) ? accI[3] : z4, 0, 0, 0); \
                  if (wave == (kp)) { accN[0] = __builtin_amdgcn_mfma_f32_16x16x32_bf16(nfrag, f0, z4, 0, 0, 0); accN[1] = __builtin_amdgcn_mfma_f32_16x16x32_bf16(nfrag, f1, z4, 0, 0, 0); \
                      accN[2] = __builtin_amdgcn_mfma_f32_16x16x32_bf16(nfrag, f2, z4, 0, 0, 0); accN[3] = __builtin_amdgcn_mfma_f32_16x16x32_bf16(nfrag, f3, z4, 0, 0, 0); } } while (0)
              asm volatile("s_waitcnt lgkmcnt(0)" ::: "memory");
              ML_RD4(fa0, fa1, fa2, fa3, 0);
              ML_RD4(fb0, fb1, fb2, fb3, 1); ML_WT4(fa0, fa1, fa2, fa3, 4); ML_MM4(fa0, fa1, fa2, fa3, 0);
              ML_RD4(fa0, fa1, fa2, fa3, 2); ML_WT4(fb0, fb1, fb2, fb3, 4); ML_MM4(fb0, fb1, fb2, fb3, 1);
              ML_RD4(fb0, fb1, fb2, fb3, 3); ML_WT4(fa0, fa1, fa2, fa3, 4); ML_MM4(fa0, fa1, fa2, fa3, 2);
              ML_RD4(fa0, fa1, fa2, fa3, 4); ML_WT4(fb0, fb1, fb2, fb3, 4); ML_MM4(fb0, fb1, fb2, fb3, 3);
              ML_RD4(fb0, fb1, fb2, fb3, 5); ML_WT4(fa0, fa1, fa2, fa3, 4); ML_MM4(fa0, fa1, fa2, fa3, 4);
              ML_RD4(fa0, fa1, fa2, fa3, 6); ML_WT4(fb0, fb1, fb2, fb3, 4); ML_MM4(fb0, fb1, fb2, fb3, 5);
              ML_RD4(fb0, fb1, fb2, fb3, 7); ML_WT4(fa0, fa1, fa2, fa3, 4); ML_MM4(fa0, fa1, fa2, fa3, 6);
              ML_WT4(fb0, fb1, fb2, fb3, 0); ML_MM4(fb0, fb1, fb2, fb3, 7);
#undef ML_RD4
#undef ML_WT4
#undef ML_MM4
            }
            if (q4 == 0) {
#pragma unroll
                for (int tt = 0; tt < 4; ++tt) NQ[wave * 64 + 16 * tt + (int)l15] = accN[tt][0]; }
        }
        bf16x8 vf[2], vw[2]; f32x4 wA[2], wB[2];
#pragma unroll
        for (int ks = 0; ks < 2; ++ks) { const s16x4 lo = trd(vtr + VS * (32 * ks)), hi = trd(vtr + VS * (32 * ks + 8)); vf[ks] = cat8(lo, hi);
            wA[ks] = *(const LAS f32x4*)(WE + 32 * ks + wperm); wB[ks] = *(const LAS f32x4*)(WE + 32 * ks + wperm + 8); const f32x4 w0 = wA[ks], w1 = wB[ks];
            const v4u vu = __builtin_bit_cast(v4u, vf[ks]); v4u o;
            o.x = cvtpk(bflo(vu.x) * w0[0], bfhi(vu.x) * w0[1]); o.y = cvtpk(bflo(vu.y) * w0[2], bfhi(vu.y) * w0[3]);
            o.z = cvtpk(bflo(vu.z) * w1[0], bfhi(vu.z) * w1[1]); o.w = cvtpk(bflo(vu.w) * w1[2], bfhi(vu.w) * w1[3]);
            vw[ks] = __builtin_bit_cast(bf16x8, o); }
        { float na[2]; v4u wq[2];
#pragma unroll
          for (int ks = 0; ks < 2; ++ks) { wq[ks].x = cvtpk(wA[ks][0], wA[ks][1]); wq[ks].y = cvtpk(wA[ks][2], wA[ks][3]); wq[ks].z = cvtpk(wB[ks][0], wB[ks][1]); wq[ks].w = cvtpk(wB[ks][2], wB[ks][3]); }
#pragma unroll
          for (int e = 0; e < 2; ++e) { LAS unsigned char* kp_ = ktr + 64u * wave + 32 * e; float a = 0.f;
#pragma unroll
              for (int ks = 0; ks < 2; ++ks) { const v4u ku = __builtin_bit_cast(v4u, cat8(trd(kp_ + KS * (32 * ks)), trd(kp_ + KS * (32 * ks + 8))));
                  a = dot2bf(ku.x, wq[ks].x, a); a = dot2bf(ku.y, wq[ks].y, a); a = dot2bf(ku.z, wq[ks].z, a); a = dot2bf(ku.w, wq[ks].w, a); }
              na[e] = xsum32(xsum16(a)); }
          if (q4 == 0) { const int d0 = 32 * wave + (int)l15; NBUF[d0] = decay * NBUF[d0] + na[0]; NBUF[d0 + 16] = decay * NBUF[d0 + 16] + na[1]; } }
        { s16x4 kA[4][2][2], kB[4][2][2];
#define ML_KRD(buf, ig) _Pragma("unroll") for (int i4 = 0; i4 < 4; ++i4) { _Pragma("unroll") for (int ks = 0; ks < 2; ++ks) { \
            buf[i4][ks][0] = trd(ktr + KS * (32 * ks) + 32 * (4 * (ig) + i4)); buf[i4][ks][1] = trd(ktr + KS * (32 * ks + 8) + 32 * (4 * (ig) + i4)); } }
#define ML_KMM(buf, ig) _Pragma("unroll") for (int i4 = 0; i4 < 4; ++i4) { const int i = 4 * (ig) + i4; X[i] *= decay; \
            _Pragma("unroll") for (int ks = 0; ks < 2; ++ks) X[i] = __builtin_amdgcn_mfma_f32_16x16x32_bf16(cat8(buf[i4][ks][0], buf[i4][ks][1]), vw[ks], X[i], 0, 0, 0); }
          ML_KRD(kA, 0) ML_KRD(kB, 1) ML_KMM(kA, 0) ML_KRD(kA, 2) ML_KMM(kB, 1) ML_KRD(kB, 3) ML_KMM(kA, 2) ML_KMM(kB, 3)
#undef ML_KRD
#undef ML_KMM
        }
        if (latent) {
            BAR_LDS();
            bf16x8 sa0[4], sa1[2]; float nqv[8];
#pragma unroll
            for (int tt = 0; tt < 4; ++tt) sa0[tt] = *(const LAS bf16x8*)(srd + 16 * S_PITCH * tt);
#pragma unroll
            for (int tt = 2; tt < 4; ++tt) sa1[tt - 2] = *(const LAS bf16x8*)(srd + 16 * S_PITCH * tt + 64);
#pragma unroll
            for (int w = 0; w < 8; ++w) nqv[w] = NQ[w * 64 + lane];
            const float rs0 = RS[lane], rs1 = RS[64 + lane];
            if (c + 1 < (CTXL + SEQ) / 64) ML_STORE();
            float FA, FB;
            { const float nq = ((nqv[0] + nqv[1]) + (nqv[2] + nqv[3])) + ((nqv[4] + nqv[5]) + (nqv[6] + nqv[7]));
              const float inter = __expf(m - Mv), den = inter * nq + rs0 + rs1;
              FB = __builtin_amdgcn_rcpf(fmaxf(fabsf(den), __expf(-(bcs + Mv)))); FA = inter * FB; }
            f32x4 accS[4];
#pragma unroll
            for (int tt = 0; tt < 4; ++tt) {
                accS[tt] = __builtin_amdgcn_mfma_f32_16x16x32_bf16(vf[0], sa0[tt], z4, 0, 0, 0);
                if (tt >= 2) accS[tt] = __builtin_amdgcn_mfma_f32_16x16x32_bf16(vf[1], sa1[tt - 2], accS[tt], 0, 0, 0); }
            bf16* hb_ = Hb + (size_t)scan_row(b, dir, 64 * c) * DM; float fav[4], fbv[4]; rowbcast4(FA, fav); rowbcast4(FB, fbv);
#pragma unroll
            for (int tt = 0; tt < 4; ++tt) { const float fa = fav[tt], fb = fbv[tt];
                v2u w; w.x = cvtpk(fa * accI[tt][0] + fb * accS[tt][0], fa * accI[tt][1] + fb * accS[tt][1]); w.y = cvtpk(fa * accI[tt][2] + fb * accS[tt][2], fa * accI[tt][3] + fb * accS[tt][3]);
                *(v2u*)(hb_ + (hoff + sgn * 16 * tt * DM)) = w; }
        } else {
            BAR_LDS();
            if (c + 1 < (CTXL + SEQ) / 64) ML_STORE();
        }
        m = bL + M63;
    }
#undef ML_LOAD
#undef ML_STORE
    BAR_LDS();
}
}


namespace at {
typedef float f32x16 __attribute__((ext_vector_type(16)));
typedef __bf16 bf16x2_t __attribute__((ext_vector_type(2)));
typedef float f32x2_t __attribute__((ext_vector_type(2)));
constexpr int KSTR = 272, VSTR = 320, VOFF = 64 * KSTR, BUFSZ = 64 * KSTR + 64 * VSTR;
__device__ __forceinline__ float max3f(float a, float b, float c) { float r; asm("v_max3_f32 %0, %1, %2, %3" : "=v"(r) : "v"(a), "v"(b), "v"(c)); return r; }
__device__ __forceinline__ unsigned cvt2(float lo, float hi) { f32x2_t v = {lo, hi}; bf16x2_t b = __builtin_convertvector(v, bf16x2_t); return __builtin_bit_cast(unsigned, b); }
__device__ __forceinline__ bf16x8 pack_step(const f32x16& x, int s) { v4u p; p.x = cvt2(x[8 * s], x[8 * s + 1]); p.y = cvt2(x[8 * s + 2], x[8 * s + 3]); p.z = cvt2(x[8 * s + 4], x[8 * s + 5]); p.w = cvt2(x[8 * s + 6], x[8 * s + 7]); return __builtin_bit_cast(bf16x8, p); }

struct TagT { static constexpr bool v = true; }; struct TagF { static constexpr bool v = false; };
__device__ __forceinline__ void attn_items(const Args& A, LAS unsigned char* lds, int tid_in, int lane_in, int wave, int G) {
    constexpr int NIT = NB * AKV * (SEQ / 64);
    int item = blockIdx.x;
    if (item >= NIT) return;
    constexpr bool late = false;
    const bf16* P = (const bf16*)(A.ws + WS_P); bf16* AT = (bf16*)(A.ws + WS_AT);
    int lane = lane_in, tid = tid_in;
    { asm volatile("" : "+v"(lane), "+v"(tid)); }
    const int l31 = lane & 31, hh = lane >> 5;
    const float cl2 = 0.08838834764831845f * 1.4426950408889634f;
    bf16x8 qf[8], qn[8]; v4u pk[2], pv[2];
#define AT_GEOM(it, b_, hkv_, hq_, q0_, qw_, ks_, nwt_) const int b_ = (it) >> 8, hkv_ = ((it) >> 5) & 7, hq_ = hkv_ * 4 + (wave & 3), q0_ = 64 * ((it) & 31), qw_ = q0_ + 32 * (wave >> 2), \
        ks_ = q0_ - WIN < 0 ? 0 : q0_ - WIN, nwt_ = ((q0_ + 64 + WIN > SEQ ? SEQ : q0_ + 64 + WIN) - ks_) >> 6
#define AT_QLOAD(qd, b_, qw_, hq_) do { const bf16* qp_ = P + (size_t)((b_) * SEQ + (qw_) + l31) * NP + OFF_QA + (hq_) * AD + 8 * hh; \
        _Pragma("unroll") for (int ks = 0; ks < 8; ++ks) qd[ks] = *(const bf16x8*)(qp_ + 16 * ks); } while (0)
#define AT_LOAD(b_, hkv_, ks_, nwt_, i) do { const int r0_ = (i) < (nwt_) ? (b_) * SEQ + (ks_) + 64 * (i) : ML + (b_) * CTXL + 64 * ((i) - (nwt_)); \
        _Pragma("unroll") for (int j = 0; j < 2; ++j) { const int idx = tidl + 512 * j; const bf16* gp = P + (size_t)(r0_ + (idx >> 4)) * NP + (hkv_) * AD + (idx & 15) * 8; \
            pk[j] = *(const v4u*)(gp + OFF_KA); pv[j] = *(const v4u*)(gp + OFF_VA); } } while (0)
#define AT_STORE(bufo) do { _Pragma("unroll") for (int j = 0; j < 2; ++j) { const int idx = tid + 512 * j; \
            *(LAS v4u*)(lds + (unsigned)(bufo) + KSTR * (idx >> 4) + 16 * (idx & 15)) = pk[j]; *(LAS v4u*)(lds + (unsigned)(bufo) + VOFF + VSTR * (idx >> 4) + 16 * (idx & 15)) = pv[j]; } } while (0)
#define AT_PV(Vb) do { LAS unsigned char* vp_ = (Vb) + vbase; _Pragma("unroll") for (int f = 0; f < 4; ++f) { _Pragma("unroll") for (int d = 0; d < 4; ++d) { \
            const ml::s16x4 lo = ml::trd(vp_ + VSTR * (16 * f) + 64 * d), hi = ml::trd(vp_ + VSTR * (16 * f + 8) + 64 * d);     \
            O[d] = __builtin_amdgcn_mfma_f32_32x32x16_bf16(ml::cat8(lo, hi), pb[f], O[d], 0, 0, 0); } } } while (0)
    const unsigned kbase = (unsigned)(KSTR * l31 + 16 * hh), vbase = (unsigned)(VSTR * (4 * hh + ((lane & 15) >> 2)) + 32 * ((lane >> 4) & 1) + 8 * (lane & 3));
    int cb, chkv, chq, cq0, cqw, cks, cnwt;
    { AT_GEOM(item, b0, hkv0, hq0, q00, qw0, ks0, nwt0); cb = b0; chkv = hkv0; chq = hq0; cq0 = q00; cqw = qw0; cks = ks0; cnwt = nwt0; }
    int tidl = tid;
    AT_LOAD(cb, chkv, cks, cnwt, 0); AT_QLOAD(qf, cb, cqw, chq);
    AT_STORE(0);
    asm volatile("" : "+v"(qf[0]), "+v"(qf[1]), "+v"(qf[2]), "+v"(qf[3]), "+v"(qf[4]), "+v"(qf[5]), "+v"(qf[6]), "+v"(qf[7]));
#pragma unroll
    for (int ks = 0; ks < 8; ++ks) qn[ks] = qf[ks];
#pragma unroll 1
    for (;;) {
        const int b = cb, hkv = chkv, hq = chq, q0 = cq0, qw = cqw, kstart = cks, nwt = cnwt, nt = nwt + CTXL / 64;
        const int nxt = item + G; const bool more = nxt < NIT;
        AT_GEOM(more ? nxt : item, nb, nhkv, nhq, nq0, nqw, nks, nnwt);
        asm volatile("" : "+v"(tidl));
        float m = A.in[10][hq] * 1.4426950408889634f, l = hh == 0 ? 1.0f : 0.0f;
        f32x16 O[4];
#pragma unroll
        for (int d = 0; d < 4; ++d)
#pragma unroll
            for (int r = 0; r < 16; ++r) O[d][r] = 0.f;
        bf16x8 pb[4];
        int bo = 0, bprev = 0;
        auto trip = [&](const int i, auto last) {
            const int bo1 = bo == 2 * BUFSZ ? 0 : bo + BUFSZ;
            BAR_LDS();
            if (!decltype(last)::v) AT_LOAD(b, hkv, kstart, nwt, i + 1); else if (more) { AT_LOAD(nb, nhkv, nks, nnwt, 0); AT_QLOAD(qn, nb, nqw, nhq); }
            if (late && i > 0) AT_PV(lds + bprev + VOFF);
            LAS unsigned char* Kb = lds + bo + kbase;
            f32x16 S0, S1;
            { const f32x16 z16 = {0.f, 0.f, 0.f, 0.f, 0.f, 0.f, 0.f, 0.f, 0.f, 0.f, 0.f, 0.f, 0.f, 0.f, 0.f, 0.f};
              S0 = __builtin_amdgcn_mfma_f32_32x32x16_bf16(*(const LAS bf16x8*)(Kb), qf[0], z16, 0, 0, 0); S1 = __builtin_amdgcn_mfma_f32_32x32x16_bf16(*(const LAS bf16x8*)(Kb + 32 * KSTR), qf[0], z16, 0, 0, 0); }
#pragma unroll
            for (int ks = 1; ks < 8; ++ks) { const bf16x8 k0 = *(const LAS bf16x8*)(Kb + 32 * ks), k1 = *(const LAS bf16x8*)(Kb + 32 * KSTR + 32 * ks);
                S0 = __builtin_amdgcn_mfma_f32_32x32x16_bf16(k0, qf[ks], S0, 0, 0, 0); S1 = __builtin_amdgcn_mfma_f32_32x32x16_bf16(k1, qf[ks], S1, 0, 0, 0); }
            float mx = -INFINITY;
            if (i < nwt && (kstart + 64 * i + WIN == q0 || kstart + 64 * i == q0 + WIN)) {
                const int dlt = kstart + 64 * i + 4 * hh - (qw + l31);
#pragma unroll
                for (int r = 0; r < 16; ++r) { const int d0 = dlt + (r & 3) + 8 * (r >> 2), d1 = d0 + 32;
                    S0[r] = (d0 >= -WIN && d0 <= WIN) ? S0[r] : -INFINITY; S1[r] = (d1 >= -WIN && d1 <= WIN) ? S1[r] : -INFINITY; } }
#pragma unroll
            for (int r = 0; r < 16; ++r) mx = max3f(mx, S0[r], S1[r]);
            mx = xmax32(mx);
            if (!__all(mx * cl2 - m <= 8.0f)) { const float mn = fmaxf(m, mx * cl2), alpha = __builtin_amdgcn_exp2f(m - mn); m = mn; l *= alpha;
#pragma unroll
                for (int d = 0; d < 4; ++d)
#pragma unroll
                    for (int r = 0; r < 16; ++r) O[d][r] *= alpha; }
            float ls = 0.f;
#pragma unroll
            for (int r = 0; r < 16; ++r) { S0[r] = __builtin_amdgcn_exp2f(S0[r] * cl2 - m); S1[r] = __builtin_amdgcn_exp2f(S1[r] * cl2 - m); ls += S0[r] + S1[r]; }
            l += ls;
            pb[0] = pack_step(S0, 0); pb[1] = pack_step(S0, 1); pb[2] = pack_step(S1, 0); pb[3] = pack_step(S1, 1);
            if (!late) AT_PV(lds + bo + VOFF);
            if (!decltype(last)::v) AT_STORE(bo1);
            bprev = bo; bo = bo1;
        };
#pragma unroll 1
        for (int i = 0; i + 1 < nt; ++i) trip(i, TagF{});
        trip(nt - 1, TagT{});
        if (late) AT_PV(lds + bprev + VOFF);
        BAR_LDS();
        if (more) AT_STORE(0);
        const float inv = __builtin_amdgcn_rcpf(xsum32(l));
        int l2 = lane; asm volatile("" : "+v"(l2));
        bf16* op = AT + (size_t)(b * SEQ + qw + (l2 & 31)) * PK + hq * AD + 4 * (l2 >> 5);
#pragma unroll
        for (int d = 0; d < 4; ++d)
#pragma unroll
            for (int g = 0; g < 4; ++g) { ml::v2u w; w.x = cvt2(O[d][4 * g] * inv, O[d][4 * g + 1] * inv); w.y = cvt2(O[d][4 * g + 2] * inv, O[d][4 * g + 3] * inv);
                *(ml::v2u*)(op + 32 * d + 8 * g) = w; }
        if (!more) break;
#pragma unroll
        for (int ks = 0; ks < 8; ++ks) qf[ks] = qn[ks];
        item = nxt; cb = nb; chkv = nhkv; chq = nhq; cq0 = nq0; cqw = nqw; cks = nks; cnwt = nnwt;
    }
#undef AT_GEOM
#undef AT_QLOAD
#undef AT_LOAD
#undef AT_STORE
#undef AT_PV
    BAR_LDS();
}
}

__device__ __forceinline__ unsigned q4(float a, float b, float c, float d) {
    const float M = 12582912.0f;
    const unsigned ua = __builtin_bit_cast(unsigned, a + M), ub = __builtin_bit_cast(unsigned, b + M), uc = __builtin_bit_cast(unsigned, c + M), ud = __builtin_bit_cast(unsigned, d + M);
    const unsigned lo = __builtin_amdgcn_perm(ub, ua, 0x0c0c0400u), hi = __builtin_amdgcn_perm(ud, uc, 0x0c0c0400u);
    return __builtin_amdgcn_perm(hi, lo, 0x05040100u); }
struct TItem { const float* src; bf16* dst; int N, K; };
constexpr int P0_NB_IN = 129, P0_I_IN = (DM / 64) * P0_NB_IN, P0_NSMALL = P0_I_IN + (DFF / 64) * (DM / 32);
__device__ __forceinline__ TItem p0_item(const Args& A, int it, int lane) {
    unsigned char* ws = A.ws; const float* W; bf16* WT; int N, K, kb, nb; bool remap = false; int r = it;
    if (r < P0_I_IN) { W = A.in[7]; WT = (bf16*)(ws + WS_WIN); N = NPW; K = DM; remap = true; kb = r / P0_NB_IN; nb = r - kb * P0_NB_IN; if (nb == 128) nb = 12288 / 32; }
    else { r -= P0_I_IN; W = A.in[15]; WT = (bf16*)(ws + WS_WF2); N = DM; K = DFF; kb = r >> 7; nb = r & 127; }
    const int k0 = 64 * kb, n0 = 32 * nb, d0 = remap ? win_map(n0) : n0;
    TItem t; t.src = W + (size_t)(k0 + (lane >> 5)) * N + n0 + (lane & 31); t.dst = WT + (size_t)d0 * (K + 64) + k0; t.N = N; t.K = K + 64; return t;
}
__device__ __forceinline__ void p0_load(const TItem& t, float (&wv)[32]) {
#pragma unroll
    for (int i = 0; i < 32; ++i) wv[i] = __builtin_nontemporal_load(t.src + (size_t)(2 * i) * t.N);
}
__device__ __forceinline__ void p0_emit(const TItem& t, const float (&wv)[32], LAS float* scr, int lane) {
#pragma unroll
    for (int i = 0; i < 32; ++i) scr[(2 * i + (lane >> 5)) * 33 + (lane & 31)] = wv[i];
    LDS_WAIT(); asm volatile("" ::: "memory");
    const int c = lane & 7;
#pragma unroll
    for (int j = 0; j < 4; ++j) { const int n = (lane >> 3) + 8 * j; const LAS float* s = scr + (8 * c) * 33 + n;
        v4u o; o.x = pk2(s[0 * 33], s[1 * 33]); o.y = pk2(s[2 * 33], s[3 * 33]); o.z = pk2(s[4 * 33], s[5 * 33]); o.w = pk2(s[6 * 33], s[7 * 33]);
        *(GAS v4u*)(t.dst + (size_t)n * t.K + 8 * c) = o; }
    LDS_WAIT(); asm volatile("" ::: "memory");
}
constexpr int P0_NBIG_IN = 704, P0_NBIG = P0_NBIG_IN + 3 * (DM / 32) + DFF / 32;
struct BigItem { const char* W; unsigned char* dst; float* cs; int N, n0, rbase; bool rot; };
__device__ __forceinline__ BigItem p0_big_item(const Args& A, int item) {
    unsigned char* ws = A.ws; BigItem t; t.rot = false;
    if (item < P0_NBIG_IN) { t.W = (const char*)A.in[7]; t.N = NPW; t.n0 = item < 256 ? OFF_VM + 32 * item : 12320 + 32 * (item - 256); const int d0 = win_map(t.n0); t.rot = d0 >= OFF_QA && d0 < OFF_VA;
        t.rbase = (t.rot ? (d0 & ~63) + ((d0 & 32) ? 4 : 0) : d0) - OFF_KM; t.dst = ws + WS_W8G; t.cs = (float*)(ws + WS_CSG); }
    else if (item < P0_NBIG_IN + 128) { t.W = (const char*)A.in[11]; t.N = DM; t.n0 = 32 * (item - P0_NBIG_IN); t.rbase = t.n0; t.dst = ws + WS_W8OM; t.cs = (float*)(ws + WS_CSOM); }
    else if (item < P0_NBIG_IN + 256) { t.W = (const char*)A.in[12]; t.N = DM; t.n0 = 32 * (item - P0_NBIG_IN - 128); t.rbase = t.n0; t.dst = ws + WS_W8OA; t.cs = (float*)(ws + WS_CSOA); }
    else if (item < P0_NBIG_IN + 384) { t.W = (const char*)A.in[13]; t.N = DM; t.n0 = 32 * (item - P0_NBIG_IN - 256); t.rbase = t.n0; t.dst = ws + WS_W8O; t.cs = (float*)(ws + WS_CSO); }
    else { t.W = (const char*)A.in[14]; t.N = DFF; t.n0 = 32 * (item - P0_NBIG_IN - 384); t.rbase = t.n0; t.dst = ws + WS_W8F; t.cs = (float*)(ws + WS_CSF); }
    return t;
}
__device__ __forceinline__ unsigned p0_big_voff(const BigItem& t, int wave) {
    int t1; asm volatile("v_mbcnt_lo_u32_b32 %0, -1, 0\n\tv_mbcnt_hi_u32_b32 %0, -1, %0" : "=v"(t1)); t1 += wave * 64;
    return (unsigned)((64 * (t1 >> 3)) * t.N + t.n0 + 4 * (t1 & 7)) * 4u;
}
__device__ __forceinline__ void p0_bigs(const Args& A, LAS unsigned char* lds, int wave, int G) {
    int item = blockIdx.x;
    if (item >= P0_NBIG) return;
    BigItem cur = p0_big_item(A, item);
    unsigned voff = p0_big_voff(cur, wave);
    f32x4 ta[8], tb[8];
#define P0B_LD(t, b, it) _Pragma("unroll") for (int u = 0; u < 8; ++u) t[u] = __builtin_nontemporal_load((const f32x4*)((it).W + (size_t)(8 * (b) + u) * (size_t)(4 * (it).N) + voff));
#define P0B_CV(t, b) _Pragma("unroll") for (int u = 0; u < 8; ++u) { const int p = 8 * (b) + u; d[2 * p] = at::cvt2(t[u].x, t[u].y); d[2 * p + 1] = at::cvt2(t[u].z, t[u].w); \
        a0 = fmaxf(a0, fabsf(t[u].x)); a1 = fmaxf(a1, fabsf(t[u].y)); a2 = fmaxf(a2, fabsf(t[u].z)); a3 = fmaxf(a3, fabsf(t[u].w)); \
        asm volatile("" : "+v"(d[2 * p]), "+v"(d[2 * p + 1]), "+v"(a0), "+v"(a1), "+v"(a2), "+v"(a3)); }
    P0B_LD(ta, 0, cur) P0B_LD(tb, 1, cur)
    for (;;) {
        unsigned d[128]; float a0 = 0.f, a1 = 0.f, a2 = 0.f, a3 = 0.f;
        __builtin_amdgcn_sched_barrier(0);
#pragma unroll
        for (int b = 0; b < 8; b += 2) {
            P0B_CV(ta, b) __builtin_amdgcn_sched_barrier(0);
            if (b + 2 < 8) { P0B_LD(ta, b + 2, cur) } __builtin_amdgcn_sched_barrier(0);
            P0B_CV(tb, b + 1) __builtin_amdgcn_sched_barrier(0);
            if (b + 3 < 8) { P0B_LD(tb, b + 3, cur) } __builtin_amdgcn_sched_barrier(0);
        }
        const int nxt = item + G; const bool more = nxt < P0_NBIG;
        const BigItem nx = p0_big_item(A, more ? nxt : item);
        if (more) { voff = p0_big_voff(nx, wave); P0B_LD(ta, 0, nx) P0B_LD(tb, 1, nx) }
        __builtin_amdgcn_sched_barrier(0);
        int t2; asm volatile("v_mbcnt_lo_u32_b32 %0, -1, 0\n\tv_mbcnt_hi_u32_b32 %0, -1, %0" : "=v"(t2)); t2 += wave * 64;
        const int r8 = t2 >> 3, c4 = t2 & 7, ln = t2 & 63;
        a0 = xmax32(xmax16(fmaxf(a0, dppx<0x128>(a0)))); a1 = xmax32(xmax16(fmaxf(a1, dppx<0x128>(a1)))); a2 = xmax32(xmax16(fmaxf(a2, dppx<0x128>(a2)))); a3 = xmax32(xmax16(fmaxf(a3, dppx<0x128>(a3))));
        LAS float* red = (LAS float*)(lds + LDSCTL_OFF + 1024);
        if (ln < 8) { red[wave * 32 + 4 * ln] = a0; red[wave * 32 + 4 * ln + 1] = a1; red[wave * 32 + 4 * ln + 2] = a2; red[wave * 32 + 4 * ln + 3] = a3; }
        BAR_LDS();
#pragma unroll
        for (int w = 0; w < 8; ++w) { a0 = fmaxf(a0, red[w * 32 + 4 * c4]); a1 = fmaxf(a1, red[w * 32 + 4 * c4 + 1]); a2 = fmaxf(a2, red[w * 32 + 4 * c4 + 2]); a3 = fmaxf(a3, red[w * 32 + 4 * c4 + 3]); }
        const float i0 = a0 > 0.f ? 127.0f / a0 : 0.f, i1 = a1 > 0.f ? 127.0f / a1 : 0.f, i2 = a2 > 0.f ? 127.0f / a2 : 0.f, i3 = a3 > 0.f ? 127.0f / a3 : 0.f;
        const int rbase = cur.rbase; const bool rot = cur.rot;
        if (t2 < 8) { const int nb4 = 4 * c4; float* cs = cur.cs;
            cs[rbase + (rot ? 8 * ((nb4 + 0) >> 2) + ((nb4 + 0) & 3) : nb4 + 0)] = a0 * (1.0f / 127.0f); cs[rbase + (rot ? 8 * ((nb4 + 1) >> 2) + ((nb4 + 1) & 3) : nb4 + 1)] = a1 * (1.0f / 127.0f);
            cs[rbase + (rot ? 8 * ((nb4 + 2) >> 2) + ((nb4 + 2) & 3) : nb4 + 2)] = a2 * (1.0f / 127.0f); cs[rbase + (rot ? 8 * ((nb4 + 3) >> 2) + ((nb4 + 3) & 3) : nb4 + 3)] = a3 * (1.0f / 127.0f); }
        LAS unsigned char* img = lds + c4 * 4096;
#pragma unroll
        for (int j = 0; j < 4; ++j) { const int ch = ((4 * r8 + j) ^ c4) << 4; v4u o0, o1, o2, o3;
#pragma unroll
            for (int e = 0; e < 4; ++e) { const int p = 16 * j + 4 * e;
                o0[e] = q4(bflo(d[2 * p]) * i0, bflo(d[2 * p + 2]) * i0, bflo(d[2 * p + 4]) * i0, bflo(d[2 * p + 6]) * i0);
                o1[e] = q4(bfhi(d[2 * p]) * i1, bfhi(d[2 * p + 2]) * i1, bfhi(d[2 * p + 4]) * i1, bfhi(d[2 * p + 6]) * i1);
                o2[e] = q4(bflo(d[2 * p + 1]) * i2, bflo(d[2 * p + 3]) * i2, bflo(d[2 * p + 5]) * i2, bflo(d[2 * p + 7]) * i2);
                o3[e] = q4(bfhi(d[2 * p + 1]) * i3, bfhi(d[2 * p + 3]) * i3, bfhi(d[2 * p + 5]) * i3, bfhi(d[2 * p + 7]) * i3); }
            *(LAS v4u*)(img + 0 * 32768 + ch) = o0; *(LAS v4u*)(img + 1 * 32768 + ch) = o1; *(LAS v4u*)(img + 2 * 32768 + ch) = o2; *(LAS v4u*)(img + 3 * 32768 + ch) = o3; }
        BAR_LDS();
        int l3; asm volatile("v_mbcnt_lo_u32_b32 %0, -1, 0\n\tv_mbcnt_hi_u32_b32 %0, -1, %0" : "=v"(l3));
#pragma unroll
        for (int i = 0; i < 4; ++i) { const int rho = 4 * wave + i, n = 4 * (rho & 7) + (rho >> 3);
            unsigned char* drow = cur.dst + (size_t)(rbase + (rot ? 8 * (n >> 2) + (n & 3) : n)) * P8;
#pragma unroll
            for (int q = 0; q < 4; ++q) { const int ch = 64 * q + l3; *(GAS v4u*)(drow + 16 * ch) = *(const LAS v4u*)(lds + rho * 4096 + ((ch ^ (rho & 7)) << 4)); } }
        if (!more) break;
        item = nxt; cur = nx;
    }
#undef P0B_LD
#undef P0B_CV
}

__device__ __forceinline__ void p0_prologue(const Args& A, LAS unsigned char* lds, int tid, int lane, int wave, int G) {
    unsigned char* ws = A.ws;
    LAS float* scr = (LAS float*)(lds + wave * 16384);
    const int gw = blockIdx.x * NWAVES + wave, NGW = G * NWAVES;
    { const int maxbig = (P0_NBIG + G - 1) / G, ndefw = (G * maxbig - P0_NBIG) * NWAVES, nextra = 7 * ndefw <= P0_NSMALL ? 7 : 0;
      const int rb = (P0_NSMALL - nextra * ndefw) / NGW, t0 = rb * NGW, t1 = t0 + nextra * ndefw;
      const int wdef = gw - (NGW - ndefw);
      auto sidx = [&](int i) -> int {
          if (i < rb) return i * NGW + gw;
          int j = i - rb;
          if (wdef >= 0) { if (j < nextra) return t0 + j * ndefw + wdef; j -= nextra; }
          return (j == 0 && t1 + gw < P0_NSMALL) ? t1 + gw : -1; };
      float wa[32], wb[32]; int i = 0, ia = sidx(0);
      TItem ta = p0_item(A, ia >= 0 ? ia : 0, lane), tb = ta;
      if (ia >= 0) p0_load(ta, wa);
      while (ia >= 0) {
          const int ib = sidx(i + 1);
          if (ib >= 0) { tb = p0_item(A, ib, lane); p0_load(tb, wb); }
          p0_emit(ta, wa, scr, lane);
          if (ib < 0) break;
          ia = sidx(i + 2);
          if (ia >= 0) { ta = p0_item(A, ia, lane); p0_load(ta, wa); }
          p0_emit(tb, wb, scr, lane);
          i += 2;
      } }
    { float* ROT = (float*)(ws + WS_ROT); const int e = blockIdx.x * NWAVES * 64 + tid;
      if (e < 64 * 32) { const int pos = e >> 5, i = e & 31; const float freq = expf(-(float)i * (1.0f / 32.0f) * 9.210340371976184f), ang = (float)pos * freq; ROT[e] = cosf(ang); ROT[2048 + e] = sinf(ang); } }
    __syncthreads();
    LAS float* sc = (LAS float*)lds;
    LAS float* red = sc + 5 * DM;
    const float* cvec = A.in[1]; const float* cctx = A.in[3]; const float* wmod = A.in[4]; const float* bmod = A.in[5];
    float* MOD = (float*)(ws + WS_MOD);
    for (int e = tid; e < 5 * DM; e += NWAVES * 64) { const int r = e >> 12, k = e & (DM - 1); const float cv = r < 4 ? cvec[r * DM + k] : cctx[k]; sc[e] = cv / (1.0f + expf(-cv)); }
    __syncthreads();
    for (int cg = blockIdx.x; cg < NMOD / 96; cg += G) {
        const int kg = tid >> 5, cl = tid & 31;
        float a0[5], a1[5], a2[5];
#pragma unroll
        for (int r = 0; r < 5; ++r) { a0[r] = 0.f; a1[r] = 0.f; a2[r] = 0.f; }
#pragma unroll 8
        for (int k = kg; k < DM; k += 16) {
            const float* wr = wmod + (size_t)k * NMOD + cg * 96 + cl;
            const float w0 = __builtin_nontemporal_load(wr), w1 = __builtin_nontemporal_load(wr + 32), w2 = __builtin_nontemporal_load(wr + 64);
#pragma unroll
            for (int r = 0; r < 5; ++r) { const float s = sc[r * DM + k]; a0[r] += s * w0; a1[r] += s * w1; a2[r] += s * w2; }
        }
#pragma unroll
        for (int r = 0; r < 5; ++r) { red[((kg * 3 + 0) * 5 + r) * 32 + cl] = a0[r]; red[((kg * 3 + 1) * 5 + r) * 32 + cl] = a1[r]; red[((kg * 3 + 2) * 5 + r) * 32 + cl] = a2[r]; }
        __syncthreads();
        if (tid < 480) { const int cc = tid / 160, r = (tid / 32) % 5, c2 = tid & 31; float s = 0.f;
#pragma unroll
            for (int g = 0; g < 16; ++g) s += red[((g * 3 + cc) * 5 + r) * 32 + c2];
            const int col = cg * 96 + cc * 32 + c2; MOD[r * NMOD + col] = s + bmod[col]; }
        __syncthreads();
    }
}

__device__ __forceinline__ void p1_rows(const Args& A, int lane, int wave, int G) {
    const int gw = blockIdx.x * NWAVES + wave, NGW = G * NWAVES;
    const float* MOD = (const float*)(A.ws + WS_MOD); const float* ng = A.in[6];
    bf16* U = (bf16*)(A.ws + WS_U); unsigned char* U8 = A.ws + WS_U8; float* RSU = (float*)(A.ws + WS_RSU);
    for (int m = gw; m < MT; m += NGW) {
        const float* xr = m < ML ? A.in[0] + (size_t)m * DM : A.in[2] + (size_t)(m - ML) * DM;
        const int r = m < ML ? m / SEQ : 4;
        const f32x4* x4 = (const f32x4*)xr + lane;
        f32x4 v[16]; float ss = 0.f;
#pragma unroll
        for (int j = 0; j < 16; ++j) { v[j] = __builtin_nontemporal_load(x4 + 64 * j); ss += (v[j].x * v[j].x + v[j].y * v[j].y) + (v[j].z * v[j].z + v[j].w * v[j].w); }
        const float rstd = __builtin_amdgcn_rsqf(wave_sum(ss) * (1.0f / DM) + EPS);
        const f32x4* g4 = (const f32x4*)ng + lane; const f32x4* sh4 = (const f32x4*)(MOD + r * NMOD) + lane; const f32x4* s4 = (const f32x4*)(MOD + r * NMOD + DM) + lane;
        unsigned long long* o8 = (unsigned long long*)(U + (size_t)m * PK) + lane; float amax = 0.f;
#pragma unroll
        for (int j = 0; j < 16; ++j) { const f32x4 g = g4[64 * j], sh = sh4[64 * j], s = s4[64 * j]; const f32x4 y = v[j] * rstd * g; const f32x4 u = y * (1.0f + s) + sh; v[j] = u;
            amax = fmaxf(amax, fmaxf(fmaxf(fabsf(u.x), fabsf(u.y)), fmaxf(fabsf(u.z), fabsf(u.w))));
            o8[64 * j] = (unsigned long long)pk2(u.x, u.y) | ((unsigned long long)pk2(u.z, u.w) << 32); }
        { amax = wave_max(amax); const float inv = amax > 0.f ? 127.0f / amax : 0.f; if (lane == 0) RSU[m] = amax * (1.0f / 127.0f);
            unsigned* d8 = (unsigned*)(U8 + (size_t)m * P8) + lane;
#pragma unroll
            for (int j = 0; j < 16; ++j) d8[64 * j] = q4(v[j].x * inv, v[j].y * inv, v[j].z * inv, v[j].w * inv); }
    }
}

__device__ __forceinline__ void ld8f(const float* p, f32x4& a, f32x4& b) { a = *(const f32x4*)p; b = *(const f32x4*)(p + 4); }
__device__ __forceinline__ void ld8f_nt(const float* p, f32x4& a, f32x4& b) { a = __builtin_nontemporal_load((const f32x4*)p); b = __builtin_nontemporal_load((const f32x4*)(p + 4)); }
__device__ __forceinline__ void un8(const v4u w, f32x4& a, f32x4& b) { a = (f32x4){bflo(w.x), bfhi(w.x), bflo(w.y), bfhi(w.y)}; b = (f32x4){bflo(w.z), bfhi(w.z), bflo(w.w), bfhi(w.w)}; }
__device__ __forceinline__ float sq8(const f32x4& a, const f32x4& b) { return (a.x * a.x + a.y * a.y) + (a.z * a.z + a.w * a.w) + (b.x * b.x + b.y * b.y) + (b.z * b.z + b.w * b.w); }
__device__ __forceinline__ float amax8(const f32x4& a, const f32x4& b) { return fmaxf(fmaxf(fmaxf(fabsf(a.x), fabsf(a.y)), fmaxf(fabsf(a.z), fabsf(a.w))), fmaxf(fmaxf(fabsf(b.x), fabsf(b.y)), fmaxf(fabsf(b.z), fabsf(b.w)))); }
__device__ __forceinline__ void p5_readout(const Args& A, int lane, int wave, int G) {
    const int gw = blockIdx.x * NWAVES + wave, NGW = G * NWAVES;
    const bf16* HF = (const bf16*)(A.ws + WS_HF); const bf16* HB = (const bf16*)(A.ws + WS_HB); const bf16* AT = (const bf16*)(A.ws + WS_AT);
    const bf16* P = (const bf16*)(A.ws + WS_P); const float* mng = A.in[9];
    unsigned char* HM8 = A.ws + WS_HM8; unsigned char* AT8 = A.ws + WS_AT8; float* RSHM = (float*)(A.ws + WS_RSHM); float* RSAT = (float*)(A.ws + WS_RSAT);
    for (int row = gw; row < ML; row += NGW) {
        f32x4 va[8], vb[8]; float amax = 0.f;
#pragma unroll
        for (int h = 0; h < 8; ++h) { const size_t off = (size_t)row * DM + h * DV + 8 * lane;
            const v4u hf = *(const v4u*)(HF + off), hb = *(const v4u*)(HB + off); const v4u om = *(const v4u*)(P + (size_t)row * NP + OFF_OM + h * DV + 8 * lane);
            f32x4 a0 = (f32x4){bflo(hf.x) + bflo(hb.x), bfhi(hf.x) + bfhi(hb.x), bflo(hf.y) + bflo(hb.y), bfhi(hf.y) + bfhi(hb.y)}, a1 = (f32x4){bflo(hf.z) + bflo(hb.z), bfhi(hf.z) + bfhi(hb.z), bflo(hf.w) + bflo(hb.w), bfhi(hf.w) + bfhi(hb.w)};
            const float rstd = __builtin_amdgcn_rsqf(wave_sum(sq8(a0, a1)) * (1.0f / DV) + EPS);
            const f32x4 g0 = *(const f32x4*)(mng + h * DV + 8 * lane), g1 = *(const f32x4*)(mng + h * DV + 8 * lane + 4);
            a0 = a0 * rstd * g0 * (f32x4){sigm(bflo(om.x)), sigm(bfhi(om.x)), sigm(bflo(om.y)), sigm(bfhi(om.y))}; a1 = a1 * rstd * g1 * (f32x4){sigm(bflo(om.z)), sigm(bfhi(om.z)), sigm(bflo(om.w)), sigm(bfhi(om.w))};
            va[h] = a0; vb[h] = a1; amax = fmaxf(amax, amax8(a0, a1)); }
        amax = wave_max(amax); float inv = amax > 0.f ? 127.0f / amax : 0.f; if (lane == 0) RSHM[row] = amax * (1.0f / 127.0f);
#pragma unroll
        for (int h = 0; h < 8; ++h) { uint2 o; o.x = q4(va[h].x * inv, va[h].y * inv, va[h].z * inv, va[h].w * inv); o.y = q4(vb[h].x * inv, vb[h].y * inv, vb[h].z * inv, vb[h].w * inv);
            *(uint2*)(HM8 + (size_t)row * P8 + h * DV + 8 * lane) = o; }
        amax = 0.f;
#pragma unroll
        for (int j = 0; j < 8; ++j) { un8(*(const v4u*)(AT + (size_t)row * PK + 8 * lane + 512 * j), va[j], vb[j]); amax = fmaxf(amax, amax8(va[j], vb[j])); }
        amax = wave_max(amax); inv = amax > 0.f ? 127.0f / amax : 0.f; if (lane == 0) RSAT[row] = amax * (1.0f / 127.0f);
#pragma unroll
        for (int j = 0; j < 8; ++j) { uint2 o; o.x = q4(va[j].x * inv, va[j].y * inv, va[j].z * inv, va[j].w * inv); o.y = q4(vb[j].x * inv, vb[j].y * inv, vb[j].z * inv, vb[j].w * inv);
            *(uint2*)(AT8 + (size_t)row * P8 + 8 * lane + 512 * j) = o; }
    }
}

__device__ __forceinline__ void p6_ygq(const Args& A, int lane, int wave, int G) {
    const int gw = blockIdx.x * NWAVES + wave, NGW = G * NWAVES;
    const bf16* YG = (const bf16*)(A.ws + WS_YG); unsigned char* YG8 = A.ws + WS_YG8; float* RSY = (float*)(A.ws + WS_RSY); const unsigned* RM = (const unsigned*)(A.ws + WS_RMAXY);
    for (int row = gw; row < ML; row += NGW) {
        const float am = __builtin_bit_cast(float, __hip_atomic_load(RM + row, __ATOMIC_RELAXED, __HIP_MEMORY_SCOPE_AGENT)), inv = am > 0.f ? 127.0f / am : 0.f;
        if (lane == 0) RSY[row] = am * (1.0f / 127.0f);
#pragma unroll
        for (int j = 0; j < 8; ++j) { const v4u w = *(const v4u*)(YG + (size_t)row * PK + 8 * lane + 512 * j);
            uint2 o; o.x = q4(bflo(w.x) * inv, bfhi(w.x) * inv, bflo(w.y) * inv, bfhi(w.y) * inv); o.y = q4(bflo(w.z) * inv, bfhi(w.z) * inv, bflo(w.w) * inv, bfhi(w.w) * inv);
            *(uint2*)(YG8 + (size_t)row * P8 + 8 * lane + 512 * j) = o; }
    }
}

__device__ __forceinline__ void p8_rows(const Args& A, int lane, int wave, int G) {
    const int gw = blockIdx.x * NWAVES + wave, NGW = G * NWAVES;
    const float* MOD = (const float*)(A.ws + WS_MOD); const float* ng = A.in[6];
    const bf16* MIX = (const bf16*)(A.ws + WS_MIX); unsigned char* U28 = A.ws + WS_U28; float* RS2 = (float*)(A.ws + WS_RS2); bf16* H1 = (bf16*)(A.ws + WS_HB);
    for (int m = gw; m < ML; m += NGW) {
        const int r = m / SEQ; const size_t ro = (size_t)m * DM + 8 * lane; const int co = 8 * lane;
        f32x4 va[8], vb[8]; float ss = 0.f;
#pragma unroll
        for (int j = 0; j < 8; ++j) { un8(*(const v4u*)(MIX + ro + 512 * j), va[j], vb[j]); ss += sq8(va[j], vb[j]); }
        const float rstd = __builtin_amdgcn_rsqf(wave_sum(ss) * (1.0f / DM) + EPS);
        const float* n1 = ng + DM + co; const float* g1 = MOD + r * NMOD + 2 * DM + co; const float* x = A.in[0] + ro; float ss2 = 0.f;
#pragma unroll
        for (int j = 0; j < 8; ++j) { f32x4 xa, xb, na, nb, ga, gb; ld8f_nt(x + 512 * j, xa, xb); ld8f(n1 + 512 * j, na, nb); ld8f(g1 + 512 * j, ga, gb);
            va[j] = xa + ga * (va[j] * rstd * na); vb[j] = xb + gb * (vb[j] * rstd * nb); ss2 += sq8(va[j], vb[j]);
            { v4u hw; hw.x = pk2(va[j].x, va[j].y); hw.y = pk2(va[j].z, va[j].w); hw.z = pk2(vb[j].x, vb[j].y); hw.w = pk2(vb[j].z, vb[j].w); *(v4u*)(H1 + ro + 512 * j) = hw; } }
        const float rstd2 = __builtin_amdgcn_rsqf(wave_sum(ss2) * (1.0f / DM) + EPS);
        const float* n2 = ng + 2 * DM + co; const float* sh2 = MOD + r * NMOD + 3 * DM + co; const float* s2 = MOD + r * NMOD + 4 * DM + co;
        float amax = 0.f;
#pragma unroll
        for (int j = 0; j < 8; ++j) { f32x4 na, nb, ha, hb, sa, sb; ld8f(n2 + 512 * j, na, nb); ld8f(sh2 + 512 * j, ha, hb); ld8f(s2 + 512 * j, sa, sb);
            va[j] = (va[j] * rstd2 * na) * (1.0f + sa) + ha; vb[j] = (vb[j] * rstd2 * nb) * (1.0f + sb) + hb;
            amax = fmaxf(amax, fmaxf(fmaxf(fmaxf(fabsf(va[j].x), fabsf(va[j].y)), fmaxf(fabsf(va[j].z), fabsf(va[j].w))), fmaxf(fmaxf(fabsf(vb[j].x), fabsf(vb[j].y)), fmaxf(fabsf(vb[j].z), fabsf(vb[j].w))))); }
        amax = wave_max(amax); const float inv = amax > 0.f ? 127.0f / amax : 0.f; if (lane == 0) RS2[m] = amax * (1.0f / 127.0f);
#pragma unroll
        for (int j = 0; j < 8; ++j) { uint2 o; o.x = q4(va[j].x * inv, va[j].y * inv, va[j].z * inv, va[j].w * inv); o.y = q4(vb[j].x * inv, vb[j].y * inv, vb[j].z * inv, vb[j].w * inv);
            *(uint2*)(U28 + (size_t)m * P8 + co + 512 * j) = o; }
    }
}

__device__ __forceinline__ void p11_rows(const Args& A, int lane, int wave, int G, bool poison) {
    const int gw = blockIdx.x * NWAVES + wave, NGW = G * NWAVES;
    const float* MOD = (const float*)(A.ws + WS_MOD); const float* ng = A.in[6];
    const bf16* Fb = (const bf16*)(A.ws + WS_F); const bf16* H1 = (const bf16*)(A.ws + WS_HB);
    for (int m = gw; m < ML; m += NGW) {
        const int r = m / SEQ; const size_t ro = (size_t)m * DM + 8 * lane; const int co = 8 * lane;
        f32x4 va[8], vb[8]; float ss = 0.f;
#pragma unroll
        for (int j = 0; j < 8; ++j) { un8(*(const v4u*)(Fb + ro + 512 * j), va[j], vb[j]); ss += sq8(va[j], vb[j]); }
        const float rstd3 = __builtin_amdgcn_rsqf(wave_sum(ss) * (1.0f / DM) + EPS);
        const float* n3 = ng + 3 * DM + co; const float* g2 = MOD + r * NMOD + 5 * DM + co;
        const float qn = __builtin_nanf("");
#pragma unroll
        for (int j = 0; j < 8; ++j) { f32x4 ma, mb, ta, tb, ha, hb; un8(*(const v4u*)(H1 + ro + 512 * j), ma, mb);
            ld8f(n3 + 512 * j, ta, tb); ld8f(g2 + 512 * j, ha, hb);
            f32x4 oa = ma + ha * (va[j] * rstd3 * ta), ob = mb + hb * (vb[j] * rstd3 * tb);
            if (poison) { oa = (f32x4){qn, qn, qn, qn}; ob = oa; }
            __builtin_nontemporal_store(oa, (f32x4*)(A.out + ro + 512 * j)); __builtin_nontemporal_store(ob, (f32x4*)(A.out + ro + 512 * j + 4)); }
    }
}

__global__ void __launch_bounds__(NWAVES * 64, 2) fwd_kernel(Args args) {
    extern __shared__ __attribute__((aligned(16))) unsigned char lds_raw[];
    LAS unsigned char* lds = (LAS unsigned char*)lds_raw;
    volatile LAS unsigned* MISC = (volatile LAS unsigned*)(lds + MISC_OFF);
    const int tid0 = threadIdx.x, wave = __builtin_amdgcn_readfirstlane(tid0 >> 6), G = gridDim.x;
    unsigned char* ws = args.ws;
    gu32* ctl = (gu32*)(ws + WS_CTL);
    for (int u = tid0; u < (LDS_BYTES - LDSCTL_OFF) / 4; u += NWAVES * 64) ((LAS unsigned*)(lds + LDSCTL_OFF))[u] = 0u;
    __syncthreads();
    XcdBarrier bar; bar.wave = wave; bar.bar = (unsigned*)(ctl + CW_BAR); bar.x = 0; bar.st = nullptr;
    if (N_LAUNCHES == 1) bar = xcd_barrier_post((unsigned*)(ctl + CW_BAR), MISC + 8, wave);
    const int lo = args.ph_lo, hi = args.ph_hi;
#define IN(k) (lo <= (k) && (k) < hi)
#define PHASE_IDS const int lane = (int)__builtin_amdgcn_mbcnt_hi(~0u, __builtin_amdgcn_mbcnt_lo(~0u, 0u)); const int tid = wave * 64 + lane
#define SEAM(k) do { if (IN(k) && IN((k) + 1)) xcd_barrier(bar); } while (0)

    if (IN(0)) {
        p0_bigs(args, lds, wave, G);
        __syncthreads();
        int lane; asm volatile("v_mbcnt_lo_u32_b32 %0, -1, 0\n\tv_mbcnt_hi_u32_b32 %0, -1, %0" : "=v"(lane)); const int tid = wave * 64 + lane;
        p0_prologue(args, lds, tid, lane, wave, G); } SEAM(0);
    if (IN(1)) { PHASE_IDS; p1_rows(args, lane, wave, G); } SEAM(1);
    if (IN(2)) { PHASE_IDS;
        { pg8::Gemm g{(const pg8::bf16_t*)(ws + WS_U), (const pg8::bf16_t*)(ws + WS_WIN), MT, NP, DM, PK, PK}; pg8::ProjOrder S; S.init(G, (int)blockIdx.x);
          pg8::Epi8<pg8::FProj> E{{(pg8::bf16_t*)(ws + WS_P), (float*)(ws + WS_G), (const float*)(ws + WS_ROT), NP, OFF_GM / 256}};
          pg8::gemm_phase<pg8::Epi8<pg8::FProj>, pg8::ProjOrder, true, true>(lds + RING_OFF, g, S, E, wave); }
        { pg8::Gemm g{(const pg8::bf16_t*)(ws + WS_U8), (const pg8::bf16_t*)(ws + WS_W8G), MT, N8P, DM / 2, P8 / 2, P8 / 2}; pg8::ProjOrderI8 S; S.init(G, (int)blockIdx.x, 32 * 17 + 4 * 9);
          pg8::Epi8<pg8::FProjI8> E{{(pg8::bf16_t*)(ws + WS_P), (const float*)(ws + WS_RSU), (const float*)(ws + WS_CSG), (const float*)(ws + WS_ROT), NP, OFF_KM}};
          pg8::gemm_phase<pg8::Epi8<pg8::FProjI8>, pg8::ProjOrderI8, true, true, true>(lds + RING_OFF, g, S, E, wave); }
    } SEAM(2);
    if (IN(3)) { PHASE_IDS;
        for (int item = blockIdx.x; item < NB * MH * 2 * 4; item += G) ml::mlstm_item(args, lds, tid, lane, wave, item);
        __syncthreads();
        { PHASE_IDS; at::attn_items(args, lds, tid, lane, wave, G); }
        __syncthreads();
    } SEAM(3);
    if (IN(4)) { PHASE_IDS; p5_readout(args, lane, wave, G); } SEAM(4);
    if (IN(5)) { PHASE_IDS;
        { pg8::Gemm g{(const pg8::bf16_t*)(ws + WS_HM8), (const pg8::bf16_t*)(ws + WS_W8OM), ML, DM, DM / 2, P8 / 2, P8 / 2}; pg8::StaticOrder S; S.init(ML, DM, G, (int)blockIdx.x);
          pg8::Epi8<pg8::FGateM8> E{{(const pg8::bf16_t*)(ws + WS_P) + OFF_BGM, NP, (pg8::bf16_t*)(ws + WS_T), DM, (const float*)(ws + WS_RSHM), (const float*)(ws + WS_CSOM)}};
          pg8::gemm_phase<pg8::Epi8<pg8::FGateM8>, pg8::StaticOrder, true, true, true>(lds + RING_OFF, g, S, E, wave); }
        { pg8::Gemm g{(const pg8::bf16_t*)(ws + WS_AT8), (const pg8::bf16_t*)(ws + WS_W8OA), ML, DM, DM / 2, P8 / 2, P8 / 2}; pg8::StaticOrder S; S.init(ML, DM, G, (int)blockIdx.x);
          pg8::Epi8<pg8::FGateA8> E{{(const pg8::bf16_t*)(ws + WS_P) + OFF_BGA, NP, (const pg8::bf16_t*)(ws + WS_T), (pg8::bf16_t*)(ws + WS_YG), DM, PK, (const float*)(ws + WS_RSAT), (const float*)(ws + WS_CSOA), (unsigned*)(ws + WS_RMAXY)}};
          pg8::gemm_phase<pg8::Epi8<pg8::FGateA8>, pg8::StaticOrder, true, true, true>(lds + RING_OFF, g, S, E, wave); }
    } SEAM(5);
    if (IN(6)) { PHASE_IDS; p6_ygq(args, lane, wave, G); } SEAM(6);
    if (IN(7)) { PHASE_IDS;
        pg8::Gemm g{(const pg8::bf16_t*)(ws + WS_YG8), (const pg8::bf16_t*)(ws + WS_W8O), ML, DM, DM / 2, P8 / 2, P8 / 2}; pg8::StaticOrder S; S.init(ML, DM, G, (int)blockIdx.x);
        pg8::Epi8<pg8::FBf16I8> E{{(pg8::bf16_t*)(ws + WS_MIX), (const float*)(ws + WS_RSY), (const float*)(ws + WS_CSO), DM}};
        pg8::gemm_phase<pg8::Epi8<pg8::FBf16I8>, pg8::StaticOrder, true, true, true>(lds + RING_OFF, g, S, E, wave);
    } SEAM(7);
    if (IN(8)) { PHASE_IDS; p8_rows(args, lane, wave, G); } SEAM(8);
    if (IN(9)) { PHASE_IDS;
        pg8::Gemm g{(const pg8::bf16_t*)(ws + WS_U28), (const pg8::bf16_t*)(ws + WS_W8F), ML, DFF, DM / 2, P8 / 2, P8 / 2}; pg8::StaticOrder S; S.init(ML, DFF, G, (int)blockIdx.x);
        pg8::Epi8<pg8::FRelu2I8> E{{(pg8::bf16_t*)(ws + WS_HDN), (const float*)(ws + WS_RS2), (const float*)(ws + WS_CSF), PF}};
        pg8::gemm_phase<pg8::Epi8<pg8::FRelu2I8>, pg8::StaticOrder, true, true, true>(lds + RING_OFF, g, S, E, wave);
    } SEAM(9);
    if (IN(10)) { PHASE_IDS;
        pg8::Gemm g{(const pg8::bf16_t*)(ws + WS_HDN), (const pg8::bf16_t*)(ws + WS_WF2), ML, DM, DFF, PF, PF}; pg8::StaticOrder S; S.init(ML, DM, G, (int)blockIdx.x);
        pg8::Epi8<pg8::FBf16> E{{(pg8::bf16_t*)(ws + WS_F), DM}};
        pg8::gemm_phase<pg8::Epi8<pg8::FBf16>, pg8::StaticOrder, true, true>(lds + RING_OFF, g, S, E, wave);
    } SEAM(10);
    if (IN(11)) { PHASE_IDS;
        const bool poison = (N_LAUNCHES == 1) && (__hip_atomic_load(ctl + CW_BAR + XB_TMO, RLX_AGENT) != 0u);
        p11_rows(args, lane, wave, G, poison);
    }
#undef IN
#undef SEAM
}

extern "C" void kernel_launch(void* const* d_in, const int* in_sizes, int n_in, void* d_out, int out_size, void* d_ws, size_t ws_size, hipStream_t stream) {
    static int grid = 0;
    if (grid == 0) {
        if (n_in != 16 || out_size != ML * DM || ws_size < WS_END2) { fprintf(stderr, "kernel_launch: unexpected shapes: n_in %d out %d ws %zu (need %zu); nothing launched\n", n_in, out_size, ws_size, (size_t)WS_END2); grid = -1; return; }
        int dev = 0, cus = 0, per_cu = 0;
        if (hipGetDevice(&dev) != hipSuccess || hipDeviceGetAttribute(&cus, hipDeviceAttributeMultiprocessorCount, dev) != hipSuccess) { grid = -1; return; }
        if (hipFuncSetAttribute((const void*)fwd_kernel, hipFuncAttributeMaxDynamicSharedMemorySize, LDS_BYTES) != hipSuccess) { fprintf(stderr, "kernel_launch: hipFuncSetAttribute failed\n"); grid = -1; return; }
        if (hipOccupancyMaxActiveBlocksPerMultiprocessor(&per_cu, (const void*)fwd_kernel, NWAVES * 64, LDS_BYTES) != hipSuccess || per_cu < 1)
            fprintf(stderr, "kernel_launch: note: occupancy query reports %d workgroups per CU\n", per_cu);
        (void)hipGetLastError();
        grid = cus;
    }
    if (grid < 0) return;
    if (hipMemsetAsync((char*)d_ws + WS_CTL, 0, CTL_ZERO_BYTES, stream) != hipSuccess) { fprintf(stderr, "kernel_launch: memset failed\n"); return; }
    Args a{};
    for (int i = 0; i < 16; ++i) a.in[i] = (const float*)d_in[i];
    a.out = (float*)d_out; a.ws = (unsigned char*)d_ws;
    for (int li = 0; li < N_LAUNCHES; ++li) {
        a.ph_lo = (N_LAUNCHES == 1) ? 0 : li; a.ph_hi = (N_LAUNCHES == 1) ? N_PHASES : li + 1;
        hipLaunchKernelGGL(fwd_kernel, dim3(grid), dim3(NWAVES * 64), LDS_BYTES, stream, a);
        const hipError_t le = hipPeekAtLastError();
        if (le != hipSuccess) { fprintf(stderr, "kernel_launch: launch %d failed: %s\n", li, hipGetErrorName(le)); break; }
    }
}
```

```cpp
#define MK_N_LAUNCHES 1
#include <hip/hip_runtime.h>
#include <cstdio>
#include <cstdint>
namespace pg8 {
#define PG8_LAS __attribute__((address_space(3)))
typedef unsigned short bf16_t;
typedef short bf16x8 __attribute__((ext_vector_type(8)));
typedef float f32x4 __attribute__((ext_vector_type(4)));
typedef unsigned u32x4 __attribute__((ext_vector_type(4)));
constexpr int BM = 256, BK = 64, HALF = 128, HTB = HALF * BK * 2  , STAGE_BYTES = 8 * HTB, NXCD = 8, WGM = 8;

__host__ __device__ __forceinline__ int lds_byte(int r, int c) { const int st = (r >> 4) * 2 + (c >> 5), rr = r & 15, cc = c & 31, ob = rr * 64 + cc * 2; return st * 1024 + (ob ^ (((ob >> 9) & 1) << 5)); }
__host__ __device__ __forceinline__ void stage_rc(int b, int& R, int& C) { const int st = b / 1024, sb = b % 1024, swz = sb ^ (((sb >> 9) & 1) << 5); R = (st >> 1) * 16 + swz / 64; C = (st & 1) * 32 + (swz % 64) / 2; }
__host__ __device__ __forceinline__ int perm32(int rho) { const int n = rho >> 4, i = rho & 15; return 8 * (i >> 2) + 4 * n + (i & 3); }

struct Unit { int pm, pn; };
struct Gemm { const bf16_t* A; const bf16_t* Bt; int M, N, K, lda, ldb; };

struct StaticOrder {
    int nM, nN, nwg, G, c;
    __host__ __device__ void init(int M, int N, int G_, int c_) { nM = M / BM; nN = N / BM; nwg = nM * nN; G = G_; c = c_; }
    __host__ __device__ bool next(int i, Unit& u) const { return at((long)i * G + c, u); }
    __host__ __device__ bool at(const long L, Unit& u) const {
        if (L >= nwg) return false;
        int wgid = (int)L; { const int q = nwg / NXCD, r = nwg % NXCD, xcd = wgid % NXCD, off = wgid / NXCD; wgid = (xcd < r ? xcd * (q + 1) : r * (q + 1) + (xcd - r) * q) + off; }
        const int nig = WGM * nN, gid = wgid / nig, fm = gid * WGM, gsz = (nM - fm) < WGM ? (nM - fm) : WGM;
        u.pm = fm + ((wgid % nig) % gsz); u.pn = (wgid % nig) / gsz; return true;
    }
    __device__ __forceinline__ void a_ready(const Unit&) const {}
    __device__ __forceinline__ void done(const Unit&) const {}
};

__device__ __forceinline__ unsigned cvt_pk_bf16(float lo, float hi) { unsigned r; asm volatile("v_cvt_pk_bf16_f32 %0, %1, %2" : "=v"(r) : "v"(lo), "v"(hi)); return r; }
typedef float f32x2 __attribute__((ext_vector_type(2)));

__device__ __forceinline__ float bf_lo(unsigned w) { return __builtin_bit_cast(float, w << 16); }
__device__ __forceinline__ float bf_hi(unsigned w) { return __builtin_bit_cast(float, w & 0xffff0000u); }
__device__ __forceinline__ float sigmoidf_(float x) { return __builtin_amdgcn_rcpf(1.0f + __expf(-x)); }
template <class F> struct Epi8 {
    static constexpr bool PERM = true, AFTER_DRAIN = false;
    F f;
    __device__ __forceinline__ void operator()(const f32x4 (&acc)[2][2][4][2], const Unit& u, int wr, int wc, int fr, int fq) const {
        const int row0 = u.pm * BM + wr * 64 + fr, col0 = u.pn * BM + wc * 32 + 8 * fq;
#pragma unroll
        for (int ai = 0; ai < 2; ++ai)
#pragma unroll
            for (int m = 0; m < 4; ++m) { const int row = row0 + ai * HALF + m * 16;
#pragma unroll
                for (int bj = 0; bj < 2; ++bj) f(row, col0 + bj * HALF, acc[ai][bj][m][0], acc[ai][bj][m][1], u.pn); }
    }
};
__device__ __forceinline__ u32x4 pack8(const f32x4& v0, const f32x4& v1) { u32x4 w; w.x = cvt_pk_bf16(v0[0], v0[1]); w.y = cvt_pk_bf16(v0[2], v0[3]); w.z = cvt_pk_bf16(v1[0], v1[1]); w.w = cvt_pk_bf16(v1[2], v1[3]); return w; }
struct FProj { bf16_t* P; float* G; const float* ROT; int ldp; int gate_pn;
    __device__ __forceinline__ void operator()(int row, int col, const f32x4& v0, const f32x4& v1, int pn) const {
        if (pn == gate_pn) { const int cl = col - gate_pn * BM; if (cl < 32) { *(f32x4*)(G + (size_t)row * 32 + cl) = v0; *(f32x4*)(G + (size_t)row * 32 + cl + 4) = v1; } }
        else if (pn < 8) *(u32x4*)(P + (size_t)row * ldp + col) = pack8(v0 * 0.0625f, v1 * 0.0625f);
        else if (pn >= 48 && pn < 68 && row < 8192) { const int hp = col & 127, t = row & 2047, pos = (hp & 64) ? (t & 63) : (t >> 6), i0 = (hp & 63) >> 1;
            const f32x4 cs = *(const f32x4*)(ROT + pos * 32 + i0), sn = *(const f32x4*)(ROT + 2048 + pos * 32 + i0);
            *(u32x4*)(P + (size_t)row * ldp + col) = pack8(v0 * cs - v1 * sn, v0 * sn + v1 * cs); }
        else *(u32x4*)(P + (size_t)row * ldp + col) = pack8(v0, v1);
    } };
struct ProjOrder {
    StaticOrder base; int G, c;
    __host__ __device__ void init(int G_, int c_) { base.init(8192, 17 * 256, G_, c_); G = G_; c = c_; }
    __host__ __device__ bool next(int i, Unit& u) const { const long L = (long)i * G + c;
        if (L < base.nwg) { base.next(i, u); if (u.pn == 16) u.pn = 104; return true; }
        const int r = (int)(L - base.nwg); if (r >= 4 * 9) return false; u.pm = 32 + (r & 3); const int j = r >> 2; u.pn = j < 8 ? 8 + j : 104; return true; }
    __device__ __forceinline__ void a_ready(const Unit&) const {}
    __device__ __forceinline__ void done(const Unit&) const {}
};
struct ProjOrderI8 {
    StaticOrder base; int G, c, nheavy, qh;
    __host__ __device__ void init(int G_, int c_, int n_bf16_units) { base.init(8192, 88 * 256, G_, 0); G = G_; c = c_; nheavy = n_bf16_units % G_;
        const int ni = base.nwg + 4 * 24; int q = (ni - 2 * (G_ - nheavy) + G_ - 1) / G_; qh = q < 0 ? 0 : q; }
    __host__ __device__ bool next(int i, Unit& u) const {
        long L; if (i < qh) L = (long)i * G + c; else { if (c < nheavy) return false; L = (long)qh * G + (long)(i - qh) * (G - nheavy) + (c - nheavy); }
        if (L < base.nwg) { base.at(L, u); u.pn += 8; return true; }
        const int r = (int)(L - base.nwg); if (r >= 4 * 24) return false; u.pm = 32 + (r & 3); const int j = r >> 2; u.pn = j < 16 ? 8 + j : 40 + j; return true; }
    __device__ __forceinline__ void a_ready(const Unit&) const {}
    __device__ __forceinline__ void done(const Unit&) const {}
};
__device__ __forceinline__ float i2f(float bits) { return (float)__builtin_bit_cast(int, bits); }
__device__ __forceinline__ f32x4 i2f4(const f32x4& v) { return (f32x4){i2f(v[0]), i2f(v[1]), i2f(v[2]), i2f(v[3])}; }
struct FProjI8 { bf16_t* P; const float* rs; const float* cs; const float* ROT; int ldp; int off_a;
    __device__ __forceinline__ void operator()(int row, int col, const f32x4& v0, const f32x4& v1, int pn) const {
        const float r = rs[row]; const f32x4 c0 = *(const f32x4*)(cs + col) * r, c1 = *(const f32x4*)(cs + col + 4) * r;
        f32x4 a = i2f4(v0) * c0, b = i2f4(v1) * c1;
        const int oc = off_a + col;
        if (pn >= 40 && pn < 60 && row < 8192) { const int hp = oc & 127, t = row & 2047, pos = (hp & 64) ? (t & 63) : (t >> 6), i0 = (hp & 63) >> 1;
            const f32x4 csn = *(const f32x4*)(ROT + pos * 32 + i0), sn = *(const f32x4*)(ROT + 2048 + pos * 32 + i0);
            const f32x4 ra = a * csn - b * sn, rb = a * sn + b * csn; a = ra; b = rb; }
        *(u32x4*)(P + (size_t)row * ldp + oc) = pack8(a, b);
    } };
struct FGateM { const bf16_t* Pg; int ldp; bf16_t* T; int ldt;
    __device__ __forceinline__ void operator()(int row, int col, const f32x4& v0, const f32x4& v1, int) const {
        const u32x4 g = *(const u32x4*)(Pg + (size_t)row * ldp + col);
        f32x4 a, b; a[0] = sigmoidf_(bf_lo(g.x)) * v0[0]; a[1] = sigmoidf_(bf_hi(g.x)) * v0[1]; a[2] = sigmoidf_(bf_lo(g.y)) * v0[2]; a[3] = sigmoidf_(bf_hi(g.y)) * v0[3];
        b[0] = sigmoidf_(bf_lo(g.z)) * v1[0]; b[1] = sigmoidf_(bf_hi(g.z)) * v1[1]; b[2] = sigmoidf_(bf_lo(g.w)) * v1[2]; b[3] = sigmoidf_(bf_hi(g.w)) * v1[3];
        *(u32x4*)(T + (size_t)row * ldt + col) = pack8(a, b);
    } };
struct FGateA { const bf16_t* Pg; int ldp; const bf16_t* T; bf16_t* Y; int ldt, ldy;
    __device__ __forceinline__ void operator()(int row, int col, const f32x4& v0, const f32x4& v1, int) const {
        const u32x4 g = *(const u32x4*)(Pg + (size_t)row * ldp + col), t = *(const u32x4*)(T + (size_t)row * ldt + col);
        f32x4 a, b;
        a[0] = bf_lo(t.x) + sigmoidf_(bf_lo(g.x)) * v0[0]; a[1] = bf_hi(t.x) + sigmoidf_(bf_hi(g.x)) * v0[1]; a[2] = bf_lo(t.y) + sigmoidf_(bf_lo(g.y)) * v0[2]; a[3] = bf_hi(t.y) + sigmoidf_(bf_hi(g.y)) * v0[3];
        b[0] = bf_lo(t.z) + sigmoidf_(bf_lo(g.z)) * v1[0]; b[1] = bf_hi(t.z) + sigmoidf_(bf_hi(g.z)) * v1[1]; b[2] = bf_lo(t.w) + sigmoidf_(bf_lo(g.w)) * v1[2]; b[3] = bf_hi(t.w) + sigmoidf_(bf_hi(g.w)) * v1[3];
        *(u32x4*)(Y + (size_t)row * ldy + col) = pack8(a, b);
    } };
struct FGateM8 { const bf16_t* Pg; int ldp; bf16_t* T; int ldt; const float* rs; const float* cs;
    __device__ __forceinline__ void operator()(int row, int col, const f32x4& v0, const f32x4& v1, int) const {
        const float r = rs[row]; const f32x4 c0 = *(const f32x4*)(cs + col) * r, c1 = *(const f32x4*)(cs + col + 4) * r;
        const u32x4 g = *(const u32x4*)(Pg + (size_t)row * ldp + col);
        f32x4 a, b; a[0] = sigmoidf_(bf_lo(g.x)) * i2f(v0[0]) * c0[0]; a[1] = sigmoidf_(bf_hi(g.x)) * i2f(v0[1]) * c0[1]; a[2] = sigmoidf_(bf_lo(g.y)) * i2f(v0[2]) * c0[2]; a[3] = sigmoidf_(bf_hi(g.y)) * i2f(v0[3]) * c0[3];
        b[0] = sigmoidf_(bf_lo(g.z)) * i2f(v1[0]) * c1[0]; b[1] = sigmoidf_(bf_hi(g.z)) * i2f(v1[1]) * c1[1]; b[2] = sigmoidf_(bf_lo(g.w)) * i2f(v1[2]) * c1[2]; b[3] = sigmoidf_(bf_hi(g.w)) * i2f(v1[3]) * c1[3];
        *(u32x4*)(T + (size_t)row * ldt + col) = pack8(a, b);
    } };
struct FGateA8 { const bf16_t* Pg; int ldp; const bf16_t* T; bf16_t* Y; int ldt, ldy; const float* rs; const float* cs; unsigned* rmax;
    __device__ __forceinline__ void operator()(int row, int col, const f32x4& v0, const f32x4& v1, int) const {
        const float r = rs[row]; const f32x4 c0 = *(const f32x4*)(cs + col) * r, c1 = *(const f32x4*)(cs + col + 4) * r;
        const u32x4 g = *(const u32x4*)(Pg + (size_t)row * ldp + col), t = *(const u32x4*)(T + (size_t)row * ldt + col);
        f32x4 a, b;
        a[0] = bf_lo(t.x) + sigmoidf_(bf_lo(g.x)) * i2f(v0[0]) * c0[0]; a[1] = bf_hi(t.x) + sigmoidf_(bf_hi(g.x)) * i2f(v0[1]) * c0[1]; a[2] = bf_lo(t.y) + sigmoidf_(bf_lo(g.y)) * i2f(v0[2]) * c0[2]; a[3] = bf_hi(t.y) + sigmoidf_(bf_hi(g.y)) * i2f(v0[3]) * c0[3];
        b[0] = bf_lo(t.z) + sigmoidf_(bf_lo(g.z)) * i2f(v1[0]) * c1[0]; b[1] = bf_hi(t.z) + sigmoidf_(bf_hi(g.z)) * i2f(v1[1]) * c1[1]; b[2] = bf_lo(t.w) + sigmoidf_(bf_lo(g.w)) * i2f(v1[2]) * c1[2]; b[3] = bf_hi(t.w) + sigmoidf_(bf_hi(g.w)) * i2f(v1[3]) * c1[3];
        *(u32x4*)(Y + (size_t)row * ldy + col) = pack8(a, b);
        float mx = fmaxf(fmaxf(fmaxf(fabsf(a[0]), fabsf(a[1])), fmaxf(fabsf(a[2]), fabsf(a[3]))), fmaxf(fmaxf(fabsf(b[0]), fabsf(b[1])), fmaxf(fabsf(b[2]), fabsf(b[3]))));
        mx = fmaxf(mx, __shfl_xor(mx, 16)); mx = fmaxf(mx, __shfl_xor(mx, 32));
        if ((__builtin_amdgcn_mbcnt_hi(~0u, __builtin_amdgcn_mbcnt_lo(~0u, 0u)) >> 4) == 0u) atomicMax(rmax + row, __builtin_bit_cast(unsigned, mx));
    } };
struct FF32 { float* C; int ldc;
    __device__ __forceinline__ void operator()(int row, int col, const f32x4& v0, const f32x4& v1, int) const { *(f32x4*)(C + (size_t)row * ldc + col) = v0; *(f32x4*)(C + (size_t)row * ldc + col + 4) = v1; } };
struct FBf16 { bf16_t* O; int ldc;
    __device__ __forceinline__ void operator()(int row, int col, const f32x4& v0, const f32x4& v1, int) const { *(u32x4*)(O + (size_t)row * ldc + col) = pack8(v0, v1); } };
struct FBf16I8 { bf16_t* O; const float* rs; const float* cs; int ldc;
    __device__ __forceinline__ void operator()(int row, int col, const f32x4& v0, const f32x4& v1, int) const {
        const float r = rs[row]; const f32x4 c0 = *(const f32x4*)(cs + col) * r, c1 = *(const f32x4*)(cs + col + 4) * r;
        const f32x4 a = i2f4(v0) * c0, b = i2f4(v1) * c1;
        *(u32x4*)(O + (size_t)row * ldc + col) = pack8(a, b);
    } };
struct FRelu2I8 { bf16_t* O; const float* rs; const float* cs; int ldc;
    __device__ __forceinline__ void operator()(int row, int col, const f32x4& v0, const f32x4& v1, int) const {
        const float r = rs[row]; const f32x4 c0 = *(const f32x4*)(cs + col) * r, c1 = *(const f32x4*)(cs + col + 4) * r;
        f32x4 a = i2f4(v0) * c0, b = i2f4(v1) * c1;
#pragma unroll
        for (int j = 0; j < 4; ++j) { a[j] = fmaxf(a[j], 0.f); b[j] = fmaxf(b[j], 0.f); }
        a = a * a; b = b * b;
        *(u32x4*)(O + (size_t)row * ldc + col) = pack8(a, b);
    } };
struct FRelu2 { bf16_t* O; int ldc;
    __device__ __forceinline__ void operator()(int row, int col, const f32x4& v0, const f32x4& v1, int) const {
        f32x4 a, b;
#pragma unroll
        for (int j = 0; j < 4; ++j) { const float x = fmaxf(v0[j], 0.f), y = fmaxf(v1[j], 0.f); a[j] = x * x; b[j] = y * y; }
        *(u32x4*)(O + (size_t)row * ldc + col) = pack8(a, b);
    } };

typedef int i32x4 __attribute__((ext_vector_type(4)));
template <bool I8> __device__ __forceinline__ f32x4 mma16(const bf16x8& b, const bf16x8& a, const f32x4& c) {
    if constexpr (I8) return __builtin_bit_cast(f32x4, __builtin_amdgcn_mfma_i32_16x16x64_i8(__builtin_bit_cast(i32x4, b), __builtin_bit_cast(i32x4, a), __builtin_bit_cast(i32x4, c), 0, 0, 0));
    else return __builtin_amdgcn_mfma_f32_16x16x32_bf16(b, a, c, 0, 0, 0);
}
template <class Epi, class Sched, bool ALIGN_EPI = false, bool SP2 = false, bool I8 = false>
__device__ __forceinline__ void gemm_phase(PG8_LAS unsigned char* lds, const Gemm g, const Sched& S, const Epi& E, const int wave_id) {
    const int lane = (int)__builtin_amdgcn_mbcnt_hi(~0u, __builtin_amdgcn_mbcnt_lo(~0u, 0u)), wid = wave_id, tid = wid * 64 + lane,
              wr = wid >> 2, wc = wid & 3, fr = lane & 15, fq = lane >> 4;
    const int K = g.K, nt = K / BK;
    unsigned voffA[2], voffB[2];
#pragma unroll
    for (int i = 0; i < 2; ++i) { int R, C; stage_rc(tid * 16 + i * 8192, R, C); const int Rb = Epi::PERM ? ((R & ~31) + perm32(R & 31)) : R;
        voffA[i] = (unsigned)(R * g.lda + C) * 2u; voffB[i] = (unsigned)(Rb * g.ldb + C) * 2u; }
    const size_t kstep = (size_t)(BK * 2);
    const size_t hstepA = (size_t)HALF * g.lda * 2, hstepB = (size_t)HALF * g.ldb * 2;
    const size_t tstepA = 2 * hstepA, tstepB = 2 * hstepB;
    const unsigned ldsw = (unsigned)wid * 1024u;
    const int aoff = lds_byte(wr * 64 + fr, fq * 8), boff = lds_byte(wc * 32 + fr, fq * 8);
#define PG8_SA(b, h) (((b) * 2 + (h)) * HTB)
#define PG8_SB(b, h) ((4 + (b) * 2 + (h)) * HTB)
#define PG8_STAGE(bufoff, gbase, voff) do { _Pragma("unroll") for (int _i = 0; _i < 2; ++_i) \
        __builtin_amdgcn_global_load_lds((const unsigned*)((const char*)(gbase) + (voff)[_i]), (PG8_LAS unsigned*)(lds + (bufoff) + ldsw + _i * 8192), 16, 0, 0); } while (0)
#define PG8_LDA(dst, b, h) do { _Pragma("unroll") for (int m = 0; m < 4; ++m) _Pragma("unroll") for (int k = 0; k < 2; ++k) dst[m][k] = *(const PG8_LAS bf16x8*)(lds + PG8_SA(b, h) + aoff + m * 2048 + k * 1024); } while (0)
#define PG8_LDB(dst, b, h) do { _Pragma("unroll") for (int n = 0; n < 2; ++n) _Pragma("unroll") for (int k = 0; k < 2; ++k) dst[n][k] = *(const PG8_LAS bf16x8*)(lds + PG8_SB(b, h) + boff + n * 2048 + k * 1024); } while (0)
#define PG8_MMA(ai, bj, At, Bt) do { __builtin_amdgcn_s_setprio(1); _Pragma("unroll") for (int m = 0; m < 4; ++m) _Pragma("unroll") for (int n = 0; n < 2; ++n) _Pragma("unroll") for (int k = 0; k < 2; ++k) \
        acc[ai][bj][m][n] = mma16<I8>(Bt[n][k], At[m][k], acc[ai][bj][m][n]); __builtin_amdgcn_s_setprio(0); } while (0)
#define PG8_WAIT_V(n) asm volatile("s_waitcnt vmcnt(" #n ")" ::: "memory")
#define PG8_WAIT_L(n) asm volatile("s_waitcnt lgkmcnt(" #n ")" ::: "memory")
#define PG8_BAR __builtin_amdgcn_s_barrier()
#define PG8_SCHED __builtin_amdgcn_sched_barrier(0)
    Unit cur, nxt; int ui = 0;
    if (!S.next(0, cur)) return;
    f32x4 acc[2][2][4][2];
#pragma unroll
    for (int a = 0; a < 2; ++a)
#pragma unroll
        for (int b = 0; b < 2; ++b)
#pragma unroll
            for (int m = 0; m < 4; ++m)
#pragma unroll
                for (int n = 0; n < 2; ++n) acc[a][b][m][n] = (f32x4){0.f, 0.f, 0.f, 0.f};
    bf16x8 At[4][2], B0[2][2], B1[2][2];
    const char* cA = (const char*)g.A + (size_t)cur.pm * tstepA; const char* cB = (const char*)g.Bt + (size_t)cur.pn * tstepB;
    S.a_ready(cur);
    if constexpr (SP2) {
        PG8_STAGE(PG8_SB(0, 0), cB, voffB); PG8_STAGE(PG8_SB(0, 1), cB + hstepB, voffB); PG8_STAGE(PG8_SA(0, 0), cA, voffA); PG8_STAGE(PG8_SA(0, 1), cA + hstepA, voffA);
        if (wr == 1) PG8_BAR;
        PG8_WAIT_V(2); PG8_BAR;
        PG8_STAGE(PG8_SB(1, 0), cB + kstep, voffB); PG8_STAGE(PG8_SA(1, 0), cA + kstep, voffA); PG8_STAGE(PG8_SB(1, 1), cB + hstepB + kstep, voffB);
        PG8_WAIT_V(6); PG8_BAR;
    } else {
        PG8_STAGE(PG8_SB(0, 0), cB, voffB); PG8_STAGE(PG8_SA(0, 0), cA, voffA); PG8_STAGE(PG8_SB(0, 1), cB + hstepB, voffB); PG8_STAGE(PG8_SA(0, 1), cA + hstepA, voffA);
        if (wr == 1) PG8_BAR;
        PG8_WAIT_V(4); PG8_BAR;
        PG8_STAGE(PG8_SB(1, 0), cB + kstep, voffB); PG8_STAGE(PG8_SA(1, 0), cA + kstep, voffA); PG8_STAGE(PG8_SB(1, 1), cB + hstepB + kstep, voffB);
        PG8_WAIT_V(6); PG8_BAR;
    }
    for (;;) {
        const bool has_next = S.next(ui + 1, nxt);
        const char* nA = has_next ? (const char*)g.A + (size_t)nxt.pm * tstepA : cA; const char* nB = has_next ? (const char*)g.Bt + (size_t)nxt.pn * tstepB : cB;
        for (int t = 0; t < nt; t += 2) {
            const bool last = (t == nt - 2);
            const char* a1 = cA + (size_t)(t + 1) * kstep;
            const char* a2 = last ? nA : cA + (size_t)(t + 2) * kstep; const char* b2 = last ? nB : cB + (size_t)(t + 2) * kstep;
            const char* a3 = a2 + kstep; const char* b3 = b2 + kstep;
            if (last && has_next) S.a_ready(nxt);
            if constexpr (SP2) {
            PG8_LDB(B0, 0, 0); PG8_LDB(B1, 0, 1); PG8_SCHED; PG8_LDA(At, 0, 0); PG8_STAGE(PG8_SA(1, 1), a1 + hstepA, voffA);
            PG8_WAIT_V(8); PG8_WAIT_L(0); PG8_BAR; PG8_MMA(0, 0, At, B0); PG8_MMA(0, 1, At, B1); PG8_BAR; PG8_SCHED;
            PG8_LDA(At, 0, 1); PG8_STAGE(PG8_SB(0, 0), b2, voffB); PG8_STAGE(PG8_SB(0, 1), b2 + hstepB, voffB); PG8_STAGE(PG8_SA(0, 0), a2, voffA);
            PG8_WAIT_V(8); PG8_WAIT_L(0); PG8_BAR; PG8_MMA(1, 0, At, B0); PG8_MMA(1, 1, At, B1); PG8_BAR; PG8_SCHED;
            PG8_LDB(B0, 1, 0); PG8_LDB(B1, 1, 1); PG8_SCHED; PG8_LDA(At, 1, 0); PG8_STAGE(PG8_SA(0, 1), a2 + hstepA, voffA);
            PG8_WAIT_V(8); PG8_WAIT_L(0); PG8_BAR; PG8_MMA(0, 0, At, B0); PG8_MMA(0, 1, At, B1); PG8_BAR; PG8_SCHED;
            PG8_LDA(At, 1, 1); PG8_STAGE(PG8_SB(1, 0), b3, voffB); PG8_STAGE(PG8_SB(1, 1), b3 + hstepB, voffB); PG8_STAGE(PG8_SA(1, 0), a3, voffA);
            PG8_WAIT_V(8); PG8_WAIT_L(0); PG8_BAR; PG8_MMA(1, 0, At, B0); PG8_MMA(1, 1, At, B1); PG8_BAR; PG8_SCHED;
            } else {
            PG8_LDB(B0, 0, 0); PG8_SCHED; PG8_LDA(At, 0, 0); PG8_STAGE(PG8_SA(1, 1), a1 + hstepA, voffA);
            PG8_WAIT_L(8); PG8_BAR; PG8_WAIT_L(0); PG8_MMA(0, 0, At, B0); PG8_BAR; PG8_SCHED;
            PG8_LDB(B1, 0, 1); PG8_STAGE(PG8_SB(0, 0), b2, voffB);
            PG8_BAR; PG8_WAIT_L(0); PG8_MMA(0, 1, At, B1); PG8_BAR;
            PG8_LDA(At, 0, 1); PG8_STAGE(PG8_SA(0, 0), a2, voffA);
            PG8_BAR; PG8_WAIT_L(0); PG8_MMA(1, 0, At, B0); PG8_BAR; PG8_SCHED;
            PG8_STAGE(PG8_SB(0, 1), b2 + hstepB, voffB);
            PG8_WAIT_V(6); PG8_BAR; PG8_MMA(1, 1, At, B1); PG8_BAR;
            PG8_LDB(B0, 1, 0); PG8_SCHED; PG8_LDA(At, 1, 0); PG8_STAGE(PG8_SA(0, 1), a2 + hstepA, voffA);
            PG8_WAIT_L(8); PG8_BAR; PG8_WAIT_L(0); PG8_MMA(0, 0, At, B0); PG8_BAR; PG8_SCHED;
            PG8_LDB(B1, 1, 1); PG8_STAGE(PG8_SB(1, 0), b3, voffB);
            PG8_BAR; PG8_WAIT_L(0); PG8_MMA(0, 1, At, B1); PG8_BAR;
            PG8_LDA(At, 1, 1); PG8_STAGE(PG8_SA(1, 0), a3, voffA);
            PG8_BAR; PG8_WAIT_L(0); PG8_MMA(1, 0, At, B0); PG8_BAR; PG8_SCHED;
            PG8_STAGE(PG8_SB(1, 1), b3 + hstepB, voffB);
            PG8_WAIT_V(6); PG8_BAR; PG8_MMA(1, 1, At, B1); PG8_BAR;
            }
        }
        if constexpr (ALIGN_EPI) { if (wr == 0) PG8_BAR; }
        if constexpr (!Epi::AFTER_DRAIN) { E(acc, cur, wr, wc, fr, fq); S.done(cur); }
        if (!has_next) break;
#pragma unroll
        for (int a = 0; a < 2; ++a)
#pragma unroll
            for (int b = 0; b < 2; ++b)
#pragma unroll
                for (int m = 0; m < 4; ++m)
#pragma unroll
                    for (int n = 0; n < 2; ++n) acc[a][b][m][n] = (f32x4){0.f, 0.f, 0.f, 0.f};
        cur = nxt; cA = nA; cB = nB; ++ui;
        if constexpr (ALIGN_EPI) { if (wr == 1) PG8_BAR; }
    }
    PG8_WAIT_V(0);
    if constexpr (!ALIGN_EPI) { if (wr == 0) PG8_BAR; }
    PG8_BAR;
    if constexpr (Epi::AFTER_DRAIN) { E.fused(acc, cur, wr, wc, fr, fq, lds, wid, lane); S.done(cur); }
#undef PG8_SA
#undef PG8_SB
#undef PG8_STAGE
#undef PG8_LDA
#undef PG8_LDB
#undef PG8_MMA
#undef PG8_WAIT_V
#undef PG8_WAIT_L
#undef PG8_BAR
#undef PG8_SCHED
}
}

constexpr int NWAVES = 8;
#ifndef MK_N_LAUNCHES
#define MK_N_LAUNCHES 1
#endif
constexpr int N_PHASES = 12;
constexpr int N_LAUNCHES = MK_N_LAUNCHES;
static_assert(N_LAUNCHES == 1 || N_LAUNCHES == N_PHASES, "MK_N_LAUNCHES is 1 or N_PHASES");

constexpr int DM = 4096, NB = 4, SEQ = 2048, CTXL = 256, ML = NB * SEQ, MC = NB * CTXL, MT = ML + MC;
constexpr int DFF = 16384, NMOD = 6 * DM;
constexpr int PK = DM + 64, PF = DFF + 64;
constexpr int NPW = 26656, NP = 26880;
constexpr int OFF_QM = 0, OFF_KM = 2048, OFF_VM = 4096, OFF_OM = 8192, OFF_QA = 12288, OFF_KA = 16384, OFF_VA = 17408, OFF_BGM = 18432, OFF_BGA = 22528, OFF_GM = 26624;
constexpr int MH = 8, DQK = 256, DV = 512, AH = 32, AKV = 8, AD = 128, WIN = 128;
constexpr float EPS = 1e-6f;

constexpr size_t MiB = 1u << 20;
constexpr size_t WS_CTL = 0, CTL_ZERO_BYTES = 1 * MiB;
constexpr size_t WS_MOD = 1 * MiB, WS_ROT = WS_MOD + 512 * 1024, WS_RS1 = WS_ROT + 64 * 1024;
constexpr size_t WS_WIN = 2 * MiB, WS_WOM = 216 * MiB, WS_WOA = 249 * MiB, WS_WO = 282 * MiB, WS_WF1 = 315 * MiB, WS_WF2 = 445 * MiB;
constexpr size_t WS_U = 574 * MiB;
constexpr size_t WS_P = 648 * MiB;
constexpr size_t WS_G = 1121 * MiB;
constexpr size_t WS_HM = 1123 * MiB, WS_AT = 1188 * MiB;
constexpr size_t WS_MIX = 1253 * MiB, WS_HB = 1381 * MiB;
constexpr int P8 = DM + 128;
constexpr int N8P = 24576;
constexpr size_t WS_U8 = 1445 * MiB, WS_W8G = 1483 * MiB, WS_W8F = 1582 * MiB, WS_U28 = WS_AT, WS_END = 1648 * MiB;
constexpr size_t WS_RSU = WS_ROT + 128 * 1024, WS_RS2 = WS_ROT + 192 * 1024, WS_CSG = WS_ROT + 224 * 1024, WS_CSF = WS_ROT + 320 * 1024;
constexpr size_t WS_HM8 = 130 * MiB, WS_AT8 = WS_U8;
constexpr size_t WS_W8OM = WS_HM, WS_W8OA = WS_HM + 17 * MiB, WS_END2 = WS_END;
constexpr size_t WS_RSHM = WS_ROT + 384 * 1024, WS_RSAT = WS_ROT + 416 * 1024, WS_CSOM = WS_ROT + 448 * 1024, WS_CSOA = WS_ROT + 464 * 1024, WS_CMAXO = 768 * 1024;
static_assert(WS_W8OM + (size_t)DM * P8 <= WS_W8OA && WS_W8OA + (size_t)DM * P8 <= WS_AT && WS_CSF + DFF * 4 <= WS_RSHM && WS_CSOA + DM * 4 <= WS_WIN && WS_CMAXO + 2 * DM * 4 <= CTL_ZERO_BYTES, "ws map int8 out");
constexpr size_t WS_W8O = WS_HM + 34 * MiB, WS_YG8 = WS_U8;
constexpr size_t WS_CSO = WS_ROT + 480 * 1024, WS_RSY = WS_MOD + 480 * 1024, WS_RMAXY = 832 * 1024;
static_assert(WS_W8O + (size_t)DM * P8 <= WS_AT && WS_CSO + DM * 4 <= WS_WIN && WS_RSY + ML * 4 <= WS_ROT && WS_RMAXY + ML * 4 <= CTL_ZERO_BYTES, "ws map int8 wo");
constexpr size_t WS_CMAXG = 256 * 1024, WS_CMAXF = 512 * 1024;
static_assert(WS_U8 + (size_t)MT * P8 <= WS_W8G && WS_W8G + (size_t)N8P * P8 <= WS_W8F && WS_CSG + N8P * 4 <= WS_CSF && WS_RS2 + ML * 4 <= WS_CSG && WS_RSU + MT * 4 <= WS_RS2 && WS_W8F + (size_t)DFF * P8 <= WS_END && WS_U28 + (size_t)ML * P8 <= WS_MIX && WS_CSF + DFF * 4 <= WS_WIN, "ws map int8");
constexpr size_t WS_HF = 2 * MiB, WS_T = 2 * MiB, WS_U2 = 130 * MiB;
constexpr size_t WS_YG = WS_U, WS_HDN = WS_P, WS_F = WS_MIX + 64 * MiB;
static_assert(WS_WIN + (size_t)NP * PK * 2 <= WS_WOM && WS_WOM + (size_t)DM * PK * 2 <= WS_WOA && WS_WOA + (size_t)DM * PK * 2 <= WS_WO && WS_WO + (size_t)DM * PK * 2 <= WS_WF1 && WS_WF1 + (size_t)DFF * PK * 2 <= WS_WF2 && WS_WF2 + (size_t)DM * PF * 2 <= WS_U, "ws map: weights");
static_assert(WS_U + (size_t)MT * PK * 2 <= WS_P && WS_P + (size_t)MT * NP * 2 <= WS_G && WS_G + (size_t)MT * 32 * 4 <= WS_HM && WS_HM + (size_t)ML * PK * 2 <= WS_AT && WS_AT + (size_t)ML * PK * 2 <= WS_MIX && WS_F + (size_t)ML * DM * 2 <= WS_HB && WS_HB + (size_t)ML * DM * 2 <= WS_END, "ws map");
static_assert(WS_T + (size_t)ML * DM * 4 <= WS_U2 && WS_U2 + (size_t)ML * PK * 2 <= WS_WOM && WS_HDN + (size_t)ML * PF * 2 <= WS_G && WS_YG + (size_t)ML * PK * 2 <= WS_P, "ws map overlays");
constexpr int CW_BAR = 4096;

constexpr int RING_OFF = 0, RING_BYTES = 131072;
constexpr int LDSCTL_OFF = RING_BYTES, MISC_OFF = LDSCTL_OFF + 320;
constexpr int LDS_BYTES = 147456;
static_assert(MISC_OFF + 128 <= LDS_BYTES, "LDS map");
#define GAS __attribute__((address_space(1)))
#define LAS __attribute__((address_space(3)))
typedef unsigned short bf16;
typedef unsigned v4u __attribute__((ext_vector_type(4)));
typedef float f32x4 __attribute__((ext_vector_type(4)));
typedef short bf16x8 __attribute__((ext_vector_type(8)));
typedef GAS unsigned gu32;
typedef GAS unsigned long long gu64;
#define RLX_AGENT __ATOMIC_RELAXED, __HIP_MEMORY_SCOPE_AGENT
#define LDS_WAIT() asm volatile("s_waitcnt lgkmcnt(0)" ::: "memory")
#define VM_WAIT() asm volatile("s_waitcnt vmcnt(0)" ::: "memory")
__device__ __forceinline__ unsigned long long rt() { return __builtin_amdgcn_s_memrealtime(); }
__device__ __forceinline__ unsigned f2bf(float f) { unsigned u = __builtin_bit_cast(unsigned, f); return (u + 0x7fffu + ((u >> 16) & 1u)) >> 16; }
typedef __bf16 pk2_bf2 __attribute__((ext_vector_type(2)));
typedef float pk2_f2 __attribute__((ext_vector_type(2)));
__device__ __forceinline__ unsigned pk2(float lo, float hi) { pk2_f2 v = {lo, hi}; return __builtin_bit_cast(unsigned, __builtin_convertvector(v, pk2_bf2)); }

#define XB_TMO      128
#define XB_XCNT(j)  (256  + 64 * (j))
#define XB_XSUB(j)  (1280 + 64 * (j))
#define XB_XGEN(j)  (2304 + 64 * (j))
#define XB_TOP      3328
#define XB_TOPGEN   3392
#define XCD_BAR_WORDS 3456
#define XB_SPIN_CAP (1u << 18)

__device__ __forceinline__ unsigned xb_ld(unsigned* p)              { return __hip_atomic_load(p, __ATOMIC_RELAXED, __HIP_MEMORY_SCOPE_AGENT); }
__device__ __forceinline__ unsigned xb_add(unsigned* p, unsigned v) { return __hip_atomic_fetch_add(p, v, __ATOMIC_RELAXED, __HIP_MEMORY_SCOPE_AGENT); }
__device__ __forceinline__ unsigned xb_xcc_id() { return (unsigned)__builtin_amdgcn_s_getreg((3 << 11) | 20) & 0xFu; }
#define XB_SPIN(cond, bar) do { unsigned _sp = 0; while (cond) { __builtin_amdgcn_s_sleep(1); \
    if ((++_sp & 255u) == 0u) { if (xb_ld(&(bar)[XB_TMO])) break; if (_sp > XB_SPIN_CAP) { atomicAdd(&(bar)[XB_TMO], 1u); break; } } } } while (0)

struct XcdBarrier {
    int wave;
    unsigned* bar; unsigned x;
    volatile LAS unsigned* st;
};

__device__ __forceinline__ bool xb_leader(int wave) { return wave == 0 && __builtin_amdgcn_mbcnt_hi(~0u, __builtin_amdgcn_mbcnt_lo(~0u, 0u)) == 0u; }
__device__ __forceinline__ XcdBarrier xcd_barrier_post(unsigned* bar, volatile LAS unsigned* st, int wave) {
    XcdBarrier b; b.wave = wave; b.bar = bar; b.x = xb_xcc_id(); b.st = st;
    if (xb_leader(wave)) (void)xb_add(&bar[XB_XCNT(b.x)], 1u);
    return b;
}
__device__ __forceinline__ void xcd_barrier_complete(unsigned* bar, unsigned x, unsigned& nloc, unsigned& nx) {
    const unsigned G = gridDim.x * gridDim.y * gridDim.z;
    unsigned sum, cnt, mine, sp = 0u;
    for (;;) {
        sum = 0u; cnt = 0u; mine = 0u;
#pragma unroll
        for (unsigned j = 0; j < 16; ++j) { const unsigned c = xb_ld(&bar[XB_XCNT(j)]); sum += c; cnt += (c > 0u) ? 1u : 0u; mine = (j == x) ? c : mine; }
        if (sum == G) break;
        __builtin_amdgcn_s_sleep(1);
        if ((++sp & 255u) == 0u) { if (xb_ld(&bar[XB_TMO])) break; if (sp > XB_SPIN_CAP) { atomicAdd(&bar[XB_TMO], 1u); break; } }
    }
    nloc = mine > 0u ? mine : 1u; nx = cnt > 0u ? cnt : 1u;
}

__device__ __forceinline__ void xcd_barrier(const XcdBarrier& b) {
    asm volatile("s_waitcnt vmcnt(0)" ::: "memory");
    __syncthreads();
    if (xb_leader(b.wave)) {
        unsigned* bar = b.bar;
        __builtin_amdgcn_s_waitcnt(0);
        unsigned nloc = b.st[0], nx = b.st[1];
        if (nloc == 0u) { xcd_barrier_complete(bar, b.x, nloc, nx); b.st[0] = nloc; b.st[1] = nx; }
        const unsigned old = xb_add(&bar[XB_XSUB(b.x)], 1u);
        const unsigned gen = old / nloc;
        if (old + 1u == (gen + 1u) * nloc) {
            __builtin_amdgcn_fence(__ATOMIC_RELEASE, "agent");
            asm volatile("s_waitcnt vmcnt(0)" ::: "memory");
            const unsigned og = xb_add(&bar[XB_TOP], 1u);
            const unsigned tg = og / nx;
            if (og + 1u == (tg + 1u) * nx) xb_add(&bar[XB_TOPGEN], 1u);
            else XB_SPIN(xb_ld(&bar[XB_TOPGEN]) == tg, bar);
            __builtin_amdgcn_fence(__ATOMIC_ACQUIRE, "agent");
            xb_add(&bar[XB_XGEN(b.x)], 1u);
            asm volatile("s_waitcnt vmcnt(0)" ::: "memory");
        } else {
            XB_SPIN(xb_ld(&bar[XB_XGEN(b.x)]) == gen, bar);
            __builtin_amdgcn_fence(__ATOMIC_ACQUIRE, "agent");
            asm volatile("s_waitcnt vmcnt(0)" ::: "memory");
        }
    }
    __syncthreads();
}

template <int CTRL> __device__ __forceinline__ float dppx(float v) { return __builtin_bit_cast(float, __builtin_amdgcn_update_dpp(0, __builtin_bit_cast(int, v), CTRL, 0xf, 0xf, true)); }
#define XSWAP(name, insn, comb) __device__ __forceinline__ float name(float x) { float a = x, b = x; asm("s_nop 1\n\t" insn " %0, %1" : "+v"(a), "+v"(b)); return comb; }
XSWAP(xsum16, "v_permlane16_swap_b32", a + b)
XSWAP(xsum32, "v_permlane32_swap_b32", a + b)
XSWAP(xmax16, "v_permlane16_swap_b32", fmaxf(a, b))
XSWAP(xmax32, "v_permlane32_swap_b32", fmaxf(a, b))
#undef XSWAP
__device__ __forceinline__ void rowbcast4(float x, float (&r)[4]) {
    float a = x, b = x; asm("s_nop 1\n\tv_permlane16_swap_b32 %0, %1" : "+v"(a), "+v"(b));
    float a0 = a, a2 = a; asm("s_nop 1\n\tv_permlane32_swap_b32 %0, %1" : "+v"(a0), "+v"(a2));
    float b1 = b, b3 = b; asm("s_nop 1\n\tv_permlane32_swap_b32 %0, %1" : "+v"(b1), "+v"(b3));
    r[0] = a0; r[1] = b1; r[2] = a2; r[3] = b3;
}
__device__ __forceinline__ float wave_sum(float v) {
    v += dppx<0xB1>(v); v += dppx<0x4E>(v); v += dppx<0x141>(v); v += dppx<0x140>(v);
    return xsum32(xsum16(v));
}
__device__ __forceinline__ float wave_max(float v) {
    v = fmaxf(v, dppx<0xB1>(v)); v = fmaxf(v, dppx<0x4E>(v)); v = fmaxf(v, dppx<0x141>(v)); v = fmaxf(v, dppx<0x140>(v));
    return xmax32(xmax16(v));
}
__device__ __forceinline__ float bf2f(bf16 b) { return __builtin_bit_cast(float, (unsigned)b << 16); }
__device__ __forceinline__ float bflo(unsigned w) { return __builtin_bit_cast(float, w << 16); }
typedef __bf16 bf16x2_d __attribute__((ext_vector_type(2)));
__device__ __forceinline__ float dot2bf(unsigned a, unsigned b, float c) { return __builtin_amdgcn_fdot2_f32_bf16(__builtin_bit_cast(bf16x2_d, a), __builtin_bit_cast(bf16x2_d, b), c, false); }
__device__ __forceinline__ float bfhi(unsigned w) { return __builtin_bit_cast(float, w & 0xffff0000u); }
__device__ __forceinline__ float sigm(float x) { return __builtin_amdgcn_rcpf(1.0f + __expf(-x)); }
__device__ __forceinline__ float logsig(float x) { return x < 0.f ? x - log1pf(expf(x)) : -log1pf(expf(-x)); }
__device__ __forceinline__ float logsig_fast(float x) { const float e = __expf(-fabsf(x)); return fminf(x, 0.f) - __logf(1.0f + e); }

#define BAR_LDS() do { asm volatile("s_waitcnt lgkmcnt(0)" ::: "memory"); __builtin_amdgcn_s_barrier(); asm volatile("" ::: "memory"); } while (0)
struct Args { const float* in[16]; float* out; unsigned char* ws; int ph_lo, ph_hi; };

__device__ __forceinline__ int win_map(int n0) { return n0 < 12288 ? n0 : (n0 < 12320 ? OFF_GM + (n0 - 12288) : n0 - 32); }


namespace ml {
typedef short s16x4 __attribute__((ext_vector_type(4)));
typedef short v4i16_t __attribute__((ext_vector_type(4)));
typedef unsigned v2u __attribute__((ext_vector_type(2)));
constexpr int QS = 528, KS = 544, VS = 288, S_PITCH = 144;
constexpr int Q_OFF = 0, K_OFF = Q_OFF + 64 * QS, V_OFF = K_OFF + 64 * KS, S_OFF = V_OFF + 64 * VS, NB_OFF = S_OFF + 64 * S_PITCH, NQ_OFF = NB_OFF + 1024, RS_OFF = NQ_OFF + 2048, WE_OFF = RS_OFF + 512, GG_OFF = WE_OFF + 256, MV_OFF = GG_OFF + 256, FAB_OFF = MV_OFF + 256;
static_assert(FAB_OFF + 8 * 512 <= 131072, "mLSTM LDS map");
__device__ __forceinline__ unsigned off_b(unsigned row, unsigned ch) { return 256u * row + 16u * (ch ^ (((row & 3u) << 2) | ((row >> 2) & 3u))); }
__device__ __forceinline__ unsigned rr16(unsigned lane, unsigned rb, unsigned s) { return off_b((lane & 15u) + 16u * rb, 4u * s + (lane >> 4)); }
__device__ __forceinline__ unsigned tr16(unsigned lane, unsigned c, unsigned ks, unsigned t) { const unsigned g = lane >> 4, q = (lane & 15u) >> 2, p = lane & 3u; return off_b(32u * ks + 8u * g + 4u * t + q, 2u * c + (p >> 1)) + 8u * (p & 1u); }
__device__ __forceinline__ s16x4 trd(LAS unsigned char* p) { return __builtin_bit_cast(s16x4, __builtin_amdgcn_ds_read_tr16_b64_v4i16((LAS v4i16_t*)p)); }
__device__ __forceinline__ bf16x8 cat8(s16x4 lo, s16x4 hi) { return __builtin_shufflevector(lo, hi, 0, 1, 2, 3, 4, 5, 6, 7); }
__device__ __forceinline__ unsigned cvtpk(float lo, float hi) { unsigned r; asm volatile("v_cvt_pk_bf16_f32 %0, %1, %2" : "=v"(r) : "v"(lo), "v"(hi)); return r; }
template <int CTRL, int ROWMASK> __device__ __forceinline__ float dppf(float old, float src) { return __builtin_bit_cast(float, __builtin_amdgcn_update_dpp(__builtin_bit_cast(int, old), __builtin_bit_cast(int, src), CTRL, ROWMASK, 0xf, false)); }
__device__ __forceinline__ float scan_add(float v) { v += dppf<0x111, 0xf>(0.f, v); v += dppf<0x112, 0xf>(0.f, v); v += dppf<0x114, 0xf>(0.f, v); v += dppf<0x118, 0xf>(0.f, v); v += dppf<0x142, 0xa>(0.f, v); v += dppf<0x143, 0xc>(0.f, v); return v; }
__device__ __forceinline__ float scan_max(float v) { const float ni = -INFINITY; v = fmaxf(v, dppf<0x111, 0xf>(ni, v)); v = fmaxf(v, dppf<0x112, 0xf>(ni, v)); v = fmaxf(v, dppf<0x114, 0xf>(ni, v)); v = fmaxf(v, dppf<0x118, 0xf>(ni, v)); v = fmaxf(v, dppf<0x142, 0xa>(ni, v)); v = fmaxf(v, dppf<0x143, 0xc>(ni, v)); return v; }
__device__ __forceinline__ int scan_row(int b, int dir, int st) { return st < CTXL ? ML + b * CTXL + (dir ? CTXL - 1 - st : st) : b * SEQ + (dir ? SEQ - 1 - (st - CTXL) : st - CTXL); }

__device__ __forceinline__ void mlstm_item(const Args& A, LAS unsigned char* lds, int tid_in, int lane_in, int wave, int item) {
    int tid = tid_in, lane = lane_in;
    const int vs = item & 3, dir = (item >> 2) & 1, h = (item >> 3) & 7, b = item >> 6;
    const bf16* P = (const bf16*)(A.ws + WS_P); const float* Gt = (const float*)(A.ws + WS_G);
    bf16* Hb = (bf16*)(A.ws + (dir ? WS_HB : WS_HF));
    const float bi = A.in[8][(2 * dir) * 8 + h], bfg = A.in[8][(2 * dir + 1) * 8 + h];
    LAS float* NBUF = (LAS float*)(lds + NB_OFF); LAS float* NQ = (LAS float*)(lds + NQ_OFF); LAS float* RS = (LAS float*)(lds + RS_OFF); LAS float* WE = (LAS float*)(lds + WE_OFF); LAS float* GGT = (LAS float*)(lds + GG_OFF); LAS float* MVT = (LAS float*)(lds + MV_OFF); LAS float* FAB = (LAS float*)(lds + FAB_OFF + wave * 512);
    { int t0 = tid_in; asm volatile("" : "+v"(t0)); if (t0 < 256) NBUF[t0] = 0.f; }
    asm volatile("" ::: "memory");
    f32x4 X[16];
#pragma unroll
    for (int i = 0; i < 16; ++i) X[i] = (f32x4){0.f, 0.f, 0.f, 0.f};
    float m = 0.f;
    const f32x4 z4 = (f32x4){0.f, 0.f, 0.f, 0.f};
    v4u pq[4], pk[4], pv[2]; float pgi, pgf;
    const int sgn = dir ? -1 : 1;
    const int goff_qk = sgn * (tid_in >> 5) * NP + h * DQK + (tid_in & 31) * 8, goff_v = sgn * (tid_in >> 4) * NP + OFF_VM + h * DV + vs * 128 + (tid_in & 15) * 8, goff_g = sgn * lane_in * 32 + (2 * dir) * 8 + h;
    const unsigned lds_q = (unsigned)(QS * (tid_in >> 5) + 16 * (tid_in & 31)), lds_k = (unsigned)(KS * (tid_in >> 5) + 64 * ((tid_in & 31) >> 2) + 8 * (tid_in & 3)), lds_v = (unsigned)(VS * (tid_in >> 4) + 16 * (tid_in & 15));
    const int hoff = sgn * (lane_in & 15) * DM + h * DV + vs * 128 + 16 * wave + 4 * (lane_in >> 4);
#define ML_LOAD(cc) do { const int row0_ = scan_row(b, dir, 64 * (cc)); const bf16* pb_ = P + (size_t)row0_ * NP; \
        _Pragma("unroll") for (int i = 0; i < 4; ++i) { pq[i] = *(const v4u*)(pb_ + (goff_qk + OFF_QM + sgn * 16 * i * NP)); pk[i] = *(const v4u*)(pb_ + (goff_qk + OFF_KM + sgn * 16 * i * NP)); } \
        _Pragma("unroll") for (int i = 0; i < 2; ++i) pv[i] = *(const v4u*)(pb_ + (goff_v + sgn * 32 * i * NP)); \
        { const float* gb_ = Gt + (size_t)row0_ * 32; pgi = gb_[goff_g]; pgf = gb_[goff_g + 8]; } } while (0)
#define ML_STORE() do { _Pragma("unroll") for (int i = 0; i < 4; ++i) { *(LAS v4u*)(lds + Q_OFF + lds_q + 16 * QS * i) = pq[i]; { v2u k0_, k1_; k0_.x = pk[i].x; k0_.y = pk[i].y; k1_.x = pk[i].z; k1_.y = pk[i].w; *(LAS v2u*)(lds + K_OFF + lds_k + 16 * KS * i) = k0_; *(LAS v2u*)(lds + K_OFF + lds_k + 16 * KS * i + 32) = k1_; } } \
        _Pragma("unroll") for (int i = 0; i < 2; ++i) *(LAS v4u*)(lds + V_OFF + lds_v + 32 * VS * i) = pv[i]; } while (0)
    ML_LOAD(0); ML_STORE();
#pragma unroll 1
    for (int c = 0; c < (CTXL + SEQ) / 64; ++c) {
        const bool latent = c >= CTXL / 64;
        { int lo_ = lane_in, to_ = tid_in; asm volatile("" : "+v"(lo_), "+v"(to_)); lane = lo_; tid = to_; }
        const unsigned q4 = (unsigned)lane >> 4, l15 = (unsigned)lane & 15u;
        const unsigned sperm = 16u * (q4 >> 1) + 4u * (q4 & 1u) + (l15 >> 2);
        LAS unsigned char* qacc = lds + Q_OFF + QS * l15 + 16u * q4;
        LAS unsigned char* qrow = lds + Q_OFF + QS * l15 + 32u * (q4 & 1u) + 8u * (q4 >> 1);
        LAS unsigned char* krow = lds + K_OFF + KS * l15 + 16u * q4;
        LAS unsigned char* ktr = lds + K_OFF + KS * sperm + 8u * (lane & 3);
        LAS unsigned char* vtr = lds + V_OFF + VS * sperm + 8u * (lane & 3) + 32u * wave;
        LAS unsigned char* srd = lds + S_OFF + S_PITCH * l15 + 32u * (q4 >> 1) + 16u * (q4 & 1u);
        const int wperm = 16 * (int)(q4 >> 1) + 4 * (int)(q4 & 1u);
        float bcs, gg, Mv;
        { const float ig = pgi + bi, lf = logsig_fast(pgf + bfg);
          bcs = scan_add(lf); gg = ig - bcs; Mv = fmaxf(m, scan_max(gg)); }
        const float bL = __builtin_bit_cast(float, __builtin_amdgcn_readlane(__builtin_bit_cast(int, bcs), 63)), M63 = __builtin_bit_cast(float, __builtin_amdgcn_readlane(__builtin_bit_cast(int, Mv), 63));
        const float decay = __expf(m - M63);
        if (wave == 0) { WE[lane] = __expf(gg - M63); GGT[lane] = gg * 1.4426950408889634f; MVT[lane] = Mv * 1.4426950408889634f; }
        BAR_LDS();
        if (c + 1 < (CTXL + SEQ) / 64) ML_LOAD(c + 1);
        f32x4 accI[4];
        if (latent) {
            bf16x8 nfrag; f32x4 accN[4];
            { const f32x4 n0 = *(const LAS f32x4*)(NBUF + 32 * wave + 4 * (int)q4), n1 = *(const LAS f32x4*)(NBUF + 32 * wave + 16 + 4 * (int)q4);
              v4u nb; nb.x = cvtpk(n0[0], n0[1]); nb.y = cvtpk(n0[2], n0[3]); nb.z = cvtpk(n1[0], n1[1]); nb.w = cvtpk(n1[2], n1[3]);
              nfrag = __builtin_bit_cast(bf16x8, nb); }
            const int tb = wave >> 1, sb0 = 2 * (wave & 1);
            f32x4 st0, st1;
            const int tl = 16 * tb + (int)l15; const float Mt = MVT[tl];
            const f32x4 gs0 = *(const LAS f32x4*)(GGT + 16 * sb0 + 4 * (int)q4), gs1 = *(const LAS f32x4*)(GGT + 16 * sb0 + 16 + 4 * (int)q4);
            st0 = z4; st1 = z4;
            if (sb0 + 1 <= tb) {
#pragma unroll
                for (int ks = 0; ks < 8; ++ks) {
                    const bf16x8 qb = cat8(*(const LAS s16x4*)(qrow + 16 * QS * tb + 64 * ks), *(const LAS s16x4*)(qrow + 16 * QS * tb + 64 * ks + 16));
                    const bf16x8 k0 = *(const LAS bf16x8*)(krow + 16 * KS * sb0 + 64 * ks), k1 = *(const LAS bf16x8*)(krow + 16 * KS * (sb0 + 1) + 64 * ks);
                    st0 = __builtin_amdgcn_mfma_f32_16x16x32_bf16(k0, qb, st0, 0, 0, 0); st1 = __builtin_amdgcn_mfma_f32_16x16x32_bf16(k1, qb, st1, 0, 0, 0); }
            } else if (sb0 <= tb) {
#pragma unroll
                for (int ks = 0; ks < 8; ++ks) {
                    const bf16x8 qb = cat8(*(const LAS s16x4*)(qrow + 16 * QS * tb + 64 * ks), *(const LAS s16x4*)(qrow + 16 * QS * tb + 64 * ks + 16));
                    const bf16x8 k0 = *(const LAS bf16x8*)(krow + 16 * KS * sb0 + 64 * ks);
                    st0 = __builtin_amdgcn_mfma_f32_16x16x32_bf16(k0, qb, st0, 0, 0, 0); }
            }
            float rs = 0.f;
#pragma unroll
            for (int r = 0; r < 4; ++r) { const int s0 = 16 * sb0 + 4 * (int)q4 + r, s1 = s0 + 16;
                st0[r] = s0 <= tl ? st0[r] * __builtin_amdgcn_exp2f(gs0[r] - Mt) : 0.f; st1[r] = s1 <= tl ? st1[r] * __builtin_amdgcn_exp2f(gs1[r] - Mt) : 0.f; rs += st0[r] + st1[r]; }
            rs = xsum32(xsum16(rs));
            if (q4 == 0) RS[(wave & 1) * 64 + tl] = rs;
            { v2u w0, w1; w0.x = cvtpk(st0[0], st0[1]); w0.y = cvtpk(st0[2], st0[3]); w1.x = cvtpk(st1[0], st1[1]); w1.y = cvtpk(st1[2], st1[3]);
              const int pq_ = (int)(((q4 & 1u) << 1) | (q4 >> 1));
              *(LAS v2u*)(lds + S_OFF + tl * S_PITCH + 32 * sb0 + 8 * pq_) = w0; *(LAS v2u*)(lds + S_OFF + tl * S_PITCH + 32 * sb0 + 32 + 8 * pq_) = w1; }
            { const unsigned qb0 = (unsigned)(size_t)qacc, qb1 = qb0 + 16 * QS, qb2 = qb0 + 32 * QS, qb3 = qb0 + 48 * QS;
              bf16x8 fa0, fa1, fa2, fa3, fb0, fb1, fb2, fb3;
#define ML_RD4(f0, f1, f2, f3, kp) do { asm volatile("ds_read_b128 %0, %4 offset:%8\n\tds_read_b128 %1, %5 offset:%8\n\tds_read_b128 %2, %6 offset:%8\n\tds_read_b128 %3, %7 offset:%8" \
                  : "=&v"(f0), "=&v"(f1), "=&v"(f2), "=&v"(f3) : "v"(qb0), "v"(qb1), "v"(qb2), "v"(qb3), "n"(64 * (kp)) : "memory"); } while (0)
#define ML_WT4(f0, f1, f2, f3, n) asm volatile("s_waitcnt lgkmcnt(" #n ")" : "+v"(f0), "+v"(f1), "+v"(f2), "+v"(f3))
#define ML_MM4(f0, f1, f2, f3, kp) do { v4u xb; xb.x = cvtpk(X[2 * (kp)][0], X[2 * (kp)][1]); xb.y = cvtpk(X[2 * (kp)][2], X[2 * (kp)][3]); xb.z = cvtpk(X[2 * (kp) + 1][0], X[2 * (kp) + 1][1]); xb.w = cvtpk(X[2 * (kp) + 1][2], X[2 * (kp) + 1][3]); \
                  const bf16x8 xf = __builtin_bit_cast(bf16x8, xb); \
                  accI[0] = __builtin_amdgcn_mfma_f32_16x16x32_bf16(xf, f0, (kp) ? accI[0] : z4, 0, 0, 0); accI[1] = __builtin_amdgcn_mfma_f32_16x16x32_bf16(xf, f1, (kp) ? accI[1] : z4, 0, 0, 0); \
                  accI[2] = __builtin_amdgcn_mfma_f32_16x16x32_bf16(xf, f2, (kp) ? accI[2] : z4, 0, 0, 0); accI[3] = __builtin_amdgcn_mfma_f32_16x16x32_bf16(xf, f3, (kp) ? accI[3] : z4, 0, 0, 0); \
                  if (wave == (kp)) { accN[0] = __builtin_amdgcn_mfma_f32_16x16x32_bf16(nfrag, f0, z4, 0, 0, 0); accN[1] = __builtin_amdgcn_mfma_f32_16x16x32_bf16(nfrag, f1, z4, 0, 0, 0); \
                      accN[2] = __builtin_amdgcn_mfma_f32_16x16x32_bf16(nfrag, f2, z4, 0, 0, 0); accN[3] = __builtin_amdgcn_mfma_f32_16x16x32_bf16(nfrag, f3, z4, 0, 0, 0); } } while (0)
              asm volatile("s_waitcnt lgkmcnt(0)" ::: "memory");
              ML_RD4(fa0, fa1, fa2, fa3, 0);
              ML_RD4(fb0, fb1, fb2, fb3, 1); ML_WT4(fa0, fa1, fa2, fa3, 4); ML_MM4(fa0, fa1, fa2, fa3, 0);
              ML_RD4(fa0, fa1, fa2, fa3, 2); ML_WT4(fb0, fb1, fb2, fb3, 4); ML_MM4(fb0, fb1, fb2, fb3, 1);
              ML_RD4(fb0, fb1, fb2, fb3, 3); ML_WT4(fa0, fa1, fa2, fa3, 4); ML_MM4(fa0, fa1, fa2, fa3, 2);
              ML_RD4(fa0, fa1, fa2, fa3, 4); ML_WT4(fb0, fb1, fb2, fb3, 4); ML_MM4(fb0, fb1, fb2, fb3, 3);
              ML_RD4(fb0, fb1, fb2, fb3, 5); ML_WT4(fa0, fa1, fa2, fa3, 4); ML_MM4(fa0, fa1, fa2, fa3, 4);
              ML_RD4(fa0, fa1, fa2, fa3, 6); ML_WT4(fb0, fb1, fb2, fb3, 4); ML_MM4(fb0, fb1, fb2, fb3, 5);
              ML_RD4(fb0, fb1, fb2, fb3, 7); ML_WT4(fa0, fa1, fa2, fa3, 4); ML_MM4(fa0, fa1, fa2, fa3, 6);
              ML_WT4(fb0, fb1, fb2, fb3, 0); ML_MM4(fb0, fb1, fb2, fb3, 7);
#undef ML_RD4
#undef ML_WT4
#undef ML_MM4
            }
            if (q4 == 0) {
#pragma unroll
                for (int tt = 0; tt < 4; ++tt) NQ[wave * 64 + 16 * tt + (int)l15] = accN[tt][0]; }
        }
        bf16x8 vf[2], vw[2]; f32x4 wA[2], wB[2];
#pragma unroll
        for (int ks = 0; ks < 2; ++ks) { const s16x4 lo = trd(vtr + VS * (32 * ks)), hi = trd(vtr + VS * (32 * ks + 8)); vf[ks] = cat8(lo, hi);
            wA[ks] = *(const LAS f32x4*)(WE + 32 * ks + wperm); wB[ks] = *(const LAS f32x4*)(WE + 32 * ks + wperm + 8); const f32x4 w0 = wA[ks], w1 = wB[ks];
            const v4u vu = __builtin_bit_cast(v4u, vf[ks]); v4u o;
            o.x = cvtpk(bflo(vu.x) * w0[0], bfhi(vu.x) * w0[1]); o.y = cvtpk(bflo(vu.y) * w0[2], bfhi(vu.y) * w0[3]);
            o.z = cvtpk(bflo(vu.z) * w1[0], bfhi(vu.z) * w1[1]); o.w = cvtpk(bflo(vu.w) * w1[2], bfhi(vu.w) * w1[3]);
            vw[ks] = __builtin_bit_cast(bf16x8, o); }
        { float na[2]; v4u wq[2];
#pragma unroll
          for (int ks = 0; ks < 2; ++ks) { wq[ks].x = cvtpk(wA[ks][0], wA[ks][1]); wq[ks].y = cvtpk(wA[ks][2], wA[ks][3]); wq[ks].z = cvtpk(wB[ks][0], wB[ks][1]); wq[ks].w = cvtpk(wB[ks][2], wB[ks][3]); }
#pragma unroll
          for (int e = 0; e < 2; ++e) { LAS unsigned char* kp_ = ktr + 64u * wave + 32 * e; float a = 0.f;
#pragma unroll
              for (int ks = 0; ks < 2; ++ks) { const v4u ku = __builtin_bit_cast(v4u, cat8(trd(kp_ + KS * (32 * ks)), trd(kp_ + KS * (32 * ks + 8))));
                  a = dot2bf(ku.x, wq[ks].x, a); a = dot2bf(ku.y, wq[ks].y, a); a = dot2bf(ku.z, wq[ks].z, a); a = dot2bf(ku.w, wq[ks].w, a); }
              na[e] = xsum32(xsum16(a)); }
          if (q4 == 0) { const int d0 = 32 * wave + (int)l15; NBUF[d0] = decay * NBUF[d0] + na[0]; NBUF[d0 + 16] = decay * NBUF[d0 + 16] + na[1]; } }
        { s16x4 kA[4][2][2], kB[4][2][2];
#define ML_KRD(buf, ig) _Pragma("unroll") for (int i4 = 0; i4 < 4; ++i4) { _Pragma("unroll") for (int ks = 0; ks < 2; ++ks) { \
            buf[i4][ks][0] = trd(ktr + KS * (32 * ks) + 32 * (4 * (ig) + i4)); buf[i4][ks][1] = trd(ktr + KS * (32 * ks + 8) + 32 * (4 * (ig) + i4)); } }
#define ML_KMM(buf, ig) _Pragma("unroll") for (int i4 = 0; i4 < 4; ++i4) { const int i = 4 * (ig) + i4; X[i] *= decay; \
            _Pragma("unroll") for (int ks = 0; ks < 2; ++ks) X[i] = __builtin_amdgcn_mfma_f32_16x16x32_bf16(cat8(buf[i4][ks][0], buf[i4][ks][1]), vw[ks], X[i], 0, 0, 0); }
          ML_KRD(kA, 0) ML_KRD(kB, 1) ML_KMM(kA, 0) ML_KRD(kA, 2) ML_KMM(kB, 1) ML_KRD(kB, 3) ML_KMM(kA, 2) ML_KMM(kB, 3)
#undef ML_KRD
#undef ML_KMM
        }
        if (latent) {
            BAR_LDS();
            bf16x8 sa0[4], sa1[2]; float nqv[8];
#pragma unroll
            for (int tt = 0; tt < 4; ++tt) sa0[tt] = *(const LAS bf16x8*)(srd + 16 * S_PITCH * tt);
#pragma unroll
            for (int tt = 2; tt < 4; ++tt) sa1[tt - 2] = *(const LAS bf16x8*)(srd + 16 * S_PITCH * tt + 64);
#pragma unroll
            for (int w = 0; w < 8; ++w) nqv[w] = NQ[w * 64 + lane];
            const float rs0 = RS[lane], rs1 = RS[64 + lane];
            if (c + 1 < (CTXL + SEQ) / 64) ML_STORE();
            float FA, FB;
            { const float nq = ((nqv[0] + nqv[1]) + (nqv[2] + nqv[3])) + ((nqv[4] + nqv[5]) + (nqv[6] + nqv[7]));
              const float inter = __expf(m - Mv), den = inter * nq + rs0 + rs1;
              FB = __builtin_amdgcn_rcpf(fmaxf(fabsf(den), __expf(-(bcs + Mv)))); FA = inter * FB; }
            f32x4 accS[4];
#pragma unroll
            for (int tt = 0; tt < 4; ++tt) {
                accS[tt] = __builtin_amdgcn_mfma_f32_16x16x32_bf16(vf[0], sa0[tt], z4, 0, 0, 0);
                if (tt >= 2) accS[tt] = __builtin_amdgcn_mfma_f32_16x16x32_bf16(vf[1], sa1[tt - 2], accS[tt], 0, 0, 0); }
            bf16* hb_ = Hb + (size_t)scan_row(b, dir, 64 * c) * DM; float fav[4], fbv[4]; rowbcast4(FA, fav); rowbcast4(FB, fbv);
#pragma unroll
            for (int tt = 0; tt < 4; ++tt) { const float fa = fav[tt], fb = fbv[tt];
                v2u w; w.x = cvtpk(fa * accI[tt][0] + fb * accS[tt][0], fa * accI[tt][1] + fb * accS[tt][1]); w.y = cvtpk(fa * accI[tt][2] + fb * accS[tt][2], fa * accI[tt][3] + fb * accS[tt][3]);
                *(v2u*)(hb_ + (hoff + sgn * 16 * tt * DM)) = w; }
        } else {
            BAR_LDS();
            if (c + 1 < (CTXL + SEQ) / 64) ML_STORE();
        }
        m = bL + M63;
    }
#undef ML_LOAD
#undef ML_STORE
    BAR_LDS();
}
}


namespace at {
typedef float f32x16 __attribute__((ext_vector_type(16)));
typedef __bf16 bf16x2_t __attribute__((ext_vector_type(2)));
typedef float f32x2_t __attribute__((ext_vector_type(2)));
constexpr int KSTR = 272, VSTR = 320, VOFF = 64 * KSTR, BUFSZ = 64 * KSTR + 64 * VSTR;
__device__ __forceinline__ float max3f(float a, float b, float c) { float r; asm("v_max3_f32 %0, %1, %2, %3" : "=v"(r) : "v"(a), "v"(b), "v"(c)); return r; }
__device__ __forceinline__ unsigned cvt2(float lo, float hi) { f32x2_t v = {lo, hi}; bf16x2_t b = __builtin_convertvector(v, bf16x2_t); return __builtin_bit_cast(unsigned, b); }
__device__ __forceinline__ bf16x8 pack_step(const f32x16& x, int s) { v4u p; p.x = cvt2(x[8 * s], x[8 * s + 1]); p.y = cvt2(x[8 * s + 2], x[8 * s + 3]); p.z = cvt2(x[8 * s + 4], x[8 * s + 5]); p.w = cvt2(x[8 * s + 6], x[8 * s + 7]); return __builtin_bit_cast(bf16x8, p); }

struct TagT { static constexpr bool v = true; }; struct TagF { static constexpr bool v = false; };
__device__ __forceinline__ void attn_items(const Args& A, LAS unsigned char* lds, int tid_in, int lane_in, int wave, int G) {
    constexpr int NIT = NB * AKV * (SEQ / 64);
    int item = blockIdx.x;
    if (item >= NIT) return;
    constexpr bool late = false;
    const bf16* P = (const bf16*)(A.ws + WS_P); bf16* AT = (bf16*)(A.ws + WS_AT);
    int lane = lane_in, tid = tid_in;
    { asm volatile("" : "+v"(lane), "+v"(tid)); }
    const int l31 = lane & 31, hh = lane >> 5;
    const float cl2 = 0.08838834764831845f * 1.4426950408889634f;
    bf16x8 qf[8], qn[8]; v4u pk[2], pv[2];
#define AT_GEOM(it, b_, hkv_, hq_, q0_, qw_, ks_, nwt_) const int b_ = (it) >> 8, hkv_ = ((it) >> 5) & 7, hq_ = hkv_ * 4 + (wave & 3), q0_ = 64 * ((it) & 31), qw_ = q0_ + 32 * (wave >> 2), \
        ks_ = q0_ - WIN < 0 ? 0 : q0_ - WIN, nwt_ = ((q0_ + 64 + WIN > SEQ ? SEQ : q0_ + 64 + WIN) - ks_) >> 6
#define AT_QLOAD(qd, b_, qw_, hq_) do { const bf16* qp_ = P + (size_t)((b_) * SEQ + (qw_) + l31) * NP + OFF_QA + (hq_) * AD + 8 * hh; \
        _Pragma("unroll") for (int ks = 0; ks < 8; ++ks) qd[ks] = *(const bf16x8*)(qp_ + 16 * ks); } while (0)
#define AT_LOAD(b_, hkv_, ks_, nwt_, i) do { const int r0_ = (i) < (nwt_) ? (b_) * SEQ + (ks_) + 64 * (i) : ML + (b_) * CTXL + 64 * ((i) - (nwt_)); \
        const char* gb_ = (const char*)(P + (size_t)r0_ * NP + (hkv_) * AD + OFF_KA);     \
        pk[0] = *(const v4u*)(gb_ + aoff); pv[0] = *(const v4u*)(gb_ + aoff + 2 * (OFF_VA - OFF_KA)); \
        pk[1] = *(const v4u*)(gb_ + 64 * NP + aoff); pv[1] = *(const v4u*)(gb_ + 64 * NP + aoff + 2 * (OFF_VA - OFF_KA)); } while (0)
#define AT_STORE(bufo) do { _Pragma("unroll") for (int j = 0; j < 2; ++j) { const int idx = tid + 512 * j; \
            *(LAS v4u*)(lds + (unsigned)(bufo) + KSTR * (idx >> 4) + 16 * (idx & 15)) = pk[j]; *(LAS v4u*)(lds + (unsigned)(bufo) + VOFF + VSTR * (idx >> 4) + 16 * (idx & 15)) = pv[j]; } } while (0)
#define AT_PV(Vb) do { LAS unsigned char* vp_ = (Vb) + vbase; _Pragma("unroll") for (int f = 0; f < 4; ++f) { _Pragma("unroll") for (int d = 0; d < 4; ++d) { \
            const ml::s16x4 lo = ml::trd(vp_ + VSTR * (16 * f) + 64 * d), hi = ml::trd(vp_ + VSTR * (16 * f + 8) + 64 * d);     \
            O[d] = __builtin_amdgcn_mfma_f32_32x32x16_bf16(ml::cat8(lo, hi), pb[f], O[d], 0, 0, 0); } } } while (0)
    const unsigned kbase = (unsigned)(KSTR * l31 + 16 * hh), vbase = (unsigned)(VSTR * (4 * hh + ((lane & 15) >> 2)) + 32 * ((lane >> 4) & 1) + 8 * (lane & 3));
    int cb, chkv, chq, cq0, cqw, cks, cnwt;
    { AT_GEOM(item, b0, hkv0, hq0, q00, qw0, ks0, nwt0); cb = b0; chkv = hkv0; chq = hq0; cq0 = q00; cqw = qw0; cks = ks0; cnwt = nwt0; }
    unsigned aoff = 2u * (unsigned)((tid >> 4) * NP + (tid & 15) * 8);
    int tidl = tid;
    AT_LOAD(cb, chkv, cks, cnwt, 0); AT_QLOAD(qf, cb, cqw, chq);
    AT_STORE(0);
    asm volatile("" : "+v"(qf[0]), "+v"(qf[1]), "+v"(qf[2]), "+v"(qf[3]), "+v"(qf[4]), "+v"(qf[5]), "+v"(qf[6]), "+v"(qf[7]));
#pragma unroll
    for (int ks = 0; ks < 8; ++ks) qn[ks] = qf[ks];
#pragma unroll 1
    for (;;) {
        const int b = cb, hkv = chkv, hq = chq, q0 = cq0, qw = cqw, kstart = cks, nwt = cnwt, nt = nwt + CTXL / 64;
        const int nxt = item + G; const bool more = nxt < NIT;
        AT_GEOM(more ? nxt : item, nb, nhkv, nhq, nq0, nqw, nks, nnwt);
        asm volatile("" : "+v"(tidl));
        aoff = 2u * (unsigned)((tidl >> 4) * NP + (tidl & 15) * 8);
        float m = A.in[10][hq] * 1.4426950408889634f, l = hh == 0 ? 1.0f : 0.0f;
        f32x16 O[4];
#pragma unroll
        for (int d = 0; d < 4; ++d)
#pragma unroll
            for (int r = 0; r < 16; ++r) O[d][r] = 0.f;
        bf16x8 pb[4];
        int bo = 0, bprev = 0;
        auto trip = [&](const int i, auto last) {
            const int bo1 = bo == 2 * BUFSZ ? 0 : bo + BUFSZ;
            BAR_LDS();
            if (!decltype(last)::v) AT_LOAD(b, hkv, kstart, nwt, i + 1); else if (more) { AT_LOAD(nb, nhkv, nks, nnwt, 0); AT_QLOAD(qn, nb, nqw, nhq); }
            if (late && i > 0) AT_PV(lds + bprev + VOFF);
            LAS unsigned char* Kb = lds + bo + kbase;
            f32x16 S0, S1;
            { const f32x16 z16 = {0.f, 0.f, 0.f, 0.f, 0.f, 0.f, 0.f, 0.f, 0.f, 0.f, 0.f, 0.f, 0.f, 0.f, 0.f, 0.f};
              S0 = __builtin_amdgcn_mfma_f32_32x32x16_bf16(*(const LAS bf16x8*)(Kb), qf[0], z16, 0, 0, 0); S1 = __builtin_amdgcn_mfma_f32_32x32x16_bf16(*(const LAS bf16x8*)(Kb + 32 * KSTR), qf[0], z16, 0, 0, 0); }
#pragma unroll
            for (int ks = 1; ks < 8; ++ks) { const bf16x8 k0 = *(const LAS bf16x8*)(Kb + 32 * ks), k1 = *(const LAS bf16x8*)(Kb + 32 * KSTR + 32 * ks);
                S0 = __builtin_amdgcn_mfma_f32_32x32x16_bf16(k0, qf[ks], S0, 0, 0, 0); S1 = __builtin_amdgcn_mfma_f32_32x32x16_bf16(k1, qf[ks], S1, 0, 0, 0); }
            float mx = -INFINITY;
            if (i < nwt && (kstart + 64 * i + WIN == q0 || kstart + 64 * i == q0 + WIN)) {
                const int dlt = kstart + 64 * i + 4 * hh - (qw + l31);
#pragma unroll
                for (int r = 0; r < 16; ++r) { const int d0 = dlt + (r & 3) + 8 * (r >> 2), d1 = d0 + 32;
                    S0[r] = (d0 >= -WIN && d0 <= WIN) ? S0[r] : -INFINITY; S1[r] = (d1 >= -WIN && d1 <= WIN) ? S1[r] : -INFINITY; } }
#pragma unroll
            for (int r = 0; r < 16; ++r) mx = max3f(mx, S0[r], S1[r]);
            mx = xmax32(mx);
            if (!__all(mx * cl2 - m <= 8.0f)) { const float mn = fmaxf(m, mx * cl2), alpha = __builtin_amdgcn_exp2f(m - mn); m = mn; l *= alpha;
#pragma unroll
                for (int d = 0; d < 4; ++d)
#pragma unroll
                    for (int r = 0; r < 16; ++r) O[d][r] *= alpha; }
            float ls = 0.f;
#pragma unroll
            for (int r = 0; r < 16; ++r) { S0[r] = __builtin_amdgcn_exp2f(S0[r] * cl2 - m); S1[r] = __builtin_amdgcn_exp2f(S1[r] * cl2 - m); ls += S0[r] + S1[r]; }
            l += ls;
            pb[0] = pack_step(S0, 0); pb[1] = pack_step(S0, 1); pb[2] = pack_step(S1, 0); pb[3] = pack_step(S1, 1);
            if (!late) AT_PV(lds + bo + VOFF);
            if (!decltype(last)::v) AT_STORE(bo1);
            bprev = bo; bo = bo1;
        };
#pragma unroll 1
        for (int i = 0; i + 1 < nt; ++i) trip(i, TagF{});
        trip(nt - 1, TagT{});
        if (late) AT_PV(lds + bprev + VOFF);
        BAR_LDS();
        if (more) AT_STORE(0);
        const float inv = __builtin_amdgcn_rcpf(xsum32(l));
        int l2 = lane; asm volatile("" : "+v"(l2));
        bf16* op = AT + (size_t)(b * SEQ + qw + (l2 & 31)) * PK + hq * AD + 4 * (l2 >> 5);
#pragma unroll
        for (int d = 0; d < 4; ++d)
#pragma unroll
            for (int g = 0; g < 4; ++g) { ml::v2u w; w.x = cvt2(O[d][4 * g] * inv, O[d][4 * g + 1] * inv); w.y = cvt2(O[d][4 * g + 2] * inv, O[d][4 * g + 3] * inv);
                *(ml::v2u*)(op + 32 * d + 8 * g) = w; }
        if (!more) break;
#pragma unroll
        for (int ks = 0; ks < 8; ++ks) qf[ks] = qn[ks];
        item = nxt; cb = nb; chkv = nhkv; chq = nhq; cq0 = nq0; cqw = nqw; cks = nks; cnwt = nnwt;
    }
#undef AT_GEOM
#undef AT_QLOAD
#undef AT_LOAD
#undef AT_STORE
#undef AT_PV
    BAR_LDS();
}
}

__device__ __forceinline__ unsigned q4(float a, float b, float c, float d) {
    const float M = 12582912.0f;
    const unsigned ua = __builtin_bit_cast(unsigned, a + M), ub = __builtin_bit_cast(unsigned, b + M), uc = __builtin_bit_cast(unsigned, c + M), ud = __builtin_bit_cast(unsigned, d + M);
    const unsigned lo = __builtin_amdgcn_perm(ub, ua, 0x0c0c0400u), hi = __builtin_amdgcn_perm(ud, uc, 0x0c0c0400u);
    return __builtin_amdgcn_perm(hi, lo, 0x05040100u); }
struct TItem { const float* src; bf16* dst; int N, K; };
constexpr int P0_NB_IN = 129, P0_I_IN = (DM / 64) * P0_NB_IN, P0_NSMALL = P0_I_IN + (DFF / 64) * (DM / 32);
__device__ __forceinline__ TItem p0_item(const Args& A, int it, int lane) {
    unsigned char* ws = A.ws; const float* W; bf16* WT; int N, K, kb, nb; bool remap = false; int r = it;
    if (r < P0_I_IN) { W = A.in[7]; WT = (bf16*)(ws + WS_WIN); N = NPW; K = DM; remap = true; kb = r / P0_NB_IN; nb = r - kb * P0_NB_IN; if (nb == 128) nb = 12288 / 32; }
    else { r -= P0_I_IN; W = A.in[15]; WT = (bf16*)(ws + WS_WF2); N = DM; K = DFF; kb = r >> 7; nb = r & 127; }
    const int k0 = 64 * kb, n0 = 32 * nb, d0 = remap ? win_map(n0) : n0;
    TItem t; t.src = W + (size_t)(k0 + (lane >> 5)) * N + n0 + (lane & 31); t.dst = WT + (size_t)d0 * (K + 64) + k0; t.N = N; t.K = K + 64; return t;
}
__device__ __forceinline__ void p0_load(const TItem& t, float (&wv)[32]) {
#pragma unroll
    for (int i = 0; i < 32; ++i) wv[i] = __builtin_nontemporal_load(t.src + (size_t)(2 * i) * t.N);
}
__device__ __forceinline__ void p0_emit(const TItem& t, const float (&wv)[32], LAS float* scr, int lane) {
#pragma unroll
    for (int i = 0; i < 32; ++i) scr[(2 * i + (lane >> 5)) * 33 + (lane & 31)] = wv[i];
    LDS_WAIT(); asm volatile("" ::: "memory");
    const int c = lane & 7;
#pragma unroll
    for (int j = 0; j < 4; ++j) { const int n = (lane >> 3) + 8 * j; const LAS float* s = scr + (8 * c) * 33 + n;
        v4u o; o.x = pk2(s[0 * 33], s[1 * 33]); o.y = pk2(s[2 * 33], s[3 * 33]); o.z = pk2(s[4 * 33], s[5 * 33]); o.w = pk2(s[6 * 33], s[7 * 33]);
        *(GAS v4u*)(t.dst + (size_t)n * t.K + 8 * c) = o; }
    LDS_WAIT(); asm volatile("" ::: "memory");
}
constexpr int P0_NBIG_IN = 704, P0_NBIG = P0_NBIG_IN + 3 * (DM / 32) + DFF / 32;
struct BigItem { const char* W; unsigned char* dst; float* cs; int N, n0, rbase; bool rot; };
__device__ __forceinline__ BigItem p0_big_item(const Args& A, int item) {
    unsigned char* ws = A.ws; BigItem t; t.rot = false;
    if (item < P0_NBIG_IN) { t.W = (const char*)A.in[7]; t.N = NPW; t.n0 = item < 256 ? OFF_VM + 32 * item : 12320 + 32 * (item - 256); const int d0 = win_map(t.n0); t.rot = d0 >= OFF_QA && d0 < OFF_VA;
        t.rbase = (t.rot ? (d0 & ~63) + ((d0 & 32) ? 4 : 0) : d0) - OFF_KM; t.dst = ws + WS_W8G; t.cs = (float*)(ws + WS_CSG); }
    else if (item < P0_NBIG_IN + 128) { t.W = (const char*)A.in[11]; t.N = DM; t.n0 = 32 * (item - P0_NBIG_IN); t.rbase = t.n0; t.dst = ws + WS_W8OM; t.cs = (float*)(ws + WS_CSOM); }
    else if (item < P0_NBIG_IN + 256) { t.W = (const char*)A.in[12]; t.N = DM; t.n0 = 32 * (item - P0_NBIG_IN - 128); t.rbase = t.n0; t.dst = ws + WS_W8OA; t.cs = (float*)(ws + WS_CSOA); }
    else if (item < P0_NBIG_IN + 384) { t.W = (const char*)A.in[13]; t.N = DM; t.n0 = 32 * (item - P0_NBIG_IN - 256); t.rbase = t.n0; t.dst = ws + WS_W8O; t.cs = (float*)(ws + WS_CSO); }
    else { t.W = (const char*)A.in[14]; t.N = DFF; t.n0 = 32 * (item - P0_NBIG_IN - 384); t.rbase = t.n0; t.dst = ws + WS_W8F; t.cs = (float*)(ws + WS_CSF); }
    return t;
}
__device__ __forceinline__ unsigned p0_big_voff(const BigItem& t, int wave) {
    int t1; asm volatile("v_mbcnt_lo_u32_b32 %0, -1, 0\n\tv_mbcnt_hi_u32_b32 %0, -1, %0" : "=v"(t1)); t1 += wave * 64;
    return (unsigned)((64 * (t1 >> 3)) * t.N + t.n0 + 4 * (t1 & 7)) * 4u;
}
__device__ __forceinline__ void p0_bigs(const Args& A, LAS unsigned char* lds, int wave, int G) {
    int item = blockIdx.x;
    if (item >= P0_NBIG) return;
    BigItem cur = p0_big_item(A, item);
    unsigned voff = p0_big_voff(cur, wave);
    f32x4 ta[8], tb[8];
#define P0B_LD(t, b, it) _Pragma("unroll") for (int u = 0; u < 8; ++u) t[u] = __builtin_nontemporal_load((const f32x4*)((it).W + (size_t)(8 * (b) + u) * (size_t)(4 * (it).N) + voff));
#define P0B_CV(t, b) _Pragma("unroll") for (int u = 0; u < 8; ++u) { const int p = 8 * (b) + u; d[2 * p] = at::cvt2(t[u].x, t[u].y); d[2 * p + 1] = at::cvt2(t[u].z, t[u].w); \
        a0 = fmaxf(a0, fabsf(t[u].x)); a1 = fmaxf(a1, fabsf(t[u].y)); a2 = fmaxf(a2, fabsf(t[u].z)); a3 = fmaxf(a3, fabsf(t[u].w)); \
        asm volatile("" : "+v"(d[2 * p]), "+v"(d[2 * p + 1]), "+v"(a0), "+v"(a1), "+v"(a2), "+v"(a3)); }
    P0B_LD(ta, 0, cur) P0B_LD(tb, 1, cur)
    for (;;) {
        unsigned d[128]; float a0 = 0.f, a1 = 0.f, a2 = 0.f, a3 = 0.f;
        __builtin_amdgcn_sched_barrier(0);
#pragma unroll
        for (int b = 0; b < 8; b += 2) {
            P0B_CV(ta, b) __builtin_amdgcn_sched_barrier(0);
            if (b + 2 < 8) { P0B_LD(ta, b + 2, cur) } __builtin_amdgcn_sched_barrier(0);
            P0B_CV(tb, b + 1) __builtin_amdgcn_sched_barrier(0);
            if (b + 3 < 8) { P0B_LD(tb, b + 3, cur) } __builtin_amdgcn_sched_barrier(0);
        }
        const int nxt = item + G; const bool more = nxt < P0_NBIG;
        const BigItem nx = p0_big_item(A, more ? nxt : item);
        if (more) { voff = p0_big_voff(nx, wave); P0B_LD(ta, 0, nx) P0B_LD(tb, 1, nx) }
        __builtin_amdgcn_sched_barrier(0);
        int t2; asm volatile("v_mbcnt_lo_u32_b32 %0, -1, 0\n\tv_mbcnt_hi_u32_b32 %0, -1, %0" : "=v"(t2)); t2 += wave * 64;
        const int r8 = t2 >> 3, c4 = t2 & 7, ln = t2 & 63;
        a0 = xmax32(xmax16(fmaxf(a0, dppx<0x128>(a0)))); a1 = xmax32(xmax16(fmaxf(a1, dppx<0x128>(a1)))); a2 = xmax32(xmax16(fmaxf(a2, dppx<0x128>(a2)))); a3 = xmax32(xmax16(fmaxf(a3, dppx<0x128>(a3))));
        LAS float* red = (LAS float*)(lds + LDSCTL_OFF + 1024);
        if (ln < 8) { red[wave * 32 + 4 * ln] = a0; red[wave * 32 + 4 * ln + 1] = a1; red[wave * 32 + 4 * ln + 2] = a2; red[wave * 32 + 4 * ln + 3] = a3; }
        BAR_LDS();
#pragma unroll
        for (int w = 0; w < 8; ++w) { a0 = fmaxf(a0, red[w * 32 + 4 * c4]); a1 = fmaxf(a1, red[w * 32 + 4 * c4 + 1]); a2 = fmaxf(a2, red[w * 32 + 4 * c4 + 2]); a3 = fmaxf(a3, red[w * 32 + 4 * c4 + 3]); }
        const float i0 = a0 > 0.f ? 127.0f / a0 : 0.f, i1 = a1 > 0.f ? 127.0f / a1 : 0.f, i2 = a2 > 0.f ? 127.0f / a2 : 0.f, i3 = a3 > 0.f ? 127.0f / a3 : 0.f;
        const int rbase = cur.rbase; const bool rot = cur.rot;
        if (t2 < 8) { const int nb4 = 4 * c4; float* cs = cur.cs;
            cs[rbase + (rot ? 8 * ((nb4 + 0) >> 2) + ((nb4 + 0) & 3) : nb4 + 0)] = a0 * (1.0f / 127.0f); cs[rbase + (rot ? 8 * ((nb4 + 1) >> 2) + ((nb4 + 1) & 3) : nb4 + 1)] = a1 * (1.0f / 127.0f);
            cs[rbase + (rot ? 8 * ((nb4 + 2) >> 2) + ((nb4 + 2) & 3) : nb4 + 2)] = a2 * (1.0f / 127.0f); cs[rbase + (rot ? 8 * ((nb4 + 3) >> 2) + ((nb4 + 3) & 3) : nb4 + 3)] = a3 * (1.0f / 127.0f); }
        LAS unsigned char* img = lds + c4 * 4096;
#pragma unroll
        for (int j = 0; j < 4; ++j) { const int ch = ((4 * r8 + j) ^ c4) << 4; v4u o0, o1, o2, o3;
#pragma unroll
            for (int e = 0; e < 4; ++e) { const int p = 16 * j + 4 * e;
                o0[e] = q4(bflo(d[2 * p]) * i0, bflo(d[2 * p + 2]) * i0, bflo(d[2 * p + 4]) * i0, bflo(d[2 * p + 6]) * i0);
                o1[e] = q4(bfhi(d[2 * p]) * i1, bfhi(d[2 * p + 2]) * i1, bfhi(d[2 * p + 4]) * i1, bfhi(d[2 * p + 6]) * i1);
                o2[e] = q4(bflo(d[2 * p + 1]) * i2, bflo(d[2 * p + 3]) * i2, bflo(d[2 * p + 5]) * i2, bflo(d[2 * p + 7]) * i2);
                o3[e] = q4(bfhi(d[2 * p + 1]) * i3, bfhi(d[2 * p + 3]) * i3, bfhi(d[2 * p + 5]) * i3, bfhi(d[2 * p + 7]) * i3); }
            *(LAS v4u*)(img + 0 * 32768 + ch) = o0; *(LAS v4u*)(img + 1 * 32768 + ch) = o1; *(LAS v4u*)(img + 2 * 32768 + ch) = o2; *(LAS v4u*)(img + 3 * 32768 + ch) = o3; }
        BAR_LDS();
        int l3; asm volatile("v_mbcnt_lo_u32_b32 %0, -1, 0\n\tv_mbcnt_hi_u32_b32 %0, -1, %0" : "=v"(l3));
#pragma unroll
        for (int i = 0; i < 4; ++i) { const int rho = 4 * wave + i, n = 4 * (rho & 7) + (rho >> 3);
            unsigned char* drow = cur.dst + (size_t)(rbase + (rot ? 8 * (n >> 2) + (n & 3) : n)) * P8;
#pragma unroll
            for (int q = 0; q < 4; ++q) { const int ch = 64 * q + l3; *(GAS v4u*)(drow + 16 * ch) = *(const LAS v4u*)(lds + rho * 4096 + ((ch ^ (rho & 7)) << 4)); } }
        if (!more) break;
        item = nxt; cur = nx;
    }
#undef P0B_LD
#undef P0B_CV
}

__device__ __forceinline__ void p0_prologue(const Args& A, LAS unsigned char* lds, int tid, int lane, int wave, int G) {
    unsigned char* ws = A.ws;
    LAS float* scr = (LAS float*)(lds + wave * 16384);
    const int gw = blockIdx.x * NWAVES + wave, NGW = G * NWAVES;
    { const int maxbig = (P0_NBIG + G - 1) / G, ndefw = (G * maxbig - P0_NBIG) * NWAVES, nextra = 7 * ndefw <= P0_NSMALL ? 7 : 0;
      const int rb = (P0_NSMALL - nextra * ndefw) / NGW, t0 = rb * NGW, t1 = t0 + nextra * ndefw;
      const int wdef = gw - (NGW - ndefw);
      auto sidx = [&](int i) -> int {
          if (i < rb) return i * NGW + gw;
          int j = i - rb;
          if (wdef >= 0) { if (j < nextra) return t0 + j * ndefw + wdef; j -= nextra; }
          return (j == 0 && t1 + gw < P0_NSMALL) ? t1 + gw : -1; };
      float wa[32], wb[32]; int i = 0, ia = sidx(0);
      TItem ta = p0_item(A, ia >= 0 ? ia : 0, lane), tb = ta;
      if (ia >= 0) p0_load(ta, wa);
      while (ia >= 0) {
          const int ib = sidx(i + 1);
          if (ib >= 0) { tb = p0_item(A, ib, lane); p0_load(tb, wb); }
          p0_emit(ta, wa, scr, lane);
          if (ib < 0) break;
          ia = sidx(i + 2);
          if (ia >= 0) { ta = p0_item(A, ia, lane); p0_load(ta, wa); }
          p0_emit(tb, wb, scr, lane);
          i += 2;
      } }
    { float* ROT = (float*)(ws + WS_ROT); const int e = blockIdx.x * NWAVES * 64 + tid;
      if (e < 64 * 32) { const int pos = e >> 5, i = e & 31; const float freq = expf(-(float)i * (1.0f / 32.0f) * 9.210340371976184f), ang = (float)pos * freq; ROT[e] = cosf(ang); ROT[2048 + e] = sinf(ang); } }
    __syncthreads();
    LAS float* sc = (LAS float*)lds;
    LAS float* red = sc + 5 * DM;
    const float* cvec = A.in[1]; const float* cctx = A.in[3]; const float* wmod = A.in[4]; const float* bmod = A.in[5];
    float* MOD = (float*)(ws + WS_MOD);
    for (int e = tid; e < 5 * DM; e += NWAVES * 64) { const int r = e >> 12, k = e & (DM - 1); const float cv = r < 4 ? cvec[r * DM + k] : cctx[k]; sc[e] = cv / (1.0f + expf(-cv)); }
    __syncthreads();
    for (int cg = blockIdx.x; cg < NMOD / 96; cg += G) {
        const int kg = tid >> 5, cl = tid & 31;
        float a0[5], a1[5], a2[5];
#pragma unroll
        for (int r = 0; r < 5; ++r) { a0[r] = 0.f; a1[r] = 0.f; a2[r] = 0.f; }
#pragma unroll 8
        for (int k = kg; k < DM; k += 16) {
            const float* wr = wmod + (size_t)k * NMOD + cg * 96 + cl;
            const float w0 = __builtin_nontemporal_load(wr), w1 = __builtin_nontemporal_load(wr + 32), w2 = __builtin_nontemporal_load(wr + 64);
#pragma unroll
            for (int r = 0; r < 5; ++r) { const float s = sc[r * DM + k]; a0[r] += s * w0; a1[r] += s * w1; a2[r] += s * w2; }
        }
#pragma unroll
        for (int r = 0; r < 5; ++r) { red[((kg * 3 + 0) * 5 + r) * 32 + cl] = a0[r]; red[((kg * 3 + 1) * 5 + r) * 32 + cl] = a1[r]; red[((kg * 3 + 2) * 5 + r) * 32 + cl] = a2[r]; }
        __syncthreads();
        if (tid < 480) { const int cc = tid / 160, r = (tid / 32) % 5, c2 = tid & 31; float s = 0.f;
#pragma unroll
            for (int g = 0; g < 16; ++g) s += red[((g * 3 + cc) * 5 + r) * 32 + c2];
            const int col = cg * 96 + cc * 32 + c2; MOD[r * NMOD + col] = s + bmod[col]; }
        __syncthreads();
    }
}

__device__ __forceinline__ void p1_rows(const Args& A, int lane, int wave, int G) {
    const int gw = blockIdx.x * NWAVES + wave, NGW = G * NWAVES;
    const float* MOD = (const float*)(A.ws + WS_MOD); const float* ng = A.in[6];
    bf16* U = (bf16*)(A.ws + WS_U); unsigned char* U8 = A.ws + WS_U8; float* RSU = (float*)(A.ws + WS_RSU);
    for (int m = gw; m < MT; m += NGW) {
        const float* xr = m < ML ? A.in[0] + (size_t)m * DM : A.in[2] + (size_t)(m - ML) * DM;
        const int r = m < ML ? m / SEQ : 4;
        const f32x4* x4 = (const f32x4*)xr + lane;
        f32x4 v[16]; float ss = 0.f;
#pragma unroll
        for (int j = 0; j < 16; ++j) { v[j] = __builtin_nontemporal_load(x4 + 64 * j); ss += (v[j].x * v[j].x + v[j].y * v[j].y) + (v[j].z * v[j].z + v[j].w * v[j].w); }
        const float rstd = __builtin_amdgcn_rsqf(wave_sum(ss) * (1.0f / DM) + EPS);
        const f32x4* g4 = (const f32x4*)ng + lane; const f32x4* sh4 = (const f32x4*)(MOD + r * NMOD) + lane; const f32x4* s4 = (const f32x4*)(MOD + r * NMOD + DM) + lane;
        unsigned long long* o8 = (unsigned long long*)(U + (size_t)m * PK) + lane; float amax = 0.f;
#pragma unroll
        for (int j = 0; j < 16; ++j) { const f32x4 g = g4[64 * j], sh = sh4[64 * j], s = s4[64 * j]; const f32x4 y = v[j] * rstd * g; const f32x4 u = y * (1.0f + s) + sh; v[j] = u;
            amax = fmaxf(amax, fmaxf(fmaxf(fabsf(u.x), fabsf(u.y)), fmaxf(fabsf(u.z), fabsf(u.w))));
            o8[64 * j] = (unsigned long long)pk2(u.x, u.y) | ((unsigned long long)pk2(u.z, u.w) << 32); }
        { amax = wave_max(amax); const float inv = amax > 0.f ? 127.0f / amax : 0.f; if (lane == 0) RSU[m] = amax * (1.0f / 127.0f);
            unsigned* d8 = (unsigned*)(U8 + (size_t)m * P8) + lane;
#pragma unroll
            for (int j = 0; j < 16; ++j) d8[64 * j] = q4(v[j].x * inv, v[j].y * inv, v[j].z * inv, v[j].w * inv); }
    }
}

__device__ __forceinline__ void ld8f(const float* p, f32x4& a, f32x4& b) { a = *(const f32x4*)p; b = *(const f32x4*)(p + 4); }
__device__ __forceinline__ void ld8f_nt(const float* p, f32x4& a, f32x4& b) { a = __builtin_nontemporal_load((const f32x4*)p); b = __builtin_nontemporal_load((const f32x4*)(p + 4)); }
__device__ __forceinline__ void un8(const v4u w, f32x4& a, f32x4& b) { a = (f32x4){bflo(w.x), bfhi(w.x), bflo(w.y), bfhi(w.y)}; b = (f32x4){bflo(w.z), bfhi(w.z), bflo(w.w), bfhi(w.w)}; }
__device__ __forceinline__ float sq8(const f32x4& a, const f32x4& b) { return (a.x * a.x + a.y * a.y) + (a.z * a.z + a.w * a.w) + (b.x * b.x + b.y * b.y) + (b.z * b.z + b.w * b.w); }
__device__ __forceinline__ float amax8(const f32x4& a, const f32x4& b) { return fmaxf(fmaxf(fmaxf(fabsf(a.x), fabsf(a.y)), fmaxf(fabsf(a.z), fabsf(a.w))), fmaxf(fmaxf(fabsf(b.x), fabsf(b.y)), fmaxf(fabsf(b.z), fabsf(b.w)))); }
__device__ __forceinline__ void p5_readout(const Args& A, int lane, int wave, int G) {
    const int gw = blockIdx.x * NWAVES + wave, NGW = G * NWAVES;
    const bf16* HF = (const bf16*)(A.ws + WS_HF); const bf16* HB = (const bf16*)(A.ws + WS_HB); const bf16* AT = (const bf16*)(A.ws + WS_AT);
    const bf16* P = (const bf16*)(A.ws + WS_P); const float* mng = A.in[9];
    unsigned char* HM8 = A.ws + WS_HM8; unsigned char* AT8 = A.ws + WS_AT8; float* RSHM = (float*)(A.ws + WS_RSHM); float* RSAT = (float*)(A.ws + WS_RSAT);
    for (int row = gw; row < ML; row += NGW) {
        f32x4 va[8], vb[8]; float amax = 0.f;
#pragma unroll
        for (int h = 0; h < 8; ++h) { const size_t off = (size_t)row * DM + h * DV + 8 * lane;
            const v4u hf = *(const v4u*)(HF + off), hb = *(const v4u*)(HB + off); const v4u om = *(const v4u*)(P + (size_t)row * NP + OFF_OM + h * DV + 8 * lane);
            f32x4 a0 = (f32x4){bflo(hf.x) + bflo(hb.x), bfhi(hf.x) + bfhi(hb.x), bflo(hf.y) + bflo(hb.y), bfhi(hf.y) + bfhi(hb.y)}, a1 = (f32x4){bflo(hf.z) + bflo(hb.z), bfhi(hf.z) + bfhi(hb.z), bflo(hf.w) + bflo(hb.w), bfhi(hf.w) + bfhi(hb.w)};
            const float rstd = __builtin_amdgcn_rsqf(wave_sum(sq8(a0, a1)) * (1.0f / DV) + EPS);
            const f32x4 g0 = *(const f32x4*)(mng + h * DV + 8 * lane), g1 = *(const f32x4*)(mng + h * DV + 8 * lane + 4);
            a0 = a0 * rstd * g0 * (f32x4){sigm(bflo(om.x)), sigm(bfhi(om.x)), sigm(bflo(om.y)), sigm(bfhi(om.y))}; a1 = a1 * rstd * g1 * (f32x4){sigm(bflo(om.z)), sigm(bfhi(om.z)), sigm(bflo(om.w)), sigm(bfhi(om.w))};
            va[h] = a0; vb[h] = a1; amax = fmaxf(amax, amax8(a0, a1)); }
        amax = wave_max(amax); float inv = amax > 0.f ? 127.0f / amax : 0.f; if (lane == 0) RSHM[row] = amax * (1.0f / 127.0f);
#pragma unroll
        for (int h = 0; h < 8; ++h) { uint2 o; o.x = q4(va[h].x * inv, va[h].y * inv, va[h].z * inv, va[h].w * inv); o.y = q4(vb[h].x * inv, vb[h].y * inv, vb[h].z * inv, vb[h].w * inv);
            *(uint2*)(HM8 + (size_t)row * P8 + h * DV + 8 * lane) = o; }
        amax = 0.f;
#pragma unroll
        for (int j = 0; j < 8; ++j) { un8(*(const v4u*)(AT + (size_t)row * PK + 8 * lane + 512 * j), va[j], vb[j]); amax = fmaxf(amax, amax8(va[j], vb[j])); }
        amax = wave_max(amax); inv = amax > 0.f ? 127.0f / amax : 0.f; if (lane == 0) RSAT[row] = amax * (1.0f / 127.0f);
#pragma unroll
        for (int j = 0; j < 8; ++j) { uint2 o; o.x = q4(va[j].x * inv, va[j].y * inv, va[j].z * inv, va[j].w * inv); o.y = q4(vb[j].x * inv, vb[j].y * inv, vb[j].z * inv, vb[j].w * inv);
            *(uint2*)(AT8 + (size_t)row * P8 + 8 * lane + 512 * j) = o; }
    }
}

__device__ __forceinline__ void p6_ygq(const Args& A, int lane, int wave, int G) {
    const int gw = blockIdx.x * NWAVES + wave, NGW = G * NWAVES;
    const bf16* YG = (const bf16*)(A.ws + WS_YG); unsigned char* YG8 = A.ws + WS_YG8; float* RSY = (float*)(A.ws + WS_RSY); const unsigned* RM = (const unsigned*)(A.ws + WS_RMAXY);
    for (int row = gw; row < ML; row += NGW) {
        const float am = __builtin_bit_cast(float, __hip_atomic_load(RM + row, __ATOMIC_RELAXED, __HIP_MEMORY_SCOPE_AGENT)), inv = am > 0.f ? 127.0f / am : 0.f;
        if (lane == 0) RSY[row] = am * (1.0f / 127.0f);
#pragma unroll
        for (int j = 0; j < 8; ++j) { const v4u w = *(const v4u*)(YG + (size_t)row * PK + 8 * lane + 512 * j);
            uint2 o; o.x = q4(bflo(w.x) * inv, bfhi(w.x) * inv, bflo(w.y) * inv, bfhi(w.y) * inv); o.y = q4(bflo(w.z) * inv, bfhi(w.z) * inv, bflo(w.w) * inv, bfhi(w.w) * inv);
            *(uint2*)(YG8 + (size_t)row * P8 + 8 * lane + 512 * j) = o; }
    }
}

__device__ __forceinline__ void p8_rows(const Args& A, int lane, int wave, int G) {
    const int gw = blockIdx.x * NWAVES + wave, NGW = G * NWAVES;
    const float* MOD = (const float*)(A.ws + WS_MOD); const float* ng = A.in[6];
    const bf16* MIX = (const bf16*)(A.ws + WS_MIX); unsigned char* U28 = A.ws + WS_U28; float* RS2 = (float*)(A.ws + WS_RS2); bf16* H1 = (bf16*)(A.ws + WS_HB);
    for (int m = gw; m < ML; m += NGW) {
        const int r = m / SEQ; const size_t ro = (size_t)m * DM + 8 * lane; const int co = 8 * lane;
        f32x4 va[8], vb[8]; float ss = 0.f;
#pragma unroll
        for (int j = 0; j < 8; ++j) { un8(*(const v4u*)(MIX + ro + 512 * j), va[j], vb[j]); ss += sq8(va[j], vb[j]); }
        const float rstd = __builtin_amdgcn_rsqf(wave_sum(ss) * (1.0f / DM) + EPS);
        const float* n1 = ng + DM + co; const float* g1 = MOD + r * NMOD + 2 * DM + co; const float* x = A.in[0] + ro; float ss2 = 0.f;
#pragma unroll
        for (int j = 0; j < 8; ++j) { f32x4 xa, xb, na, nb, ga, gb; ld8f_nt(x + 512 * j, xa, xb); ld8f(n1 + 512 * j, na, nb); ld8f(g1 + 512 * j, ga, gb);
            va[j] = xa + ga * (va[j] * rstd * na); vb[j] = xb + gb * (vb[j] * rstd * nb); ss2 += sq8(va[j], vb[j]);
            { v4u hw; hw.x = pk2(va[j].x, va[j].y); hw.y = pk2(va[j].z, va[j].w); hw.z = pk2(vb[j].x, vb[j].y); hw.w = pk2(vb[j].z, vb[j].w); *(v4u*)(H1 + ro + 512 * j) = hw; } }
        const float rstd2 = __builtin_amdgcn_rsqf(wave_sum(ss2) * (1.0f / DM) + EPS);
        const float* n2 = ng + 2 * DM + co; const float* sh2 = MOD + r * NMOD + 3 * DM + co; const float* s2 = MOD + r * NMOD + 4 * DM + co;
        float amax = 0.f;
#pragma unroll
        for (int j = 0; j < 8; ++j) { f32x4 na, nb, ha, hb, sa, sb; ld8f(n2 + 512 * j, na, nb); ld8f(sh2 + 512 * j, ha, hb); ld8f(s2 + 512 * j, sa, sb);
            va[j] = (va[j] * rstd2 * na) * (1.0f + sa) + ha; vb[j] = (vb[j] * rstd2 * nb) * (1.0f + sb) + hb;
            amax = fmaxf(amax, fmaxf(fmaxf(fmaxf(fabsf(va[j].x), fabsf(va[j].y)), fmaxf(fabsf(va[j].z), fabsf(va[j].w))), fmaxf(fmaxf(fabsf(vb[j].x), fabsf(vb[j].y)), fmaxf(fabsf(vb[j].z), fabsf(vb[j].w))))); }
        amax = wave_max(amax); const float inv = amax > 0.f ? 127.0f / amax : 0.f; if (lane == 0) RS2[m] = amax * (1.0f / 127.0f);
#pragma unroll
        for (int j = 0; j < 8; ++j) { uint2 o; o.x = q4(va[j].x * inv, va[j].y * inv, va[j].z * inv, va[j].w * inv); o.y = q4(vb[j].x * inv, vb[j].y * inv, vb[j].z * inv, vb[j].w * inv);
            *(uint2*)(U28 + (size_t)m * P8 + co + 512 * j) = o; }
    }
}

__device__ __forceinline__ void p11_rows(const Args& A, int lane, int wave, int G, bool poison) {
    const int gw = blockIdx.x * NWAVES + wave, NGW = G * NWAVES;
    const float* MOD = (const float*)(A.ws + WS_MOD); const float* ng = A.in[6];
    const bf16* Fb = (const bf16*)(A.ws + WS_F); const bf16* H1 = (const bf16*)(A.ws + WS_HB);
    for (int m = gw; m < ML; m += NGW) {
        const int r = m / SEQ; const size_t ro = (size_t)m * DM + 8 * lane; const int co = 8 * lane;
        f32x4 va[8], vb[8]; float ss = 0.f;
#pragma unroll
        for (int j = 0; j < 8; ++j) { un8(*(const v4u*)(Fb + ro + 512 * j), va[j], vb[j]); ss += sq8(va[j], vb[j]); }
        const float rstd3 = __builtin_amdgcn_rsqf(wave_sum(ss) * (1.0f / DM) + EPS);
        const float* n3 = ng + 3 * DM + co; const float* g2 = MOD + r * NMOD + 5 * DM + co;
        const float qn = __builtin_nanf("");
#pragma unroll
        for (int j = 0; j < 8; ++j) { f32x4 ma, mb, ta, tb, ha, hb; un8(*(const v4u*)(H1 + ro + 512 * j), ma, mb);
            ld8f(n3 + 512 * j, ta, tb); ld8f(g2 + 512 * j, ha, hb);
            f32x4 oa = ma + ha * (va[j] * rstd3 * ta), ob = mb + hb * (vb[j] * rstd3 * tb);
            if (poison) { oa = (f32x4){qn, qn, qn, qn}; ob = oa; }
            __builtin_nontemporal_store(oa, (f32x4*)(A.out + ro + 512 * j)); __builtin_nontemporal_store(ob, (f32x4*)(A.out + ro + 512 * j + 4)); }
    }
}

__global__ void __launch_bounds__(NWAVES * 64, 2) fwd_kernel(Args args) {
    extern __shared__ __attribute__((aligned(16))) unsigned char lds_raw[];
    LAS unsigned char* lds = (LAS unsigned char*)lds_raw;
    volatile LAS unsigned* MISC = (volatile LAS unsigned*)(lds + MISC_OFF);
    const int tid0 = threadIdx.x, wave = __builtin_amdgcn_readfirstlane(tid0 >> 6), G = gridDim.x;
    unsigned char* ws = args.ws;
    gu32* ctl = (gu32*)(ws + WS_CTL);
    for (int u = tid0; u < (LDS_BYTES - LDSCTL_OFF) / 4; u += NWAVES * 64) ((LAS unsigned*)(lds + LDSCTL_OFF))[u] = 0u;
    __syncthreads();
    XcdBarrier bar; bar.wave = wave; bar.bar = (unsigned*)(ctl + CW_BAR); bar.x = 0; bar.st = nullptr;
    if (N_LAUNCHES == 1) bar = xcd_barrier_post((unsigned*)(ctl + CW_BAR), MISC + 8, wave);
    const int lo = args.ph_lo, hi = args.ph_hi;
#define IN(k) (lo <= (k) && (k) < hi)
#define PHASE_IDS const int lane = (int)__builtin_amdgcn_mbcnt_hi(~0u, __builtin_amdgcn_mbcnt_lo(~0u, 0u)); const int tid = wave * 64 + lane
#define SEAM(k) do { if (IN(k) && IN((k) + 1)) xcd_barrier(bar); } while (0)

    if (IN(0)) {
        p0_bigs(args, lds, wave, G);
        __syncthreads();
        int lane; asm volatile("v_mbcnt_lo_u32_b32 %0, -1, 0\n\tv_mbcnt_hi_u32_b32 %0, -1, %0" : "=v"(lane)); const int tid = wave * 64 + lane;
        p0_prologue(args, lds, tid, lane, wave, G); } SEAM(0);
    if (IN(1)) { PHASE_IDS; p1_rows(args, lane, wave, G); } SEAM(1);
    if (IN(2)) { PHASE_IDS;
        { pg8::Gemm g{(const pg8::bf16_t*)(ws + WS_U), (const pg8::bf16_t*)(ws + WS_WIN), MT, NP, DM, PK, PK}; pg8::ProjOrder S; S.init(G, (int)blockIdx.x);
          pg8::Epi8<pg8::FProj> E{{(pg8::bf16_t*)(ws + WS_P), (float*)(ws + WS_G), (const float*)(ws + WS_ROT), NP, OFF_GM / 256}};
          pg8::gemm_phase<pg8::Epi8<pg8::FProj>, pg8::ProjOrder, true, true>(lds + RING_OFF, g, S, E, wave); }
        { pg8::Gemm g{(const pg8::bf16_t*)(ws + WS_U8), (const pg8::bf16_t*)(ws + WS_W8G), MT, N8P, DM / 2, P8 / 2, P8 / 2}; pg8::ProjOrderI8 S; S.init(G, (int)blockIdx.x, 32 * 17 + 4 * 9);
          pg8::Epi8<pg8::FProjI8> E{{(pg8::bf16_t*)(ws + WS_P), (const float*)(ws + WS_RSU), (const float*)(ws + WS_CSG), (const float*)(ws + WS_ROT), NP, OFF_KM}};
          pg8::gemm_phase<pg8::Epi8<pg8::FProjI8>, pg8::ProjOrderI8, true, true, true>(lds + RING_OFF, g, S, E, wave); }
    } SEAM(2);
    if (IN(3)) { PHASE_IDS;
        for (int item = blockIdx.x; item < NB * MH * 2 * 4; item += G) ml::mlstm_item(args, lds, tid, lane, wave, item);
        __syncthreads();
        { PHASE_IDS; at::attn_items(args, lds, tid, lane, wave, G); }
        __syncthreads();
    } SEAM(3);
    if (IN(4)) { PHASE_IDS; p5_readout(args, lane, wave, G); } SEAM(4);
    if (IN(5)) { PHASE_IDS;
        { pg8::Gemm g{(const pg8::bf16_t*)(ws + WS_HM8), (const pg8::bf16_t*)(ws + WS_W8OM), ML, DM, DM / 2, P8 / 2, P8 / 2}; pg8::StaticOrder S; S.init(ML, DM, G, (int)blockIdx.x);
          pg8::Epi8<pg8::FGateM8> E{{(const pg8::bf16_t*)(ws + WS_P) + OFF_BGM, NP, (pg8::bf16_t*)(ws + WS_T), DM, (const float*)(ws + WS_RSHM), (const float*)(ws + WS_CSOM)}};
          pg8::gemm_phase<pg8::Epi8<pg8::FGateM8>, pg8::StaticOrder, true, true, true>(lds + RING_OFF, g, S, E, wave); }
        { pg8::Gemm g{(const pg8::bf16_t*)(ws + WS_AT8), (const pg8::bf16_t*)(ws + WS_W8OA), ML, DM, DM / 2, P8 / 2, P8 / 2}; pg8::StaticOrder S; S.init(ML, DM, G, (int)blockIdx.x);
          pg8::Epi8<pg8::FGateA8> E{{(const pg8::bf16_t*)(ws + WS_P) + OFF_BGA, NP, (const pg8::bf16_t*)(ws + WS_T), (pg8::bf16_t*)(ws + WS_YG), DM, PK, (const float*)(ws + WS_RSAT), (const float*)(ws + WS_CSOA), (unsigned*)(ws + WS_RMAXY)}};
          pg8::gemm_phase<pg8::Epi8<pg8::FGateA8>, pg8::StaticOrder, true, true, true>(lds + RING_OFF, g, S, E, wave); }
    } SEAM(5);
    if (IN(6)) { PHASE_IDS; p6_ygq(args, lane, wave, G); } SEAM(6);
    if (IN(7)) { PHASE_IDS;
        pg8::Gemm g{(const pg8::bf16_t*)(ws + WS_YG8), (const pg8::bf16_t*)(ws + WS_W8O), ML, DM, DM / 2, P8 / 2, P8 / 2}; pg8::StaticOrder S; S.init(ML, DM, G, (int)blockIdx.x);
        pg8::Epi8<pg8::FBf16I8> E{{(pg8::bf16_t*)(ws + WS_MIX), (const float*)(ws + WS_RSY), (const float*)(ws + WS_CSO), DM}};
        pg8::gemm_phase<pg8::Epi8<pg8::FBf16I8>, pg8::StaticOrder, true, true, true>(lds + RING_OFF, g, S, E, wave);
    } SEAM(7);
    if (IN(8)) { PHASE_IDS; p8_rows(args, lane, wave, G); } SEAM(8);
    if (IN(9)) { PHASE_IDS;
        pg8::Gemm g{(const pg8::bf16_t*)(ws + WS_U28), (const pg8::bf16_t*)(ws + WS_W8F), ML, DFF, DM / 2, P8 / 2, P8 / 2}; pg8::StaticOrder S; S.init(ML, DFF, G, (int)blockIdx.x);
        pg8::Epi8<pg8::FRelu2I8> E{{(pg8::bf16_t*)(ws + WS_HDN), (const float*)(ws + WS_RS2), (const float*)(ws + WS_CSF), PF}};
        pg8::gemm_phase<pg8::Epi8<pg8::FRelu2I8>, pg8::StaticOrder, true, true, true>(lds + RING_OFF, g, S, E, wave);
    } SEAM(9);
    if (IN(10)) { PHASE_IDS;
        pg8::Gemm g{(const pg8::bf16_t*)(ws + WS_HDN), (const pg8::bf16_t*)(ws + WS_WF2), ML, DM, DFF, PF, PF}; pg8::StaticOrder S; S.init(ML, DM, G, (int)blockIdx.x);
        pg8::Epi8<pg8::FBf16> E{{(pg8::bf16_t*)(ws + WS_F), DM}};
        pg8::gemm_phase<pg8::Epi8<pg8::FBf16>, pg8::StaticOrder, true, true>(lds + RING_OFF, g, S, E, wave);
    } SEAM(10);
    if (IN(11)) { PHASE_IDS;
        const bool poison = (N_LAUNCHES == 1) && (__hip_atomic_load(ctl + CW_BAR + XB_TMO, RLX_AGENT) != 0u);
        p11_rows(args, lane, wave, G, poison);
    }
#undef IN
#undef SEAM
}

extern "C" void kernel_launch(void* const* d_in, const int* in_sizes, int n_in, void* d_out, int out_size, void* d_ws, size_t ws_size, hipStream_t stream) {
    static int grid = 0;
    if (grid == 0) {
        if (n_in != 16 || out_size != ML * DM || ws_size < WS_END2) { fprintf(stderr, "kernel_launch: unexpected shapes: n_in %d out %d ws %zu (need %zu); nothing launched\n", n_in, out_size, ws_size, (size_t)WS_END2); grid = -1; return; }
        int dev = 0, cus = 0, per_cu = 0;
        if (hipGetDevice(&dev) != hipSuccess || hipDeviceGetAttribute(&cus, hipDeviceAttributeMultiprocessorCount, dev) != hipSuccess) { grid = -1; return; }
        if (hipFuncSetAttribute((const void*)fwd_kernel, hipFuncAttributeMaxDynamicSharedMemorySize, LDS_BYTES) != hipSuccess) { fprintf(stderr, "kernel_launch: hipFuncSetAttribute failed\n"); grid = -1; return; }
        if (hipOccupancyMaxActiveBlocksPerMultiprocessor(&per_cu, (const void*)fwd_kernel, NWAVES * 64, LDS_BYTES) != hipSuccess || per_cu < 1)
            fprintf(stderr, "kernel_launch: note: occupancy query reports %d workgroups per CU\n", per_cu);
        (void)hipGetLastError();
        grid = cus;
    }
    if (grid < 0) return;
    if (hipMemsetAsync((char*)d_ws + WS_CTL, 0, CTL_ZERO_BYTES, stream) != hipSuccess) { fprintf(stderr, "kernel_launch: memset failed\n"); return; }
    Args a{};
    for (int i = 0; i < 16; ++i) a.in[i] = (const float*)d_in[i];
    a.out = (float*)d_out; a.ws = (unsigned char*)d_ws;
    for (int li = 0; li < N_LAUNCHES; ++li) {
        a.ph_lo = (N_LAUNCHES == 1) ? 0 : li; a.ph_hi = (N_LAUNCHES == 1) ? N_PHASES : li + 1;
        hipLaunchKernelGGL(fwd_kernel, dim3(grid), dim3(NWAVES * 64), LDS_BYTES, stream, a);
        const hipError_t le = hipPeekAtLastError();
        if (le != hipSuccess) { fprintf(stderr, "kernel_launch: launch %d failed: %s\n", li, hipGetErrorName(le)); break; }
    }
}
```
